# Optimizing an MI355X kernel written in HIP

```python
import math
import jax, jax.numpy as jnp
from jax import lax
import numpy as np

D_MODEL = 1024
BATCH = 16
SEQ = 4096
DEPTH = 4

HEAD_DIM = 64
RMS_EPS = 1e-6
A_WIDTH = D_MODEL // 2
A_HEADS = A_WIDTH // HEAD_DIM
DECAY_LORA = 64
AAA_LORA = 64
GATE_LORA = 128
GN_EPS = 64e-5
B_WIDTH = D_MODEL // 2
B_GROUPS = 4
B_GROUP_DIM = B_WIDTH // B_GROUPS
CHUNK = 128
LN_EPS = 1e-5
OFF_K = A_WIDTH
OFF_V = 2 * A_WIDTH
OFF_W = 3 * A_WIDTH
OFF_A = OFF_W + DECAY_LORA
OFF_G = OFF_A + AAA_LORA
A_COLS = OFF_G + GATE_LORA
IN_COLS = A_COLS + 2 * B_WIDTH
Q_HEADS = D_MODEL // HEAD_DIM
KV_HEADS = 4
Q_PER_KV = Q_HEADS // KV_HEADS
WINDOW = 128
ROPE_THETA = 10000.0
QKV_COLS = (Q_HEADS + 2 * KV_HEADS) * HEAD_DIM
D_FF = 2816
N_EVEN = (DEPTH + 1) // 2
N_ODD = DEPTH // 2

kernel_name = "hybrid_rwkv7_gmlp_swa_macaron"


def rms_norm(x, gain, eps=RMS_EPS):
    xf = x.astype(jnp.float32)
    y = xf * lax.rsqrt(jnp.mean(xf * xf, axis=-1, keepdims=True) + eps)
    return (y * gain.astype(jnp.float32)).astype(x.dtype)


def layer_norm(x, gain, bias, eps=LN_EPS):
    xf = x.astype(jnp.float32)
    mu = jnp.mean(xf, axis=-1, keepdims=True)
    var = jnp.mean(jnp.square(xf - mu), axis=-1, keepdims=True)
    return ((xf - mu) * lax.rsqrt(var + eps) * gain.astype(jnp.float32) + bias.astype(jnp.float32)).astype(x.dtype)


def swiglu_ffn(x, w_gate, w_up, w_down):
    return (jax.nn.silu(x @ w_gate) * (x @ w_up)) @ w_down


def token_shift(z):
    return jnp.pad(z, ((0, 0), (1, 0), (0, 0)))[:, :-1]


def rope(x, cos, sin):
    x1, x2 = jnp.split(x, 2, axis=-1)
    return jnp.concatenate([x1 * cos - x2 * sin, x2 * cos + x1 * sin], axis=-1).astype(x.dtype)


def rwkv7_scan(r, w, k, v, a, b):
    def step(S, inp):
        r_t, w_t, k_t, v_t, a_t, b_t = inp
        sa = jnp.einsum('bhij,bhj->bhi', S, a_t)
        S = S * w_t[:, :, None, :] + sa[..., None] * b_t[:, :, None, :] + v_t[..., None] * k_t[:, :, None, :]
        return S, jnp.einsum('bhij,bhj->bhi', S, r_t)
    xs = tuple(jnp.moveaxis(t.astype(jnp.float32), 1, 0) for t in (r, w, k, v, a, b))
    bsz, _, heads, dim = r.shape
    s0 = jnp.zeros((bsz, heads, dim, dim), jnp.float32)
    _, y = lax.scan(step, s0, xs)
    return jnp.moveaxis(y, 0, 1)


def rwkv_gmlp_mixer(h, w_in, mu_shift, w0, w_decay_up, a0, w_aaa_up, w_gate_up, k_k, k_a, r_k,
                    gn_gain, gn_bias, sg_ln_gain, sg_ln_bias, w_spatial, b_spatial, w_out):
    bsz, t_len, _ = h.shape
    z = h @ w_in
    z_a, z_b = z[..., :A_COLS], z[..., A_COLS:]

    z_a = z_a + (token_shift(z_a) - z_a) * mu_shift
    r, k, v, xw, xa, xg = jnp.split(z_a, [OFF_K, OFF_V, OFF_W, OFF_A, OFF_G], axis=-1)
    w_log = -jax.nn.softplus(-(w0 + jnp.tanh(xw) @ w_decay_up)) - 0.5
    decay = jnp.exp(-jnp.exp(w_log.astype(jnp.float32)))
    iclr = jax.nn.sigmoid(a0 + xa @ w_aaa_up)
    gate = jax.nn.sigmoid(xg) @ w_gate_up
    heads = lambda t: t.reshape(bsz, t_len, A_HEADS, HEAD_DIM)
    kk = heads(k * k_k).astype(jnp.float32)
    kk = kk / jnp.maximum(jnp.sqrt(jnp.sum(kk * kk, axis=-1, keepdims=True)), 1e-12)
    k = k * (1.0 + (iclr - 1.0) * k_a)
    r_h, k_h, v_h, a_h = heads(r), heads(k), heads(v), heads(iclr)
    y = rwkv7_scan(r_h, heads(decay), k_h, v_h, -kk, kk * a_h.astype(jnp.float32))
    mu = jnp.mean(y, axis=-1, keepdims=True)
    var = jnp.mean(jnp.square(y - mu), axis=-1, keepdims=True)
    y = ((y - mu) * lax.rsqrt(var + GN_EPS)).reshape(bsz, t_len, A_WIDTH)
    y = (y * gn_gain.astype(jnp.float32) + gn_bias.astype(jnp.float32)).astype(h.dtype)
    bonus = (jnp.sum(r_h * k_h * r_k, axis=-1, keepdims=True) * v_h).reshape(bsz, t_len, A_WIDTH)
    y_a = (y + bonus) * gate

    z_b = jax.nn.gelu(z_b, approximate=False)
    u, s = jnp.split(z_b, 2, axis=-1)
    s = layer_norm(s, sg_ln_gain, sg_ln_bias)
    s = s.reshape(bsz, t_len // CHUNK, CHUNK, B_GROUPS, B_GROUP_DIM)
    causal = jnp.tril(jnp.ones((CHUNK, CHUNK), dtype=bool))
    w_s = jnp.where(causal[None], w_spatial, jnp.zeros((), w_spatial.dtype))
    s = jnp.einsum('gts,bcsgd->bctgd', w_s, s) + b_spatial.T[None, None, :, :, None]
    y_b = u * s.reshape(bsz, t_len, B_WIDTH)

    return jnp.concatenate([y_a, y_b], axis=-1) @ w_out


def swa_sink_attention(h, cos, sin, w_qkv, b_qkv, q_norm, k_norm, sinks, w_o, b_o):
    bsz, t_len, _ = h.shape
    nb = t_len // WINDOW
    qkv = h @ w_qkv + b_qkv
    q, k, v = jnp.split(qkv, [Q_HEADS * HEAD_DIM, (Q_HEADS + KV_HEADS) * HEAD_DIM], axis=-1)
    q = rope(rms_norm(q.reshape(bsz, t_len, Q_HEADS, HEAD_DIM), q_norm), cos, sin)
    k = rope(rms_norm(k.reshape(bsz, t_len, KV_HEADS, HEAD_DIM), k_norm), cos, sin)
    v = v.reshape(bsz, t_len, KV_HEADS, HEAD_DIM)

    q_blk = q.reshape(bsz, nb, WINDOW, KV_HEADS, Q_PER_KV, HEAD_DIM).transpose(1, 0, 2, 3, 4, 5)

    def band(t):
        tb = t.reshape(bsz, nb, WINDOW, KV_HEADS, HEAD_DIM)
        prev = jnp.pad(tb, ((0, 0), (1, 0), (0, 0), (0, 0), (0, 0)))[:, :-1]
        return jnp.concatenate([prev, tb], axis=2).transpose(1, 0, 2, 3, 4)

    k_band, v_band = band(k), band(v)
    qi = jnp.arange(WINDOW)[:, None]
    kj = jnp.arange(2 * WINDOW)[None, :]
    dist = qi + WINDOW - kj
    in_window = (dist >= 0) & (dist < WINDOW)
    scale = HEAD_DIM ** -0.5
    sink = sinks.astype(jnp.float32).reshape(KV_HEADS, Q_PER_KV)[None, :, :, None]

    def block(args):
        n, qb, kb, vb = args
        s = jnp.einsum('bqhgd,bkhd->bhgqk', qb, kb, preferred_element_type=jnp.float32) * scale
        valid = in_window & ((n > 0) | (kj >= WINDOW))
        s = jnp.where(valid, s, -jnp.inf)
        m = jnp.maximum(jnp.max(s, axis=-1), sink)
        p = jnp.exp(s - m[..., None])
        denom = jnp.sum(p, axis=-1) + jnp.exp(sink - m)
        o = jnp.einsum('bhgqk,bkhd->bqhgd', p, vb.astype(jnp.float32))
        return (o / denom.transpose(0, 3, 1, 2)[..., None]).astype(qb.dtype)

    o = lax.map(block, (jnp.arange(nb), q_blk, k_band, v_band))
    o = o.transpose(1, 0, 2, 3, 4, 5).reshape(bsz, t_len, Q_HEADS * HEAD_DIM)
    return o @ w_o + b_o


def setup_inputs(seed: int = 0) -> dict:
    key = jax.random.key(seed)
    ks = iter(jax.random.split(key, 40))
    nrm = lambda shape, scale: scale * jax.random.normal(next(ks), shape, jnp.float32)
    d = D_MODEL
    inp = {}
    inp["x"] = nrm((BATCH, SEQ, d), 1.0)
    inp["positions"] = jnp.broadcast_to(jnp.arange(SEQ, dtype=jnp.int32)[None, :], (BATCH, SEQ)).astype(jnp.int32)
    inp["ffn1_norm"] = 1.0 + nrm((DEPTH, d), 0.1)
    inp["ffn1_w_gate"] = nrm((DEPTH, d, D_FF), d ** -0.5)
    inp["ffn1_w_up"] = nrm((DEPTH, d, D_FF), d ** -0.5)
    inp["ffn1_w_down"] = nrm((DEPTH, D_FF, d), D_FF ** -0.5)
    inp["mix_norm"] = 1.0 + nrm((DEPTH, d), 0.1)
    inp["ffn2_norm"] = 1.0 + nrm((DEPTH, d), 0.1)
    inp["ffn2_w_gate"] = nrm((DEPTH, d, D_FF), d ** -0.5)
    inp["ffn2_w_up"] = nrm((DEPTH, d, D_FF), d ** -0.5)
    inp["ffn2_w_down"] = nrm((DEPTH, D_FF, d), D_FF ** -0.5)
    inp["ab_w_in"] = nrm((N_EVEN, d, IN_COLS), d ** -0.5)
    inp["ab_mu_shift"] = jax.random.uniform(next(ks), (N_EVEN, A_COLS), jnp.float32)
    inp["rwkv_w0"] = -2.0 + nrm((N_EVEN, A_WIDTH), 0.7)
    inp["rwkv_w_decay_up"] = nrm((N_EVEN, DECAY_LORA, A_WIDTH), 0.5 * DECAY_LORA ** -0.5)
    inp["rwkv_a0"] = nrm((N_EVEN, A_WIDTH), 0.1)
    inp["rwkv_w_aaa_up"] = nrm((N_EVEN, AAA_LORA, A_WIDTH), 0.5 * AAA_LORA ** -0.5)
    inp["rwkv_w_gate_up"] = nrm((N_EVEN, GATE_LORA, A_WIDTH), GATE_LORA ** -0.5)
    inp["rwkv_k_k"] = 0.85 + nrm((N_EVEN, A_WIDTH), 0.1)
    inp["rwkv_k_a"] = 1.0 + nrm((N_EVEN, A_WIDTH), 0.1)
    inp["rwkv_r_k"] = nrm((N_EVEN, A_HEADS, HEAD_DIM), 0.1)
    inp["rwkv_gn_gain"] = 1.0 + nrm((N_EVEN, A_WIDTH), 0.1)
    inp["rwkv_gn_bias"] = nrm((N_EVEN, A_WIDTH), 0.02)
    inp["sg_ln_gain"] = 1.0 + nrm((N_EVEN, B_WIDTH), 0.1)
    inp["sg_ln_bias"] = nrm((N_EVEN, B_WIDTH), 0.02)
    inp["sg_w_spatial"] = nrm((N_EVEN, B_GROUPS, CHUNK, CHUNK), 0.5 * CHUNK ** -0.5)
    inp["sg_b_spatial"] = 1.0 + nrm((N_EVEN, B_GROUPS, CHUNK), 0.1)
    inp["ab_w_out"] = nrm((N_EVEN, A_WIDTH + B_WIDTH, d), (A_WIDTH + B_WIDTH) ** -0.5)
    inp["attn_w_qkv"] = nrm((N_ODD, d, QKV_COLS), d ** -0.5)
    inp["attn_b_qkv"] = nrm((N_ODD, QKV_COLS), 0.02)
    inp["attn_q_norm"] = 1.0 + nrm((N_ODD, HEAD_DIM), 0.1)
    inp["attn_k_norm"] = 1.0 + nrm((N_ODD, HEAD_DIM), 0.1)
    inp["attn_sinks"] = nrm((N_ODD, Q_HEADS), 1.0)
    inp["attn_w_o"] = nrm((N_ODD, Q_HEADS * HEAD_DIM, d), (Q_HEADS * HEAD_DIM) ** -0.5)
    inp["attn_b_o"] = nrm((N_ODD, d), 0.02)
    return inp


def reference(x, positions, ffn1_norm, ffn1_w_gate, ffn1_w_up, ffn1_w_down, mix_norm,
              ffn2_norm, ffn2_w_gate, ffn2_w_up, ffn2_w_down,
              ab_w_in, ab_mu_shift, rwkv_w0, rwkv_w_decay_up, rwkv_a0, rwkv_w_aaa_up, rwkv_w_gate_up,
              rwkv_k_k, rwkv_k_a, rwkv_r_k, rwkv_gn_gain, rwkv_gn_bias,
              sg_ln_gain, sg_ln_bias, sg_w_spatial, sg_b_spatial, ab_w_out,
              attn_w_qkv, attn_b_qkv, attn_q_norm, attn_k_norm, attn_sinks, attn_w_o, attn_b_o):
    inv_freq = ROPE_THETA ** (-jnp.arange(0, HEAD_DIM, 2, dtype=jnp.float32) / HEAD_DIM)
    ang = positions.astype(jnp.float32)[..., None] * inv_freq
    cos = jnp.cos(ang)[:, :, None, :]
    sin = jnp.sin(ang)[:, :, None, :]
    for l in range(DEPTH):
        h = rms_norm(x, ffn1_norm[l])
        x = x + 0.5 * swiglu_ffn(h, ffn1_w_gate[l], ffn1_w_up[l], ffn1_w_down[l])
        h = rms_norm(x, mix_norm[l])
        i = l // 2
        if l % 2 == 0:
            x = x + rwkv_gmlp_mixer(h, ab_w_in[i], ab_mu_shift[i], rwkv_w0[i], rwkv_w_decay_up[i],
                                    rwkv_a0[i], rwkv_w_aaa_up[i], rwkv_w_gate_up[i], rwkv_k_k[i],
                                    rwkv_k_a[i], rwkv_r_k[i], rwkv_gn_gain[i], rwkv_gn_bias[i],
                                    sg_ln_gain[i], sg_ln_bias[i], sg_w_spatial[i], sg_b_spatial[i],
                                    ab_w_out[i])
        else:
            x = x + swa_sink_attention(h, cos, sin, attn_w_qkv[i], attn_b_qkv[i], attn_q_norm[i],
                                       attn_k_norm[i], attn_sinks[i], attn_w_o[i], attn_b_o[i])
        h = rms_norm(x, ffn2_norm[l])
        x = x + 0.5 * swiglu_ffn(h, ffn2_w_gate[l], ffn2_w_up[l], ffn2_w_down[l])
    return x
```

```cpp
#include <hip/hip_runtime.h>
#include <hip/hip_cooperative_groups.h>
#include <cstdio>
#include <cstdint>
#include <cmath>
namespace pg8 {
#define PG8_LAS __attribute__((address_space(3)))
typedef unsigned short bf16_t;
typedef short bf16x8 __attribute__((ext_vector_type(8)));
typedef float f32x4 __attribute__((ext_vector_type(4)));
typedef unsigned u32x4 __attribute__((ext_vector_type(4)));
constexpr int BM = 256, BK = 64, HALF = 128, HTB = HALF * BK * 2  , STAGE_BYTES = 8 * HTB, NXCD = 8, WGM = 8;

__host__ __device__ __forceinline__ int lds_byte(int r, int c) { const int st = (r >> 4) * 2 + (c >> 5), rr = r & 15, cc = c & 31, ob = rr * 64 + cc * 2; return st * 1024 + (ob ^ (((ob >> 9) & 1) << 5)); }
__host__ __device__ __forceinline__ void stage_rc(int b, int& R, int& C) { const int st = b / 1024, sb = b % 1024, swz = sb ^ (((sb >> 9) & 1) << 5); R = (st >> 1) * 16 + swz / 64; C = (st & 1) * 32 + (swz % 64) / 2; }
__host__ __device__ __forceinline__ int perm32(int rho) { const int n = rho >> 4, i = rho & 15; return 8 * (i >> 2) + 4 * n + (i & 3); }

struct Unit { int pm, pn; };
struct Gemm { const bf16_t* A; const bf16_t* Bt; int M, N, K; };

struct StaticOrder {
    int nM, nN, nwg, G, c;
    __host__ __device__ void init(int M, int N, int G_, int c_) { nM = M / BM; nN = N / BM; nwg = nM * nN; G = G_; c = c_; }
    __host__ __device__ bool next(int i, Unit& u) const {
        const long L = (long)i * G + c; if (L >= nwg) return false;
        int wgid = (int)L; { const int q = nwg / NXCD, r = nwg % NXCD, xcd = wgid % NXCD, off = wgid / NXCD; wgid = (xcd < r ? xcd * (q + 1) : r * (q + 1) + (xcd - r) * q) + off; }
        const int nig = WGM * nN, gid = wgid / nig, fm = gid * WGM, gsz = (nM - fm) < WGM ? (nM - fm) : WGM;
        u.pm = fm + ((wgid % nig) % gsz); u.pn = (wgid % nig) / gsz; return true;
    }
    __device__ __forceinline__ void a_ready(const Unit&) const {}
    __device__ __forceinline__ void done(const Unit&) const {}
};
__device__ __forceinline__ unsigned cvt_pk_bf16(float lo, float hi) { unsigned r; asm volatile("v_cvt_pk_bf16_f32 %0, %1, %2" : "=v"(r) : "v"(lo), "v"(hi)); return r; }
typedef float f32x2 __attribute__((ext_vector_type(2)));
__device__ __forceinline__ f32x2 gelu_pk(f32x2 v) {
    const f32x2 av = __builtin_elementwise_abs(v), d = av * 0.2316418882f + 1.0f;
    f32x2 t; t.x = __builtin_amdgcn_rcpf(d.x); t.y = __builtin_amdgcn_rcpf(d.y);
    f32x2 q = t * 0.5307027145f + (-0.7265760135f); q = q * t + 0.7107068705f; q = q * t + (-0.142248368f); q = q * t + 0.127414796f; q = q * t;
    const f32x2 s = (v * v) * (-0.72134752044f);
    f32x2 e; e.x = __builtin_amdgcn_exp2f(s.x); e.y = __builtin_amdgcn_exp2f(s.y);
    const f32x2 m = v * (q * e), r = v - m;
    f32x2 o; o.x = v.x < 0.f ? m.x : r.x; o.y = v.y < 0.f ? m.y : r.y; return o;
}
typedef unsigned u32x2 __attribute__((ext_vector_type(2)));
typedef __bf16 bf16x2_t __attribute__((ext_vector_type(2)));
__device__ __forceinline__ unsigned pk2(float lo, float hi) { f32x2 v = {lo, hi}; bf16x2_t b = __builtin_convertvector(v, bf16x2_t); return __builtin_bit_cast(unsigned, b); }
__device__ __forceinline__ float fast_sigmoid(float x) { return __builtin_amdgcn_rcpf(1.0f + __builtin_amdgcn_exp2f(-1.4426950408889634f * x)); }

__device__ __forceinline__ float row_rs(const float* ss, int r, int fq) { const f32x4 a = *(const f32x4*)(ss + (size_t)r * 16 + 4 * fq);
    float t = (a[0] + a[1]) + (a[2] + a[3]); t += __shfl_xor(t, 16); t += __shfl_xor(t, 32); return __builtin_amdgcn_rsqf(t * (1.0f / 1024.0f) + 1e-6f); }
struct EpiSwiglu {
    static constexpr bool PERM = true, AFTER_DRAIN = false, WIDE = false;
    bf16_t* H; int ldh; const float* ss;
    __device__ __forceinline__ void operator()(const f32x4 (&acc)[2][2][4][2], const Unit& u, int wr, int wc, int fr, int fq) const {
        const int row0 = u.pm * BM + wr * 64 + fr; const int col0 = u.pn * HALF + wc * 32 + 8 * fq;
        float rsv[2][4];
#pragma unroll
        for (int ai = 0; ai < 2; ++ai)
#pragma unroll
            for (int m = 0; m < 4; ++m) rsv[ai][m] = row_rs(ss, row0 + ai * HALF + m * 16, fq);
#pragma unroll
        for (int ai = 0; ai < 2; ++ai)
#pragma unroll
            for (int m = 0; m < 4; ++m) { const int r = row0 + ai * HALF + m * 16; const float rs = rsv[ai][m], rs2 = rs * rs, nl = -1.4426950408889634f * rs;
                unsigned w[4];
#pragma unroll
                for (int n = 0; n < 2; ++n) { const f32x4 g = acc[ai][0][m][n], gu = g * acc[ai][1][m][n] * rs2, ge = g * nl; float hv[4];
#pragma unroll
                    for (int e = 0; e < 4; ++e) hv[e] = gu[e] * __builtin_amdgcn_rcpf(1.0f + __builtin_amdgcn_exp2f(ge[e]));
                    w[2 * n] = pk2(hv[0], hv[1]); w[2 * n + 1] = pk2(hv[2], hv[3]); }
                *(u32x4*)(H + (size_t)r * ldh + col0) = (u32x4){w[0], w[1], w[2], w[3]}; }
    }
};
struct EpiResid {
    static constexpr bool PERM = true, AFTER_DRAIN = false, WIDE = true;
    bf16_t* hi; const bf16_t* lo_in; bf16_t* lo_out;
    float* fout;
    float* ssn; const float* bias; float scale;
    __device__ __forceinline__ void operator()(const f32x4 (&acc)[2][2][4][2], const Unit& u, int wr, int wc, int fr, int fq) const {
        const int row0 = u.pm * BM + wr * 64 + fr; const int col0 = u.pn * BM + wc * 64 + 8 * fq;
        float sacc[2][4];
#pragma unroll
        for (int ai = 0; ai < 2; ++ai)
#pragma unroll
            for (int m = 0; m < 4; ++m) sacc[ai][m] = 0.f;
#pragma unroll
        for (int b = 0; b < 3; ++b) {
            u32x4 rh[6], rl[6];
#pragma unroll
            for (int k = 0; k < 6; ++k) { const int gi = 6 * b + k; if (gi >= 16) break; const int ai = gi >> 3, m = (gi >> 1) & 3, bj = gi & 1;
                const size_t c = (size_t)(row0 + ai * HALF + m * 16) * 1024 + col0 + bj * 32; rh[k] = *(const u32x4*)(hi + c); rl[k] = *(const u32x4*)(lo_in + c); }
#pragma unroll
            for (int k = 0; k < 6; ++k) { const int gi = 6 * b + k; if (gi >= 16) break; const int ai = gi >> 3, m = (gi >> 1) & 3, bj = gi & 1;
                const size_t c = (size_t)(row0 + ai * HALF + m * 16) * 1024 + col0 + bj * 32; const u32x4 h = rh[k], l = rl[k];
                const f32x4 b0 = {__uint_as_float(h.x << 16) + __uint_as_float(l.x << 16), __uint_as_float(h.x & 0xffff0000u) + __uint_as_float(l.x & 0xffff0000u),
                                  __uint_as_float(h.y << 16) + __uint_as_float(l.y << 16), __uint_as_float(h.y & 0xffff0000u) + __uint_as_float(l.y & 0xffff0000u)};
                const f32x4 b1 = {__uint_as_float(h.z << 16) + __uint_as_float(l.z << 16), __uint_as_float(h.z & 0xffff0000u) + __uint_as_float(l.z & 0xffff0000u),
                                  __uint_as_float(h.w << 16) + __uint_as_float(l.w << 16), __uint_as_float(h.w & 0xffff0000u) + __uint_as_float(l.w & 0xffff0000u)};
                f32x4 v0 = b0 + acc[ai][bj][m][0] * scale, v1 = b1 + acc[ai][bj][m][1] * scale;
                if (bias) { v0 += *(const f32x4*)(bias + col0 + bj * 32); v1 += *(const f32x4*)(bias + col0 + bj * 32 + 4); }
                if (fout) { *(f32x4*)(fout + c) = v0; *(f32x4*)(fout + c + 4) = v1; }
                else { const unsigned h0 = pk2(v0[0], v0[1]), h1 = pk2(v0[2], v0[3]), h2 = pk2(v1[0], v1[1]), h3 = pk2(v1[2], v1[3]);
                    const unsigned l0 = pk2(v0[0] - __uint_as_float(h0 << 16), v0[1] - __uint_as_float(h0 & 0xffff0000u)), l1 = pk2(v0[2] - __uint_as_float(h1 << 16), v0[3] - __uint_as_float(h1 & 0xffff0000u)),
                                   l2 = pk2(v1[0] - __uint_as_float(h2 << 16), v1[1] - __uint_as_float(h2 & 0xffff0000u)), l3 = pk2(v1[2] - __uint_as_float(h3 << 16), v1[3] - __uint_as_float(h3 & 0xffff0000u));
                    *(u32x4*)(hi + c) = (u32x4){h0, h1, h2, h3}; *(u32x4*)(lo_out + c) = (u32x4){l0, l1, l2, l3}; }
                sacc[ai][m] += ((v0[0] * v0[0] + v0[1] * v0[1]) + (v0[2] * v0[2] + v0[3] * v0[3])) + ((v1[0] * v1[0] + v1[1] * v1[1]) + (v1[2] * v1[2] + v1[3] * v1[3])); }
        }
#pragma unroll
        for (int ai = 0; ai < 2; ++ai)
#pragma unroll
            for (int m = 0; m < 4; ++m) { float s = sacc[ai][m]; s += __shfl_xor(s, 16); s += __shfl_xor(s, 32);
                if (fq == 0) ssn[(size_t)(row0 + ai * HALF + m * 16) * 16 + u.pn * 4 + wc] = s; }
    }
};
struct EpiBf {
    static constexpr bool PERM = true, AFTER_DRAIN = false, WIDE = true;
    bf16_t* O; int ldc; const float* ss; const float* bias; int mode;
    __device__ __forceinline__ void operator()(const f32x4 (&acc)[2][2][4][2], const Unit& u, int wr, int wc, int fr, int fq) const {
        const int row0 = u.pm * BM + wr * 64 + fr; const int col0 = u.pn * BM + wc * 64 + 8 * fq;
        const int seg = (mode == 1) ? (u.pn >> 1) : 3;
        f32x4 bv[2][2];
#pragma unroll
        for (int bj = 0; bj < 2; ++bj)
#pragma unroll
            for (int n = 0; n < 2; ++n) bv[bj][n] = bias ? *(const f32x4*)(bias + col0 + bj * 32 + 4 * n) : (f32x4){0.f, 0.f, 0.f, 0.f};
        float rsv[2][4];
#pragma unroll
        for (int ai = 0; ai < 2; ++ai)
#pragma unroll
            for (int m = 0; m < 4; ++m) rsv[ai][m] = ss ? row_rs(ss, row0 + ai * HALF + m * 16, fq) : 1.0f;
#pragma unroll
        for (int ai = 0; ai < 2; ++ai)
#pragma unroll
            for (int m = 0; m < 4; ++m) { const int r = row0 + ai * HALF + m * 16; const float rs = rsv[ai][m];
                bf16_t* rowp = O + (size_t)r * ldc + col0;
#pragma unroll
                for (int bj = 0; bj < 2; ++bj) { f32x4 v0 = acc[ai][bj][m][0] * rs + bv[bj][0], v1 = acc[ai][bj][m][1] * rs + bv[bj][1];
                    if (seg < 2) { const float sc = (seg == 0) ? 0.60653065971263342f : 1.0f;
#pragma unroll
                        for (int e = 0; e < 4; ++e) { v0[e] = sc * fast_sigmoid(v0[e]); v1[e] = sc * fast_sigmoid(v1[e]); } }
                    *(u32x4*)(rowp + bj * 32) = (u32x4){pk2(v0[0], v0[1]), pk2(v0[2], v0[3]), pk2(v1[0], v1[1]), pk2(v1[2], v1[3])}; } }
    }
};

template <class Epi, class Sched, bool ALIGN_EPI = false, bool SP2 = false>
__device__ __forceinline__ void gemm_phase(PG8_LAS unsigned char* lds, const Gemm g, const Sched& S, const Epi& E, const int tid_) {
    const int tid = tid_, wid = __builtin_amdgcn_readfirstlane(tid >> 6), lane = tid & 63, wr = wid >> 2, wc = wid & 3, fr = lane & 15, fq = lane >> 4;
    const int K = g.K, nt = K / BK;
    unsigned voffA[2], voffB[2];
#pragma unroll
    for (int i = 0; i < 2; ++i) { int R, C; stage_rc(tid * 16 + i * 8192, R, C); const int Rb = Epi::WIDE ? (64 * (R >> 5) + (Epi::PERM ? perm32(R & 31) : (R & 31))) : (Epi::PERM ? ((R & ~31) + perm32(R & 31)) : R);
        voffA[i] = (unsigned)(R * K + C) * 2u; voffB[i] = (unsigned)(Rb * K + C) * 2u; }
    const size_t kstep = (size_t)(BK * 2);
    const size_t hstep = (size_t)HALF * K * 2;
    const size_t tstep = 2 * hstep;
    const size_t hstepB = Epi::WIDE ? (size_t)32 * K * 2 : hstep;
    const unsigned ldsw = (unsigned)wid * 1024u;
    const int aoff = lds_byte(wr * 64 + fr, fq * 8), boff = lds_byte(wc * 32 + fr, fq * 8);
#define PG8_SA(b, h) (((b) * 2 + (h)) * HTB)
#define PG8_SB(b, h) ((4 + (b) * 2 + (h)) * HTB)
#define PG8_STAGE(bufoff, gbase, voff) do { _Pragma("unroll") for (int _i = 0; _i < 2; ++_i) \
        __builtin_amdgcn_global_load_lds((const unsigned*)((const char*)(gbase) + (voff)[_i]), (PG8_LAS unsigned*)(lds + (bufoff) + ldsw + _i * 8192), 16, 0, 0); } while (0)
#define PG8_LDA(dst, b, h) do { _Pragma("unroll") for (int m = 0; m < 4; ++m) _Pragma("unroll") for (int k = 0; k < 2; ++k) dst[m][k] = *(const PG8_LAS bf16x8*)(lds + PG8_SA(b, h) + aoff + m * 2048 + k * 1024); } while (0)
#define PG8_LDB(dst, b, h) do { _Pragma("unroll") for (int n = 0; n < 2; ++n) _Pragma("unroll") for (int k = 0; k < 2; ++k) dst[n][k] = *(const PG8_LAS bf16x8*)(lds + PG8_SB(b, h) + boff + n * 2048 + k * 1024); } while (0)
#define PG8_MMA(ai, bj, At, Bt) do { __builtin_amdgcn_s_setprio(1); _Pragma("unroll") for (int m = 0; m < 4; ++m) _Pragma("unroll") for (int n = 0; n < 2; ++n) _Pragma("unroll") for (int k = 0; k < 2; ++k) \
        acc[ai][bj][m][n] = __builtin_amdgcn_mfma_f32_16x16x32_bf16(Bt[n][k], At[m][k], acc[ai][bj][m][n], 0, 0, 0); __builtin_amdgcn_s_setprio(0); } while (0)
#define PG8_WAIT_V(n) asm volatile("s_waitcnt vmcnt(" #n ")" ::: "memory")
#define PG8_WAIT_L(n) asm volatile("s_waitcnt lgkmcnt(" #n ")" ::: "memory")
#define PG8_BAR __builtin_amdgcn_s_barrier()
#define PG8_SCHED __builtin_amdgcn_sched_barrier(0)
    Unit cur, nxt; int ui = 0;
    if (!S.next(0, cur)) return;
    f32x4 acc[2][2][4][2];
#pragma unroll
    for (int a = 0; a < 2; ++a)
#pragma unroll
        for (int b = 0; b < 2; ++b)
#pragma unroll
            for (int m = 0; m < 4; ++m)
#pragma unroll
                for (int n = 0; n < 2; ++n) acc[a][b][m][n] = (f32x4){0.f, 0.f, 0.f, 0.f};
    bf16x8 At[4][2], B0[2][2], B1[2][2];
    const char* cA = (const char*)g.A + (size_t)cur.pm * tstep; const char* cB = (const char*)g.Bt + (size_t)cur.pn * tstep;
    S.a_ready(cur);
    if constexpr (SP2) {
        PG8_STAGE(PG8_SB(0, 0), cB, voffB); PG8_STAGE(PG8_SB(0, 1), cB + hstepB, voffB); PG8_STAGE(PG8_SA(0, 0), cA, voffA); PG8_STAGE(PG8_SA(0, 1), cA + hstep, voffA);
        if (wr == 1) PG8_BAR;
        PG8_WAIT_V(2); PG8_BAR;
        PG8_STAGE(PG8_SB(1, 0), cB + kstep, voffB); PG8_STAGE(PG8_SA(1, 0), cA + kstep, voffA); PG8_STAGE(PG8_SB(1, 1), cB + hstepB + kstep, voffB);
        PG8_WAIT_V(6); PG8_BAR;
    } else {
        PG8_STAGE(PG8_SB(0, 0), cB, voffB); PG8_STAGE(PG8_SA(0, 0), cA, voffA); PG8_STAGE(PG8_SB(0, 1), cB + hstepB, voffB); PG8_STAGE(PG8_SA(0, 1), cA + hstep, voffA);
        if (wr == 1) PG8_BAR;
        PG8_WAIT_V(4); PG8_BAR;
        PG8_STAGE(PG8_SB(1, 0), cB + kstep, voffB); PG8_STAGE(PG8_SA(1, 0), cA + kstep, voffA); PG8_STAGE(PG8_SB(1, 1), cB + hstepB + kstep, voffB);
        PG8_WAIT_V(6); PG8_BAR;
    }
    for (;;) {
        const bool has_next = S.next(ui + 1, nxt);
        const char* nA = has_next ? (const char*)g.A + (size_t)nxt.pm * tstep : cA; const char* nB = has_next ? (const char*)g.Bt + (size_t)nxt.pn * tstep : cB;
        for (int t = 0; t < nt; t += 2) {
            const bool last = (t == nt - 2);
            const char* a1 = cA + (size_t)(t + 1) * kstep;
            const char* a2 = last ? nA : cA + (size_t)(t + 2) * kstep; const char* b2 = last ? nB : cB + (size_t)(t + 2) * kstep;
            const char* a3 = a2 + kstep; const char* b3 = b2 + kstep;
            if (last && has_next) S.a_ready(nxt);
            if constexpr (SP2) {
            PG8_LDB(B0, 0, 0); PG8_LDB(B1, 0, 1); PG8_SCHED; PG8_LDA(At, 0, 0); PG8_STAGE(PG8_SA(1, 1), a1 + hstep, voffA);
            PG8_WAIT_V(8); PG8_WAIT_L(0); PG8_BAR; PG8_MMA(0, 0, At, B0); PG8_MMA(0, 1, At, B1); PG8_BAR; PG8_SCHED;
            PG8_LDA(At, 0, 1); PG8_STAGE(PG8_SB(0, 0), b2, voffB); PG8_STAGE(PG8_SB(0, 1), b2 + hstepB, voffB); PG8_STAGE(PG8_SA(0, 0), a2, voffA);
            PG8_WAIT_V(8); PG8_WAIT_L(0); PG8_BAR; PG8_MMA(1, 0, At, B0); PG8_MMA(1, 1, At, B1); PG8_BAR; PG8_SCHED;
            PG8_LDB(B0, 1, 0); PG8_LDB(B1, 1, 1); PG8_SCHED; PG8_LDA(At, 1, 0); PG8_STAGE(PG8_SA(0, 1), a2 + hstep, voffA);
            PG8_WAIT_V(8); PG8_WAIT_L(0); PG8_BAR; PG8_MMA(0, 0, At, B0); PG8_MMA(0, 1, At, B1); PG8_BAR; PG8_SCHED;
            PG8_LDA(At, 1, 1); PG8_STAGE(PG8_SB(1, 0), b3, voffB); PG8_STAGE(PG8_SB(1, 1), b3 + hstepB, voffB); PG8_STAGE(PG8_SA(1, 0), a3, voffA);
            PG8_WAIT_V(8); PG8_WAIT_L(0); PG8_BAR; PG8_MMA(1, 0, At, B0); PG8_MMA(1, 1, At, B1); PG8_BAR; PG8_SCHED;
            } else {
            PG8_LDB(B0, 0, 0); PG8_SCHED; PG8_LDA(At, 0, 0); PG8_STAGE(PG8_SA(1, 1), a1 + hstep, voffA);
            PG8_WAIT_L(8); PG8_BAR; PG8_WAIT_L(0); PG8_MMA(0, 0, At, B0); PG8_BAR; PG8_SCHED;
            PG8_LDB(B1, 0, 1); PG8_STAGE(PG8_SB(0, 0), b2, voffB);
            PG8_BAR; PG8_WAIT_L(0); PG8_MMA(0, 1, At, B1); PG8_BAR;
            PG8_LDA(At, 0, 1); PG8_STAGE(PG8_SA(0, 0), a2, voffA);
            PG8_BAR; PG8_WAIT_L(0); PG8_MMA(1, 0, At, B0); PG8_BAR; PG8_SCHED;
            PG8_STAGE(PG8_SB(0, 1), b2 + hstepB, voffB);
            PG8_WAIT_V(6); PG8_BAR; PG8_MMA(1, 1, At, B1); PG8_BAR;
            PG8_LDB(B0, 1, 0); PG8_SCHED; PG8_LDA(At, 1, 0); PG8_STAGE(PG8_SA(0, 1), a2 + hstep, voffA);
            PG8_WAIT_L(8); PG8_BAR; PG8_WAIT_L(0); PG8_MMA(0, 0, At, B0); PG8_BAR; PG8_SCHED;
            PG8_LDB(B1, 1, 1); PG8_STAGE(PG8_SB(1, 0), b3, voffB);
            PG8_BAR; PG8_WAIT_L(0); PG8_MMA(0, 1, At, B1); PG8_BAR;
            PG8_LDA(At, 1, 1); PG8_STAGE(PG8_SA(1, 0), a3, voffA);
            PG8_BAR; PG8_WAIT_L(0); PG8_MMA(1, 0, At, B0); PG8_BAR; PG8_SCHED;
            PG8_STAGE(PG8_SB(1, 1), b3 + hstepB, voffB);
            PG8_WAIT_V(6); PG8_BAR; PG8_MMA(1, 1, At, B1); PG8_BAR;
            }
        }
        if constexpr (ALIGN_EPI) { if (wr == 0) PG8_BAR; }
        if constexpr (!Epi::AFTER_DRAIN) { E(acc, cur, wr, wc, fr, fq); S.done(cur); }
        if (!has_next) break;
#pragma unroll
        for (int a = 0; a < 2; ++a)
#pragma unroll
            for (int b = 0; b < 2; ++b)
#pragma unroll
                for (int m = 0; m < 4; ++m)
#pragma unroll
                    for (int n = 0; n < 2; ++n) acc[a][b][m][n] = (f32x4){0.f, 0.f, 0.f, 0.f};
        cur = nxt; cA = nA; cB = nB; ++ui;
        if constexpr (ALIGN_EPI) { if (wr == 1) PG8_BAR; }
    }
    PG8_WAIT_V(0);
    if constexpr (!ALIGN_EPI) { if (wr == 0) PG8_BAR; }
    PG8_BAR;
    if constexpr (Epi::AFTER_DRAIN) { E.fused(acc, cur, wr, wc, fr, fq, lds, wid, lane); S.done(cur); }
#undef PG8_SA
#undef PG8_SB
#undef PG8_STAGE
#undef PG8_LDA
#undef PG8_LDB
#undef PG8_MMA
#undef PG8_WAIT_V
#undef PG8_WAIT_L
#undef PG8_BAR
#undef PG8_SCHED
}
}
namespace cg = cooperative_groups;
#define LAS __attribute__((address_space(3)))
using pg8::bf16_t; using pg8::bf16x8; using pg8::f32x4; using pg8::u32x4; using pg8::f32x2; using pg8::u32x2; using pg8::pk2; using pg8::fast_sigmoid;

constexpr int M = 65536, T = 4096, D = 1024, FF = 2816, ZC = 2816, QKVC = 1536, LOC = 1536, LAC = 256;
constexpr size_t MiB = (size_t)1 << 20;
constexpr size_t WS_SS = 1 * MiB;
constexpr size_t WS_LB = 5 * MiB;
constexpr size_t WS_RKB = 6 * MiB;
constexpr size_t WS_ROPE = 8 * MiB;
constexpr size_t WS_W = 24 * MiB;
constexpr size_t FFN_STRIDE = 16 * MiB + MiB / 2, WD_OFF = 11 * MiB;
constexpr size_t WS_WMIX = WS_W + 8 * FFN_STRIDE;
constexpr size_t EVEN_STRIDE = 8 * MiB + MiB / 4, WOUT_OFF = 5 * MiB + MiB / 2, WLORA_OFF = 7 * MiB + MiB / 2;
constexpr size_t WS_WODD = WS_WMIX + 2 * EVEN_STRIDE, ODD_STRIDE = 5 * MiB, WO_OFF = 3 * MiB;
constexpr size_t WS_XB = 184 * MiB;
constexpr size_t OUT_XL = 0, OUT_LA = 128 * MiB, OUT_YRAW = 160 * MiB;
constexpr size_t WS_HZ = 312 * MiB;
constexpr size_t WS_Y = 664 * MiB;
constexpr size_t WS_LO = 792 * MiB;
constexpr size_t WS_END = 984 * MiB;
static_assert(WS_WODD + 2 * ODD_STRIDE <= WS_XB, "ws map");
constexpr int LDS_BYTES = 147456;

struct Args {
    const float* x; const int* pos;
    const float *f1n, *f1g, *f1u, *f1d, *mixn, *f2n, *f2g, *f2u, *f2d;
    const float *win, *mu, *w0, *wdec, *a0, *waaa, *wgate, *kk, *ka, *rk, *gng, *gnb, *lng, *lnb, *wsp, *bsp, *wout;
    const float *wqkv, *bqkv, *qn, *kn, *sinks, *wo, *bo;
    float* out; unsigned char* ws;
    float inv_freq[32];
    int ph_lo, ph_hi;
};

#define KAS __attribute__((address_space(4)))
__device__ __forceinline__ const KAS Args* kargs(int off) { return (const KAS Args*)((const KAS char*)__builtin_amdgcn_kernarg_segment_ptr() + off); }
__device__ __forceinline__ float bf2f(unsigned short h) { return __uint_as_float((unsigned)h << 16); }
__device__ __forceinline__ float bflo(unsigned w) { return __uint_as_float(w << 16); }
__device__ __forceinline__ float bfhi(unsigned w) { return __uint_as_float(w & 0xffff0000u); }
__device__ __forceinline__ void unpack8(const u32x4 w, float (&f)[8]) { f[0] = bflo(w.x); f[1] = bfhi(w.x); f[2] = bflo(w.y); f[3] = bfhi(w.y); f[4] = bflo(w.z); f[5] = bfhi(w.z); f[6] = bflo(w.w); f[7] = bfhi(w.w); }
__device__ __forceinline__ u32x4 pack8(const float (&f)[8]) { return (u32x4){pk2(f[0], f[1]), pk2(f[2], f[3]), pk2(f[4], f[5]), pk2(f[6], f[7])}; }
__device__ __forceinline__ float wave_sum(float v) {
#pragma unroll
    for (int o = 1; o < 64; o <<= 1) v += __shfl_xor(v, o);
    return v;
}
template <int CTRL> __device__ __forceinline__ float dpp_mov(float x) { return __int_as_float(__builtin_amdgcn_update_dpp(0, __float_as_int(x), CTRL, 0xF, 0xF, false)); }
__device__ __forceinline__ float row16_sum(float x) { x += dpp_mov<0xB1>(x); x += dpp_mov<0x4E>(x); x += dpp_mov<0x124>(x); x += dpp_mov<0x128>(x); return x; }
__device__ __forceinline__ float row16_max(float x) { x = fmaxf(x, dpp_mov<0xB1>(x)); x = fmaxf(x, dpp_mov<0x4E>(x)); x = fmaxf(x, dpp_mov<0x124>(x)); x = fmaxf(x, dpp_mov<0x128>(x)); return x; }
__device__ __forceinline__ float wave_sum_dpp(float x) { x = row16_sum(x);
    return __int_as_float(__builtin_amdgcn_readlane(__float_as_int(x), 0)) + __int_as_float(__builtin_amdgcn_readlane(__float_as_int(x), 16)) + (__int_as_float(__builtin_amdgcn_readlane(__float_as_int(x), 32)) + __int_as_float(__builtin_amdgcn_readlane(__float_as_int(x), 48))); }
#define LDS_FENCE() asm volatile("s_waitcnt lgkmcnt(0)" ::: "memory")

__device__ __forceinline__ void tr_item(const float* W, int N, const float* gk, bf16_t* WT, int ldk, int drow, int k0, int n0, LAS float* scr, int lane) {
    f32x4 v[8];
#pragma unroll
    for (int i = 0; i < 8; ++i) { const int kk = 8 * i + (lane >> 3); v[i] = *(const f32x4*)(W + (size_t)(k0 + kk) * N + n0 + 4 * (lane & 7)); }
#pragma unroll
    for (int i = 0; i < 8; ++i) { const int kk = 8 * i + (lane >> 3); const float g = gk ? gk[k0 + kk] : 1.0f; *(LAS f32x4*)(scr + kk * 36 + 4 * (lane & 7)) = v[i] * g; }
    LDS_FENCE();
    const int c = lane & 7;
#pragma unroll
    for (int j = 0; j < 4; ++j) { const int n = (lane >> 3) + 8 * j; const LAS float* s = scr + (8 * c) * 36 + n;
        u32x4 o; o.x = pk2(s[0 * 36], s[1 * 36]); o.y = pk2(s[2 * 36], s[3 * 36]); o.z = pk2(s[4 * 36], s[5 * 36]); o.w = pk2(s[6 * 36], s[7 * 36]);
        *(u32x4*)(WT + (size_t)(drow + n) * ldk + k0 + 8 * c) = o; }
    LDS_FENCE();
}
__device__ __forceinline__ void prologue(const KAS Args& a, LAS unsigned char* lds, const int tid_, const int bid, const int nblk) {
    unsigned char* ws = a.ws;
    const int tid = tid_, lane = tid & 63, wave = tid >> 6;
    LAS float* scr = (LAS float*)(lds + wave * 16384);
    const int gw = bid * 8 + wave, NGW = nblk * 8;
    const int gt = bid * 512 + tid, NGT = nblk * 512;
    constexpr int I_GU = 16 * 88, I_DN = 44 * 32, I_FFN = 2 * I_GU + I_DN, N_FFN = 8 * I_FFN;
    constexpr int I_IN = 16 * 88, I_OUT = 16 * 32, I_QKV = 16 * 48, I_O = 16 * 32, I_MIX = I_IN + I_OUT + I_QKV + I_O;
    for (int it = gw; it < N_FFN + 2 * I_MIX; it += NGW) {
        if (it < N_FFN) {
            const int f = it / I_FFN, r = it % I_FFN, l = f >> 1, second = f & 1;
            bf16_t* wgu = (bf16_t*)(ws + WS_W + (size_t)f * FFN_STRIDE); bf16_t* wd = (bf16_t*)(ws + WS_W + (size_t)f * FFN_STRIDE + WD_OFF);
            if (r < 2 * I_GU) { const int part = r / I_GU, loc = r % I_GU, kb = loc / 88, nb = loc % 88, n0 = 32 * nb;
                const float* src = (part == 0 ? (second ? a.f2g : a.f1g) : (second ? a.f2u : a.f1u)) + (size_t)l * D * FF;
                const float* gk = (second ? a.f2n : a.f1n) + l * D;
                tr_item(src, FF, gk, wgu, D, (n0 >> 7) * 256 + (n0 & 127) + part * 128, 64 * kb, n0, scr, lane);
            } else { const int loc = r - 2 * I_GU, kb = loc / 32, nb = loc % 32;
                const float* src = (second ? a.f2d : a.f1d) + (size_t)l * FF * D;
                tr_item(src, D, nullptr, wd, FF, 32 * nb, 64 * kb, 32 * nb, scr, lane); }
        } else {
            const int r = it - N_FFN, i = r / I_MIX, q = r % I_MIX;
            if (q < I_IN) { const int kb = q / 88, nb = q % 88;
                tr_item(a.win + (size_t)i * D * ZC, ZC, a.mixn + (2 * i) * D, (bf16_t*)(ws + WS_WMIX + i * EVEN_STRIDE), D, 32 * nb, 64 * kb, 32 * nb, scr, lane);
            } else if (q < I_IN + I_OUT) { const int loc = q - I_IN, kb = loc / 32, nb = loc % 32;
                tr_item(a.wout + (size_t)i * D * D, D, nullptr, (bf16_t*)(ws + WS_WMIX + i * EVEN_STRIDE + WOUT_OFF), D, 32 * nb, 64 * kb, 32 * nb, scr, lane);
            } else if (q < I_IN + I_OUT + I_QKV) { const int loc = q - I_IN - I_OUT, kb = loc / 48, nb = loc % 48;
                tr_item(a.wqkv + (size_t)i * D * QKVC, QKVC, a.mixn + (2 * i + 1) * D, (bf16_t*)(ws + WS_WODD + i * ODD_STRIDE), D, 32 * nb, 64 * kb, 32 * nb, scr, lane);
            } else { const int loc = q - I_IN - I_OUT - I_QKV, kb = loc / 32, nb = loc % 32;
                tr_item(a.wo + (size_t)i * D * D, D, nullptr, (bf16_t*)(ws + WS_WODD + i * ODD_STRIDE + WO_OFF), D, 32 * nb, 64 * kb, 32 * nb, scr, lane); }
        }
    }
    for (int idx = gt; idx < 2 * LOC * LAC; idx += NGT) {
        const int i = idx / (LOC * LAC), e = idx % (LOC * LAC), n = e / LAC, k = e % LAC, seg = n >> 9, nn = n & 511;
        float v = 0.f;
        if (seg == 0) { if (k < 64) v = a.wdec[(size_t)i * 64 * 512 + k * 512 + nn]; }
        else if (seg == 1) { if (k >= 64 && k < 128) v = a.waaa[(size_t)i * 64 * 512 + (k - 64) * 512 + nn]; }
        else { if (k >= 128) v = a.wgate[(size_t)i * 128 * 512 + (k - 128) * 512 + nn]; }
        ((bf16_t*)(ws + WS_WMIX + i * EVEN_STRIDE + WLORA_OFF))[e] = (bf16_t)(pk2(v, 0.f) & 0xffffu);
    }
    for (int idx = gt; idx < 2 * LOC; idx += NGT) { const int i = idx / LOC, n = idx % LOC;
        ((float*)(ws + WS_LB))[idx] = (n < 512) ? a.w0[i * 512 + n] : (n < 1024 ? a.a0[i * 512 + n - 512] : 0.f); }
    { bf16_t* xb = (bf16_t*)(ws + WS_XB); bf16_t* xl = (bf16_t*)((unsigned char*)a.out + OUT_XL); float* ss0 = (float*)(ws + WS_SS);
      for (int mb = gw; mb < M; mb += 2 * NGW) { f32x4 v[2][4]; const int m1 = (mb + NGW < M) ? mb + NGW : mb;
#pragma unroll
          for (int j = 0; j < 4; ++j) { v[0][j] = ((const f32x4*)(a.x + (size_t)mb * D) + lane)[64 * j]; v[1][j] = ((const f32x4*)(a.x + (size_t)m1 * D) + lane)[64 * j]; }
#pragma unroll
          for (int k = 0; k < 2; ++k) { const int m = k ? m1 : mb; if (k && m1 == mb) break; float s = 0.f;
#pragma unroll
              for (int j = 0; j < 4; ++j) { const f32x4 w = v[k][j]; s += (w[0] * w[0] + w[1] * w[1]) + (w[2] * w[2] + w[3] * w[3]);
                  const unsigned h01 = pk2(w[0], w[1]), h23 = pk2(w[2], w[3]);
                  const unsigned l01 = pk2(w[0] - bflo(h01), w[1] - bfhi(h01)), l23 = pk2(w[2] - bflo(h23), w[3] - bfhi(h23));
                  *(u32x2*)(xb + (size_t)m * D + 4 * (lane + 64 * j)) = (u32x2){h01, h23}; *(u32x2*)(xl + (size_t)m * D + 4 * (lane + 64 * j)) = (u32x2){l01, l23}; }
              s = wave_sum(s); if (lane < 16) ss0[(size_t)m * 16 + lane] = (lane == 0) ? s : 0.f; } } }
    { float* tab = (float*)(ws + WS_ROPE);
      for (int idx = gt; idx < M * 32; idx += NGT) { const int m = idx >> 5, d = idx & 31; const float ang = (float)a.pos[m] * a.inv_freq[d];
          const double rev = (double)ang * 0.15915494309189535; const float fr = (float)(rev - __builtin_rint(rev));
          tab[(size_t)m * 64 + d] = __builtin_amdgcn_cosf(fr); tab[(size_t)m * 64 + 32 + d] = __builtin_amdgcn_sinf(fr); } }
}

__device__ __forceinline__ void el_phase(const KAS Args& a, int i, const int tid_, const int bid, const int nblk) {
    const bf16_t* Z = (const bf16_t*)(a.ws + WS_HZ); bf16_t* LA = (bf16_t*)((unsigned char*)a.out + OUT_LA);
    const float* mu = a.mu + i * 1792 + 1536;
    const int gt = bid * 512 + tid_, NGT = nblk * 512;
    for (int ib = gt; ib < M * 32; ib += 4 * NGT) { u32x4 rc[4], rp[4];
#pragma unroll
        for (int k = 0; k < 4; ++k) { const int idx = ib + k * NGT; const int ii = idx < M * 32 ? idx : ib; const int m = ii >> 5, c0 = (ii & 31) * 8, t = m & (T - 1);
            rc[k] = *(const u32x4*)(Z + (size_t)m * ZC + 1536 + c0); rp[k] = (t > 0) ? *(const u32x4*)(Z + (size_t)(m - 1) * ZC + 1536 + c0) : (u32x4){0u, 0u, 0u, 0u}; }
#pragma unroll
        for (int k = 0; k < 4; ++k) { const int idx = ib + k * NGT; if (idx >= M * 32) break; const int m = idx >> 5, c0 = (idx & 31) * 8;
            float zc[8], zp[8], o[8]; unpack8(rc[k], zc); unpack8(rp[k], zp);
#pragma unroll
            for (int e = 0; e < 8; ++e) { const float z = zc[e] + (zp[e] - zc[e]) * mu[c0 + e];
                o[e] = (c0 < 64) ? (2.0f * fast_sigmoid(2.0f * z) - 1.0f) : (c0 < 128 ? z : fast_sigmoid(z)); }
            *(u32x4*)(LA + (size_t)m * LAC + c0) = pack8(o); } }
}

constexpr int TC = 32, SST = 352;
__device__ __forceinline__ void scan_load(const bf16_t* Z, const bf16_t* LO, size_t mrow0, int t0, int tid, int colb, u32x2 (&pz)[8]) {
    const int t = t0 + (tid >> 4); const size_t m = mrow0 + t; const bf16_t* zr = Z + m * ZC + colb; const bf16_t* lo = LO + m * LOC + colb;
    pz[0] = *(const u32x2*)(zr); pz[1] = *(const u32x2*)(zr + 512); pz[2] = *(const u32x2*)(zr + 1024);
    if (t > 0) { pz[3] = *(const u32x2*)(zr - ZC); pz[4] = *(const u32x2*)(zr + 512 - ZC); pz[5] = *(const u32x2*)(zr + 1024 - ZC); } else { pz[3] = (u32x2){0u, 0u}; pz[4] = (u32x2){0u, 0u}; pz[5] = (u32x2){0u, 0u}; }
    pz[6] = *(const u32x2*)(lo); pz[7] = *(const u32x2*)(lo + 512);
}
__device__ __forceinline__ void up4(const u32x2 w, float (&f)[4]) { f[0] = bflo(w.x); f[1] = bfhi(w.x); f[2] = bflo(w.y); f[3] = bfhi(w.y); }
__device__ __forceinline__ void scan_stage(const u32x2 (&pz)[8], LAS float* buf, float* RKB, size_t mrow0, int t0, int tid, int h, int half,
                                           const float (&mu_r)[4], const float (&mu_k)[4], const float (&mu_v)[4], const float (&kkc)[4], const float (&kac)[4], const float (&rkc)[4]) {
    const int tl = tid >> 4, cgp = tid & 15;
    float zr[4], zk[4], zv[4], zrp[4], zkp[4], zvp[4], ew[4], ic[4];
    up4(pz[0], zr); up4(pz[1], zk); up4(pz[2], zv); up4(pz[3], zrp); up4(pz[4], zkp); up4(pz[5], zvp); up4(pz[6], ew); up4(pz[7], ic);
    f32x4 r, k2, v, kkv, w; float n2 = 0.f, rkb = 0.f;
#pragma unroll
    for (int e = 0; e < 4; ++e) { r[e] = zr[e] + (zrp[e] - zr[e]) * mu_r[e]; const float k = zk[e] + (zkp[e] - zk[e]) * mu_k[e]; v[e] = zv[e] + (zvp[e] - zv[e]) * mu_v[e];
        kkv[e] = k * kkc[e]; n2 += kkv[e] * kkv[e]; k2[e] = k * (1.0f + (ic[e] - 1.0f) * kac[e]); w[e] = __builtin_amdgcn_exp2f(-1.4426950408889634f * ew[e]); rkb += r[e] * k2[e] * rkc[e]; }
    n2 = row16_sum(n2); rkb = row16_sum(rkb);
    const float inv = __builtin_amdgcn_rsqf(fmaxf(n2, 1e-24f));
    const f32x4 kkn = kkv * inv; f32x4 nb;
#pragma unroll
    for (int e = 0; e < 4; ++e) nb[e] = -kkn[e] * ic[e];
    if (half == 0 && cgp == 0) RKB[(mrow0 + t0 + tl) * 8 + h] = rkb;
    LAS float* sb = buf + tl * SST + 4 * cgp;
    *(LAS f32x4*)(sb) = kkn; *(LAS f32x4*)(sb + 64) = nb; *(LAS f32x4*)(sb + 128) = w; *(LAS f32x4*)(sb + 192) = k2; *(LAS f32x4*)(sb + 256) = r;
    if ((cgp >> 3) == half) *(LAS f32x4*)(buf + tl * SST + 320 + 4 * (cgp & 7)) = v;
}
__device__ __forceinline__ void scan_phase(const KAS Args& a, LAS unsigned char* lds, int i, const int tid_, const int bid, const int nblk) {
    const int tid = tid_, lane = tid & 63, wave = __builtin_amdgcn_readfirstlane(tid >> 6);
    const bf16_t* Z = (const bf16_t*)(a.ws + WS_HZ); const bf16_t* LO = (const bf16_t*)(a.ws + WS_LO);
    bf16_t* YR = (bf16_t*)((unsigned char*)a.out + OUT_YRAW); float* RKB = (float*)(a.ws + WS_RKB);
    LAS float* bufs = (LAS float*)lds; LAS float* ybuf = bufs + 2 * TC * SST;
    for (int unit = bid; unit < 256; unit += nblk) {
        const int bh = unit >> 1, half = unit & 1, b = bh >> 3, h = bh & 7, colb = h * 64 + 4 * (tid & 15);
        float mu_r[4], mu_k[4], mu_v[4], kkc[4], kac[4], rkc[4];
#pragma unroll
        for (int e = 0; e < 4; ++e) { mu_r[e] = a.mu[i * 1792 + colb + e]; mu_k[e] = a.mu[i * 1792 + 512 + colb + e]; mu_v[e] = a.mu[i * 1792 + 1024 + colb + e];
            kkc[e] = a.kk[i * 512 + colb + e]; kac[e] = a.ka[i * 512 + colb + e]; rkc[e] = a.rk[i * 512 + colb + e]; }
        const size_t mrow0 = (size_t)b * T;
        const int rl = wave * 4 + (lane >> 4), cgp = lane & 15;
        f32x4 S = {0.f, 0.f, 0.f, 0.f};
        u32x2 pz[8];
        __syncthreads();
        scan_load(Z, LO, mrow0, 0, tid, colb, pz);
        scan_stage(pz, bufs, RKB, mrow0, 0, tid, h, half, mu_r, mu_k, mu_v, kkc, kac, rkc);
        __syncthreads();
        for (int c = 0; c < T / TC; ++c) {
            const bool more = (c + 1 < T / TC);
            if (more) scan_load(Z, LO, mrow0, (c + 1) * TC, tid, colb, pz);
            const LAS float* buf = bufs + (c & 1) * (TC * SST); LAS float* yb = ybuf + (c & 1) * (TC * 32);
            {
                const LAS float* sb = buf + 4 * cgp; const LAS float* vb = buf + 320 + rl;
                f32x4 kk4 = *(const LAS f32x4*)(sb), nb4 = *(const LAS f32x4*)(sb + 64), w4 = *(const LAS f32x4*)(sb + 128), k4 = *(const LAS f32x4*)(sb + 192), r4 = *(const LAS f32x4*)(sb + 256);
                float v = vb[0], ysel = 0.f;
#pragma unroll
                for (int t = 0; t < TC; ++t) {
                    f32x4 kk4n = kk4, nb4n = nb4, w4n = w4, k4n = k4, r4n = r4; float vn = v;
                    if (t + 1 < TC) { const LAS float* sn = sb + (t + 1) * SST;
                        kk4n = *(const LAS f32x4*)(sn); nb4n = *(const LAS f32x4*)(sn + 64); w4n = *(const LAS f32x4*)(sn + 128); k4n = *(const LAS f32x4*)(sn + 192); r4n = *(const LAS f32x4*)(sn + 256); vn = vb[(t + 1) * SST]; }
                    __builtin_amdgcn_sched_barrier(0x6);
                    float sa = fmaf(S[3], kk4[3], fmaf(S[2], kk4[2], fmaf(S[1], kk4[1], S[0] * kk4[0])));
                    const f32x4 Tm = S * w4 + k4 * v;
                    sa = row16_sum(sa);
                    S = Tm + nb4 * sa;
                    float y = fmaf(S[3], r4[3], fmaf(S[2], r4[2], fmaf(S[1], r4[1], S[0] * r4[0]))); y = row16_sum(y);
                    ysel = (cgp == (t & 15)) ? y : ysel;
                    if ((t & 15) == 15) yb[(t - 15 + cgp) * 32 + rl] = ysel;
                    kk4 = kk4n; nb4 = nb4n; w4 = w4n; k4 = k4n; r4 = r4n; v = vn; }
            }
            if (more) scan_stage(pz, bufs + ((c + 1) & 1) * (TC * SST), RKB, mrow0, (c + 1) * TC, tid, h, half, mu_r, mu_k, mu_v, kkc, kac, rkc);
            __syncthreads();
#pragma unroll
            for (int q = 0; q < 2; ++q) { const int idx = tid + 512 * q, t = idx >> 5, r = idx & 31;
                YR[(mrow0 + c * TC + t) * 512 + h * 64 + half * 32 + r] = (bf16_t)(pk2(yb[t * 32 + r], 0.f) & 0xffffu); }
        }
    }
}

__device__ __forceinline__ void post_phase(const KAS Args& a, LAS unsigned char* lds, int i, const int tid_, const int bid, const int nblk) {
    const int tid = tid_, lane = tid & 63, wave = __builtin_amdgcn_readfirstlane(tid >> 6);
    const bf16_t* Z = (const bf16_t*)(a.ws + WS_HZ); const bf16_t* LO = (const bf16_t*)(a.ws + WS_LO); const bf16_t* YR = (const bf16_t*)((unsigned char*)a.out + OUT_YRAW);
    const float* RKB = (const float*)(a.ws + WS_RKB); bf16_t* Y = (bf16_t*)(a.ws + WS_Y);
    { const int c0 = 8 * lane; float gg[8], gb[8], muv[8];
#pragma unroll
      for (int e = 0; e < 8; ++e) { gg[e] = a.gng[i * 512 + c0 + e]; gb[e] = a.gnb[i * 512 + c0 + e]; muv[e] = a.mu[i * 1792 + 1024 + c0 + e]; }
      const int stride = nblk * 8;
      for (int mb = bid * 8 + wave; mb < M; mb += 2 * stride) {
          u32x4 ry[2], rvc[2], rvp[2], rg[2]; float bon[2]; bool has[2];
#pragma unroll
          for (int k = 0; k < 2; ++k) { const int m = mb + k * stride; has[k] = (m < M); const int mm = has[k] ? m : mb; const int t = mm & (T - 1);
              ry[k] = *(const u32x4*)(YR + (size_t)mm * 512 + c0); rvc[k] = *(const u32x4*)(Z + (size_t)mm * ZC + 1024 + c0);
              rvp[k] = (t > 0) ? *(const u32x4*)(Z + (size_t)(mm - 1) * ZC + 1024 + c0) : (u32x4){0u, 0u, 0u, 0u};
              rg[k] = *(const u32x4*)(LO + (size_t)mm * LOC + 1024 + c0); bon[k] = RKB[(size_t)mm * 8 + (lane >> 3)]; }
#pragma unroll
          for (int k = 0; k < 2; ++k) { const int m = mb + k * stride;
              float y[8], vc[8], vp[8], g[8], o[8];
              unpack8(ry[k], y); unpack8(rvc[k], vc); unpack8(rvp[k], vp); unpack8(rg[k], g);
              float s = 0.f;
#pragma unroll
              for (int e = 0; e < 8; ++e) s += y[e];
              s += __shfl_xor(s, 1); s += __shfl_xor(s, 2); s += __shfl_xor(s, 4);
              const float mean = s * (1.0f / 64.0f); float q = 0.f;
#pragma unroll
              for (int e = 0; e < 8; ++e) { const float d = y[e] - mean; q += d * d; }
              q += __shfl_xor(q, 1); q += __shfl_xor(q, 2); q += __shfl_xor(q, 4);
              const float rstd = 1.0f / sqrtf(q * (1.0f / 64.0f) + 64e-5f);
#pragma unroll
              for (int e = 0; e < 8; ++e) { const float vs = vc[e] + (vp[e] - vc[e]) * muv[e]; o[e] = ((y[e] - mean) * rstd * gg[e] + gb[e] + bon[k] * vs) * g[e]; }
              if (has[k]) *(u32x4*)(Y + (size_t)m * D + c0) = pack8(o); } } }
    LAS float* stat = (LAS float*)lds;
    LAS bf16_t* Wl = (LAS bf16_t*)(lds + 1024);
    LAS bf16_t* St = (LAS bf16_t*)(lds + 1024 + 128 * 136 * 2);
    const int l15 = lane & 15, l4 = lane >> 4;
    for (int ch = bid; ch < M / 128; ch += nblk) { const size_t m0 = (size_t)ch * 128;
        __syncthreads();
#pragma unroll 1
        for (int tb = 0; tb < 16; tb += 4) { u32x4 raw[4];
#pragma unroll
            for (int k = 0; k < 4; ++k) raw[k] = *(const u32x4*)(Z + (m0 + wave * 16 + tb + k) * ZC + 2304 + 8 * lane);
#pragma unroll
            for (int k = 0; k < 4; ++k) { const int tok = wave * 16 + tb + k; float sv[8]; unpack8(raw[k], sv); float s = 0.f;
#pragma unroll
                for (int e = 0; e < 8; e += 2) { const f32x2 gq = pg8::gelu_pk((f32x2){sv[e], sv[e + 1]}); sv[e] = gq.x; sv[e + 1] = gq.y; s += gq.x + gq.y; }
                const float mean = wave_sum(s) * (1.0f / 512.0f); float q = 0.f;
#pragma unroll
                for (int e = 0; e < 8; ++e) { const float d = sv[e] - mean; q += d * d; }
                const float rstd = 1.0f / sqrtf(wave_sum(q) * (1.0f / 512.0f) + 1e-5f);
                if (lane == 0) { stat[2 * tok] = mean; stat[2 * tok + 1] = rstd; } } }
        const int stok = tid >> 2, spart = tid & 3, etok = 16 * wave + l15;
        u32x4 raw[4]; f32x4 wr0[4], wr1[4];
#define GM_LOAD(G) do { const float* wsrc_ = a.wsp + ((size_t)(i * 4 + (G)) * 128 + stok) * 128 + 32 * spart; _Pragma("unroll") for (int q = 0; q < 4; ++q) { \
        raw[q] = *(const u32x4*)(Z + (m0 + stok) * ZC + 2304 + (G) * 128 + 32 * spart + 8 * q); wr0[q] = *(const f32x4*)(wsrc_ + 8 * q); wr1[q] = *(const f32x4*)(wsrc_ + 8 * q + 4); } } while (0)
        GM_LOAD(0);
#pragma unroll 1
        for (int g = 0; g < 4; ++g) {
            __syncthreads();
            { const float mean = stat[2 * stok], rstd = stat[2 * stok + 1];
#pragma unroll
              for (int q = 0; q < 4; ++q) { float sv[8], wv[8]; const int d0 = 32 * spart + 8 * q;
                  unpack8(raw[q], sv);
#pragma unroll
                  for (int e = 0; e < 8; e += 2) { const f32x2 gq = pg8::gelu_pk((f32x2){sv[e], sv[e + 1]}); sv[e] = gq.x; sv[e + 1] = gq.y; }
#pragma unroll
                  for (int e = 0; e < 8; ++e) { const int dd = g * 128 + d0 + e; const float sn = (sv[e] - mean) * rstd * a.lng[i * 512 + dd] + a.lnb[i * 512 + dd];
                      St[(d0 + e) * 136 + stok] = (bf16_t)(pk2(sn, 0.f) & 0xffffu); }
#pragma unroll
                  for (int e = 0; e < 4; ++e) { wv[e] = (d0 + e <= stok) ? wr0[q][e] : 0.f; wv[4 + e] = (d0 + 4 + e <= stok) ? wr1[q][e] : 0.f; }
                  *(LAS u32x4*)(Wl + stok * 136 + d0) = pack8(wv); } }
            if (g < 3) GM_LOAD(g + 1);
            u32x2 uz[8];
#pragma unroll
            for (int dt = 0; dt < 8; ++dt) uz[dt] = *(const u32x2*)(Z + (m0 + etok) * ZC + 1792 + g * 128 + 16 * dt + 4 * l4);
            const float bs = a.bsp[(i * 4 + g) * 128 + etok];
            __syncthreads();
            f32x4 acc[8];
#pragma unroll
            for (int dt = 0; dt < 8; ++dt) acc[dt] = (f32x4){0.f, 0.f, 0.f, 0.f};
#pragma unroll
            for (int ks = 0; ks < 4; ++ks) { const bf16x8 wf = *(const LAS bf16x8*)(Wl + (16 * wave + l15) * 136 + 32 * ks + 8 * l4);
#pragma unroll
                for (int dt = 0; dt < 8; ++dt) { const bf16x8 sf = *(const LAS bf16x8*)(St + (16 * dt + l15) * 136 + 32 * ks + 8 * l4);
                    acc[dt] = __builtin_amdgcn_mfma_f32_16x16x32_bf16(sf, wf, acc[dt], 0, 0, 0); } }
#pragma unroll
            for (int dt = 0; dt < 8; ++dt) { const f32x2 u0 = pg8::gelu_pk((f32x2){bflo(uz[dt].x), bfhi(uz[dt].x)}), u1 = pg8::gelu_pk((f32x2){bflo(uz[dt].y), bfhi(uz[dt].y)});
                *(u32x2*)(Y + (m0 + etok) * D + 512 + g * 128 + 16 * dt + 4 * l4) = (u32x2){pk2(u0.x * (acc[dt][0] + bs), u0.y * (acc[dt][1] + bs)), pk2(u1.x * (acc[dt][2] + bs), u1.y * (acc[dt][3] + bs))}; }
        }
#undef GM_LOAD
    }
}

__device__ __forceinline__ void attn_phase(const KAS Args& a, LAS unsigned char* lds, int i, const int tid_, const int bid, const int nblk) {
    const int tid = tid_, lane = tid & 63, wave = __builtin_amdgcn_readfirstlane(tid >> 6);
    const int l15 = lane & 15, l4 = lane >> 4;
    const bf16_t* QKV = (const bf16_t*)(a.ws + WS_HZ); bf16_t* Y = (bf16_t*)(a.ws + WS_Y); const float* tab = (const float*)(a.ws + WS_ROPE);
    LAS bf16_t* Ks = (LAS bf16_t*)lds;
    LAS bf16_t* Vt = (LAS bf16_t*)(lds + 36864);
    LAS bf16_t* Pb = (LAS bf16_t*)(lds + 36864 + 33792) + wave * (16 * 168);
    const float* qn = a.qn + i * 64; const float* kn = a.kn + i * 64;
    for (int unit = bid; unit < 16 * 4 * 32; unit += nblk) {
        const int b = unit >> 7, kvh = (unit >> 5) & 3, n = unit & 31;
        const size_t m0 = (size_t)b * T + n * 128;
        __syncthreads();
        { const int key = tid >> 1, hh = tid & 1; const bool valid = (n > 0) || (key >= 128); const size_t mk = m0 + key - 128;
          float x1[16], x2[16];
          if (valid) { const bf16_t* kp = QKV + mk * QKVC + 1024 + kvh * 64 + 16 * hh; float t8[8];
              unpack8(*(const u32x4*)(kp), t8);
#pragma unroll
              for (int e = 0; e < 8; ++e) x1[e] = t8[e];
              unpack8(*(const u32x4*)(kp + 8), t8);
#pragma unroll
              for (int e = 0; e < 8; ++e) x1[8 + e] = t8[e];
              unpack8(*(const u32x4*)(kp + 32), t8);
#pragma unroll
              for (int e = 0; e < 8; ++e) x2[e] = t8[e];
              unpack8(*(const u32x4*)(kp + 40), t8);
#pragma unroll
              for (int e = 0; e < 8; ++e) x2[8 + e] = t8[e];
          } else {
#pragma unroll
              for (int e = 0; e < 16; ++e) { x1[e] = 0.f; x2[e] = 0.f; } }
          float s = 0.f;
#pragma unroll
          for (int e = 0; e < 16; ++e) s += x1[e] * x1[e] + x2[e] * x2[e];
          s += __shfl_xor(s, 1);
          const float rms = 1.0f / sqrtf(s * (1.0f / 64.0f) + 1e-6f);
          float o1[16], o2[16];
#pragma unroll
          for (int e = 0; e < 16; ++e) { const int d = 16 * hh + e; float c = 1.f, sn = 0.f; if (valid) { c = tab[mk * 64 + d]; sn = tab[mk * 64 + 32 + d]; }
              const float a1 = x1[e] * rms * kn[d], a2 = x2[e] * rms * kn[32 + d]; o1[e] = a1 * c - a2 * sn; o2[e] = a2 * c + a1 * sn; }
          LAS bf16_t* kd = Ks + key * 72 + 16 * hh;
          *(LAS u32x4*)(kd) = (u32x4){pk2(o1[0], o1[1]), pk2(o1[2], o1[3]), pk2(o1[4], o1[5]), pk2(o1[6], o1[7])};
          *(LAS u32x4*)(kd + 8) = (u32x4){pk2(o1[8], o1[9]), pk2(o1[10], o1[11]), pk2(o1[12], o1[13]), pk2(o1[14], o1[15])};
          *(LAS u32x4*)(kd + 32) = (u32x4){pk2(o2[0], o2[1]), pk2(o2[2], o2[3]), pk2(o2[4], o2[5]), pk2(o2[6], o2[7])};
          *(LAS u32x4*)(kd + 40) = (u32x4){pk2(o2[8], o2[9]), pk2(o2[10], o2[11]), pk2(o2[12], o2[13]), pk2(o2[14], o2[15])};
        }
        { const int kp = (wave & 1) * 64 + lane, dq = wave >> 1; const bool valid = (n > 0) || (kp >= 64); const size_t mk = m0 + 2 * kp - 128;
          u32x4 va0 = {0u, 0u, 0u, 0u}, va1 = va0, vb0 = va0, vb1 = va0;
          if (valid) { const bf16_t* vp = QKV + mk * QKVC + 1280 + kvh * 64 + 16 * dq; va0 = *(const u32x4*)(vp); va1 = *(const u32x4*)(vp + 8); vb0 = *(const u32x4*)(vp + QKVC); vb1 = *(const u32x4*)(vp + QKVC + 8); }
          LAS unsigned* vt32 = (LAS unsigned*)Vt;
#define VT_ST(dd, A, B) vt32[((16 * dq + (dd)) * 264 + 2 * kp) >> 1] = ((A) & 0xffffu) | ((B) << 16); vt32[((16 * dq + (dd) + 1) * 264 + 2 * kp) >> 1] = ((A) >> 16) | ((B) & 0xffff0000u)
          VT_ST(0, va0.x, vb0.x); VT_ST(2, va0.y, vb0.y); VT_ST(4, va0.z, vb0.z); VT_ST(6, va0.w, vb0.w);
          VT_ST(8, va1.x, vb1.x); VT_ST(10, va1.y, vb1.y); VT_ST(12, va1.z, vb1.z); VT_ST(14, va1.w, vb1.w);
#undef VT_ST
        }
        __syncthreads();
        const int g = wave >> 1, qh = kvh * 4 + g; const float sink = a.sinks[i * 16 + qh];
#pragma unroll 1
        for (int pass = 0; pass < 2; ++pass) { const int i0 = (wave & 1) * 64 + pass * 32;
            bf16x8 qf[2][2];
#pragma unroll
            for (int rt = 0; rt < 2; ++rt) { const size_t mq = m0 + i0 + 16 * rt + l15; const bf16_t* qp = QKV + mq * QKVC + qh * 64 + 8 * l4; float x1[8], x2[8];
                unpack8(*(const u32x4*)(qp), x1); unpack8(*(const u32x4*)(qp + 32), x2);
                float s = 0.f;
#pragma unroll
                for (int e = 0; e < 8; ++e) s += x1[e] * x1[e] + x2[e] * x2[e];
                s += __shfl_xor(s, 16); s += __shfl_xor(s, 32);
                const float rms = 0.125f * __builtin_amdgcn_rsqf(s * (1.0f / 64.0f) + 1e-6f);
                float o1[8], o2[8];
#pragma unroll
                for (int e = 0; e < 8; ++e) { const int d = 8 * l4 + e; const float c = tab[mq * 64 + d], sn = tab[mq * 64 + 32 + d];
                    const float a1 = x1[e] * rms * qn[d], a2 = x2[e] * rms * qn[32 + d]; o1[e] = a1 * c - a2 * sn; o2[e] = a2 * c + a1 * sn; }
                qf[rt][0] = __builtin_bit_cast(bf16x8, pack8(o1)); qf[rt][1] = __builtin_bit_cast(bf16x8, pack8(o2)); }
            f32x4 sc[2][10];
#pragma unroll
            for (int rt = 0; rt < 2; ++rt)
#pragma unroll
                for (int kt = 0; kt < 10; ++kt) sc[rt][kt] = (f32x4){0.f, 0.f, 0.f, 0.f};
#pragma unroll
            for (int kt = 0; kt < 10; ++kt)
#pragma unroll
                for (int ks = 0; ks < 2; ++ks) { const bf16x8 kf = *(const LAS bf16x8*)(Ks + (i0 + 16 * kt + l15) * 72 + 32 * ks + 8 * l4);
#pragma unroll
                    for (int rt = 0; rt < 2; ++rt) if (kt - rt >= 0 && kt - rt <= 8) sc[rt][kt] = __builtin_amdgcn_mfma_f32_16x16x32_bf16(kf, qf[rt][ks], sc[rt][kt], 0, 0, 0); }
#pragma unroll
            for (int rt = 0; rt < 2; ++rt) {
                float mx = -INFINITY;
#pragma unroll
                for (int kt = 0; kt < 10; ++kt) { const int dk = kt - rt;
                    if (dk < 0 || dk > 8) continue;
#pragma unroll
                    for (int reg = 0; reg < 4; ++reg) { float sv = sc[rt][kt][reg];
                        if (dk == 0) sv = (4 * l4 + reg > l15) ? sv : -INFINITY;
                        if (dk == 8) sv = (4 * l4 + reg <= l15) ? sv : -INFINITY;
                        if (n == 0) sv = (i0 + 16 * kt + 4 * l4 + reg >= 128) ? sv : -INFINITY;
                        sc[rt][kt][reg] = sv; mx = fmaxf(mx, sv); } }
                mx = fmaxf(mx, __shfl_xor(mx, 16)); mx = fmaxf(mx, __shfl_xor(mx, 32)); mx = fmaxf(mx, sink);
                const float mneg = -mx * 1.4426950408889634f; float sum = 0.f;
#pragma unroll
                for (int kt = 0; kt < 10; ++kt) { const int dk = kt - rt;
                    if (dk < 0 || dk > 8) { sc[rt][kt] = (f32x4){0.f, 0.f, 0.f, 0.f}; continue; }
#pragma unroll
                    for (int reg = 0; reg < 4; ++reg) { const float p = __builtin_amdgcn_exp2f(fmaf(sc[rt][kt][reg], 1.4426950408889634f, mneg)); sc[rt][kt][reg] = p; sum += p; } }
                sum += __shfl_xor(sum, 16); sum += __shfl_xor(sum, 32);
                sum += __builtin_amdgcn_exp2f(fmaf(sink, 1.4426950408889634f, mneg));
                const float rden = __builtin_amdgcn_rcpf(sum);
                f32x4 o[4];
#pragma unroll
                for (int dt = 0; dt < 4; ++dt) o[dt] = (f32x4){0.f, 0.f, 0.f, 0.f};
#pragma unroll
                for (int ks = 0; ks < 5; ++ks) { const f32x4 pa = sc[rt][2 * ks], pb = sc[rt][2 * ks + 1];
                    const bf16x8 pf = __builtin_bit_cast(bf16x8, (u32x4){pk2(pa[0], pa[1]), pk2(pa[2], pa[3]), pk2(pb[0], pb[1]), pk2(pb[2], pb[3])});
#pragma unroll
                    for (int dt = 0; dt < 4; ++dt) { const LAS bf16_t* vp = Vt + (16 * dt + l15) * 264 + i0 + 32 * ks + 4 * l4;
                        const u32x2 v0 = *(const LAS u32x2*)(vp), v1 = *(const LAS u32x2*)(vp + 16);
                        const bf16x8 vf = __builtin_bit_cast(bf16x8, (u32x4){v0.x, v0.y, v1.x, v1.y});
                        o[dt] = __builtin_amdgcn_mfma_f32_16x16x32_bf16(vf, pf, o[dt], 0, 0, 0); } }
                { const size_t mq = m0 + i0 + 16 * rt + l15;
#pragma unroll
                  for (int dt = 0; dt < 4; ++dt) *(u32x2*)(Y + mq * D + qh * 64 + 16 * dt + 4 * l4) = (u32x2){pk2(o[dt][0] * rden, o[dt][1] * rden), pk2(o[dt][2] * rden, o[dt][3] * rden)}; }
            }
        }
    }
}

#define XB_TMO      128
#define XB_XCNT(j)  (256  + 64 * (j))
#define XB_XSUB(j)  (1280 + 64 * (j))
#define XB_XGEN(j)  (2304 + 64 * (j))
#define XB_TOP      3328
#define XB_TOPGEN   3392
#define XCD_BAR_WORDS 3456
#define XB_SPIN_CAP (1u << 18)

__device__ __forceinline__ unsigned xb_ld(unsigned* p)              { return __hip_atomic_load(p, __ATOMIC_RELAXED, __HIP_MEMORY_SCOPE_AGENT); }
__device__ __forceinline__ unsigned xb_add(unsigned* p, unsigned v) { return __hip_atomic_fetch_add(p, v, __ATOMIC_RELAXED, __HIP_MEMORY_SCOPE_AGENT); }
__device__ __forceinline__ unsigned xb_xcc_id() { return (unsigned)__builtin_amdgcn_s_getreg((3 << 11) | 20) & 0xFu; }
#define XB_SPIN(cond, bar) do { unsigned _sp = 0; while (cond) { __builtin_amdgcn_s_sleep(1); \
    if ((++_sp & 255u) == 0u) { if (xb_ld(&(bar)[XB_TMO])) break; if (_sp > XB_SPIN_CAP) { atomicAdd(&(bar)[XB_TMO], 1u); break; } } } } while (0)

struct XcdBarrier {
    unsigned* bar; unsigned x;
    volatile LAS unsigned* st;
};

__device__ __forceinline__ XcdBarrier xcd_barrier_post(unsigned* bar, volatile LAS unsigned* st) {
    XcdBarrier b; b.bar = bar; b.x = xb_xcc_id(); b.st = st;
    if (threadIdx.x == 0) (void)xb_add(&bar[XB_XCNT(b.x)], 1u);
    return b;
}
__device__ __forceinline__ void xcd_barrier_complete(unsigned* bar, unsigned x, unsigned& nloc, unsigned& nx) {
    const unsigned G = gridDim.x * gridDim.y * gridDim.z;
    unsigned sum, cnt, mine, sp = 0u;
    for (;;) {
        sum = 0u; cnt = 0u; mine = 0u;
#pragma unroll
        for (unsigned j = 0; j < 16; ++j) { const unsigned c = xb_ld(&bar[XB_XCNT(j)]); sum += c; cnt += (c > 0u) ? 1u : 0u; mine = (j == x) ? c : mine; }
        if (sum == G) break;
        __builtin_amdgcn_s_sleep(1);
        if ((++sp & 255u) == 0u) { if (xb_ld(&bar[XB_TMO])) break; if (sp > XB_SPIN_CAP) { atomicAdd(&bar[XB_TMO], 1u); break; } }
    }
    nloc = mine > 0u ? mine : 1u; nx = cnt > 0u ? cnt : 1u;
}

__device__ __forceinline__ void xcd_barrier(const XcdBarrier& b) {
    asm volatile("s_waitcnt vmcnt(0)" ::: "memory");
    __syncthreads();
    if (threadIdx.x == 0) {
        unsigned* bar = b.bar;
        __builtin_amdgcn_s_waitcnt(0);
        unsigned nloc = b.st[0], nx = b.st[1];
        if (nloc == 0u) { xcd_barrier_complete(bar, b.x, nloc, nx); b.st[0] = nloc; b.st[1] = nx; }
        const unsigned old = xb_add(&bar[XB_XSUB(b.x)], 1u);
        const unsigned gen = old / nloc;
        if (old + 1u == (gen + 1u) * nloc) {
            __builtin_amdgcn_fence(__ATOMIC_RELEASE, "agent");
            asm volatile("s_waitcnt vmcnt(0)" ::: "memory");
            const unsigned og = xb_add(&bar[XB_TOP], 1u);
            const unsigned tg = og / nx;
            if (og + 1u == (tg + 1u) * nx) xb_add(&bar[XB_TOPGEN], 1u);
            else XB_SPIN(xb_ld(&bar[XB_TOPGEN]) == tg, bar);
            __builtin_amdgcn_fence(__ATOMIC_ACQUIRE, "agent");
            xb_add(&bar[XB_XGEN(b.x)], 1u);
            asm volatile("s_waitcnt vmcnt(0)" ::: "memory");
        } else {
            XB_SPIN(xb_ld(&bar[XB_XGEN(b.x)]) == gen, bar);
            __builtin_amdgcn_fence(__ATOMIC_ACQUIRE, "agent");
            asm volatile("s_waitcnt vmcnt(0)" ::: "memory");
        }
    }
    __syncthreads();
}
#ifndef PROBE_KIND
#define PROBE_KIND -1
#endif
#if PROBE_KIND == 6
constexpr int NE = 11, NO = 7; __device__ const signed char EVEN_K[NE] = {1, 2, 3, 4, 5, 6, 6, 7, 8, 1, 2}, EVEN_S[NE] = {0, 0, 0, 0, 0, 0, 0, 0, 0, 1, 1}, ODD_K[NO] = {1, 2, 3, 9, 8, 1, 2}, ODD_S[NO] = {0, 0, 0, 0, 0, 1, 1};
#elif PROBE_KIND == 7
constexpr int NE = 11, NO = 7; __device__ const signed char EVEN_K[NE] = {1, 2, 3, 4, 5, 6, 7, 7, 8, 1, 2}, EVEN_S[NE] = {0, 0, 0, 0, 0, 0, 0, 0, 0, 1, 1}, ODD_K[NO] = {1, 2, 3, 9, 8, 1, 2}, ODD_S[NO] = {0, 0, 0, 0, 0, 1, 1};
#elif PROBE_KIND == 9
constexpr int NE = 10, NO = 8; __device__ const signed char EVEN_K[NE] = {1, 2, 3, 4, 5, 6, 7, 8, 1, 2}, EVEN_S[NE] = {0, 0, 0, 0, 0, 0, 0, 0, 1, 1}, ODD_K[NO] = {1, 2, 3, 9, 9, 8, 1, 2}, ODD_S[NO] = {0, 0, 0, 0, 0, 0, 1, 1};
#elif PROBE_KIND == 1
constexpr int NE = 12, NO = 9; __device__ const signed char EVEN_K[NE] = {1, 1, 2, 3, 4, 5, 6, 7, 8, 1, 1, 2}, EVEN_S[NE] = {0, 0, 0, 0, 0, 0, 0, 0, 0, 1, 1, 1}, ODD_K[NO] = {1, 1, 2, 3, 9, 8, 1, 1, 2}, ODD_S[NO] = {0, 0, 0, 0, 0, 0, 1, 1, 1};
#elif PROBE_KIND == 3
constexpr int NE = 12, NO = 8; __device__ const signed char EVEN_K[NE] = {1, 2, 3, 3, 4, 5, 5, 6, 7, 8, 1, 2}, EVEN_S[NE] = {0, 0, 0, 0, 0, 0, 0, 0, 0, 0, 1, 1}, ODD_K[NO] = {1, 2, 3, 3, 9, 8, 1, 2}, ODD_S[NO] = {0, 0, 0, 0, 0, 0, 1, 1};
#else
constexpr int NE = 10, NO = 7; __device__ const signed char EVEN_K[NE] = {1, 2, 3, 4, 5, 6, 7, 8, 1, 2}, EVEN_S[NE] = {0, 0, 0, 0, 0, 0, 0, 0, 1, 1}, ODD_K[NO] = {1, 2, 3, 9, 8, 1, 2}, ODD_S[NO] = {0, 0, 0, 0, 0, 1, 1};
#endif
constexpr int N_PHASES = 1 + 2 * (NE + NO);
__global__ void __launch_bounds__(512) mega_fwd(Args a_) {
    extern __shared__ __attribute__((aligned(16))) unsigned char lds_raw[];
    cg::grid_group grid = cg::this_grid();
    const int ph_lo = a_.ph_lo, ph_hi = a_.ph_hi;
    volatile LAS unsigned* MISC = (volatile LAS unsigned*)((LAS unsigned char*)lds_raw + 131072 + 320);
    if (threadIdx.x < 32) MISC[threadIdx.x] = 0u;
    __syncthreads();
    XcdBarrier xbar; xbar.bar = (unsigned*)a_.ws; xbar.x = 0; xbar.st = nullptr;
    if (ph_hi - ph_lo > 1) xbar = xcd_barrier_post((unsigned*)a_.ws, MISC + 8);
    for (int ph = ph_lo; ph < ph_hi; ++ph) {
        int koff = 0, bid = blockIdx.x, nblk = gridDim.x, tid_ = threadIdx.x; asm volatile("" : "+s"(koff), "+s"(bid), "+s"(nblk), "+v"(tid_));
        LAS unsigned char* lds = (LAS unsigned char*)lds_raw + koff;
        const KAS Args& a = *kargs(koff);
        unsigned char* ws = a.ws;
        float* ssb = (float*)(ws + WS_SS);
        bf16_t* XB = (bf16_t*)(ws + WS_XB); bf16_t* HZ = (bf16_t*)(ws + WS_HZ); bf16_t* YB = (bf16_t*)(ws + WS_Y);
        int kind = 0, l = 0, second = 0;
        if (ph > 0) { const int p = ph - 1, pair = p / (NE + NO), q = p % (NE + NO);
            if (q < NE) { l = 2 * pair; kind = EVEN_K[q]; second = EVEN_S[q]; }
            else { l = 2 * pair + 1; kind = ODD_K[q - NE]; second = ODD_S[q - NE]; } }
        const int i = l >> 1, odd = l & 1, f = 2 * l + second;
#ifndef PHM
#define PHM 0x3ff
#endif
        if (kind == 0) { if (PHM & 1) prologue(a, lds, tid_, bid, nblk); }
        else if (kind == 1 && (PHM & 2)) {
            pg8::Gemm g{XB, (const bf16_t*)(ws + WS_W + (size_t)f * FFN_STRIDE), M, 2 * FF, D}; pg8::StaticOrder S; S.init(M, 2 * FF, nblk, bid);
            pg8::EpiSwiglu E{HZ, FF, ssb};
            pg8::gemm_phase<pg8::EpiSwiglu, pg8::StaticOrder, true, true>(lds, g, S, E, tid_);
        } else if ((kind == 2 || kind == 8) && (PHM & 4)) {
            pg8::Gemm g; const float* bias = nullptr; float scale = 1.0f; float* ssn;
            if (kind == 2) { g = pg8::Gemm{HZ, (const bf16_t*)(ws + WS_W + (size_t)f * FFN_STRIDE + WD_OFF), M, D, FF}; scale = 0.5f; ssn = ssb; }
            else { g = pg8::Gemm{YB, (const bf16_t*)(odd ? ws + WS_WODD + i * ODD_STRIDE + WO_OFF : ws + WS_WMIX + i * EVEN_STRIDE + WOUT_OFF), M, D, D}; if (odd) bias = a.bo + i * D; ssn = ssb; }
            const bool last = (kind == 2 && l == 3 && second), prelast = (kind == 8 && l == 3);
            bf16_t* xl = (bf16_t*)((unsigned char*)a.out + OUT_XL); bf16_t* xl2 = (bf16_t*)(ws + WS_LO);
            pg8::StaticOrder S; S.init(M, D, nblk, bid);
            pg8::EpiResid E{XB, last ? xl2 : xl, prelast ? xl2 : xl, last ? a.out : nullptr, ssn, bias, scale};
            pg8::gemm_phase<pg8::EpiResid, pg8::StaticOrder, false, true>(lds, g, S, E, tid_);
        } else if ((kind == 3 || kind == 5) && (PHM & 8)) {
            pg8::Gemm g; pg8::EpiBf E;
            if (kind == 3 && !odd) { g = pg8::Gemm{XB, (const bf16_t*)(ws + WS_WMIX + i * EVEN_STRIDE), M, ZC, D}; E = pg8::EpiBf{HZ, ZC, ssb, nullptr, 0}; }
            else if (kind == 3) { g = pg8::Gemm{XB, (const bf16_t*)(ws + WS_WODD + i * ODD_STRIDE), M, QKVC, D}; E = pg8::EpiBf{HZ, QKVC, ssb, a.bqkv + i * QKVC, 0}; }
            else { g = pg8::Gemm{(const bf16_t*)((unsigned char*)a.out + OUT_LA), (const bf16_t*)(ws + WS_WMIX + i * EVEN_STRIDE + WLORA_OFF), M, LOC, LAC}; E = pg8::EpiBf{(bf16_t*)(ws + WS_LO), LOC, nullptr, (const float*)(ws + WS_LB) + i * LOC, 1}; }
            pg8::StaticOrder S; S.init(M, g.N, nblk, bid);
            pg8::gemm_phase<pg8::EpiBf, pg8::StaticOrder, true, true>(lds, g, S, E, tid_);
        } else if (kind == 4 && (PHM & 16)) el_phase(a, i, tid_, bid, nblk);
        else if (kind == 6 && (PHM & 32)) scan_phase(a, lds, i, tid_, bid, nblk);
        else if (kind == 7 && (PHM & 64)) post_phase(a, lds, i, tid_, bid, nblk);
        else if (kind == 9 && (PHM & 128)) attn_phase(a, lds, i, tid_, bid, nblk);
#ifndef PROBE_SYNC
#define PROBE_SYNC 1
#endif
#ifndef PROBE_PRO2
#define PROBE_PRO2 0
#endif
        if (PROBE_PRO2 && ph == 0) { grid.sync(); prologue(a, lds, tid_, bid, nblk); }
        if (ph + 1 < ph_hi) { if (ph_hi < 0) grid.sync(); else xcd_barrier(xbar); }
    }
}

#ifndef MK_MULTI
#define MK_MULTI 0
#endif
extern "C" void kernel_launch(void* const* d_in, const int* in_sizes, int n_in, void* d_out, int out_size, void* d_ws, size_t ws_size, hipStream_t stream) {
    static int grid = 0;
    if (grid == 0) {
        if (n_in != 35 || in_sizes[0] != M * D || out_size != M * D || ws_size < WS_END) { fprintf(stderr, "kernel_launch: unexpected shapes (n_in %d, in0 %d, out %d, ws %zu); nothing launched\n", n_in, n_in > 0 ? in_sizes[0] : -1, out_size, ws_size); grid = -1; return; }
        int dev = 0, cus = 0, per_cu = 0;
        hipGetDevice(&dev); hipDeviceGetAttribute(&cus, hipDeviceAttributeMultiprocessorCount, dev);
        if (hipFuncSetAttribute((const void*)mega_fwd, hipFuncAttributeMaxDynamicSharedMemorySize, LDS_BYTES) != hipSuccess) { fprintf(stderr, "kernel_launch: hipFuncSetAttribute failed\n"); grid = -1; return; }
        if (hipOccupancyMaxActiveBlocksPerMultiprocessor(&per_cu, (const void*)mega_fwd, 512, LDS_BYTES) != hipSuccess || per_cu < 1) { fprintf(stderr, "kernel_launch: occupancy query says %d\n", per_cu); per_cu = 1; }
        (void)hipGetLastError();
        grid = cus * per_cu;
        if (grid > 256) grid = 256;
    }
    if (grid < 0) return;
    Args a{};
    const float** fp = (const float**)&a.f1n;
    a.x = (const float*)d_in[0]; a.pos = (const int*)d_in[1];
    for (int k = 2; k < 35; ++k) fp[k - 2] = (const float*)d_in[k];
    a.out = (float*)d_out; a.ws = (unsigned char*)d_ws;
    for (int d = 0; d < 32; ++d) a.inv_freq[d] = (float)pow(10000.0, -(double)(2 * d) / 64.0);
#if MK_MULTI
    for (int ph = 0; ph < N_PHASES; ++ph) { a.ph_lo = ph; a.ph_hi = ph + 1; hipLaunchKernelGGL(mega_fwd, dim3(grid), dim3(512), LDS_BYTES, stream, a); }
#else
    a.ph_lo = 0; a.ph_hi = N_PHASES;
    if (hipMemsetAsync(d_ws, 0, 16384, stream) != hipSuccess) { fprintf(stderr, "kernel_launch: memset of the barrier words failed\n"); return; }
    void* args[] = {&a};
    hipError_t e = hipLaunchCooperativeKernel((const void*)mega_fwd, dim3(grid), dim3(512), args, LDS_BYTES, stream);
    if (e != hipSuccess) fprintf(stderr, "cooperative launch failed: %s (grid %d)\n", hipGetErrorString(e), grid);
#endif
}
```

```cpp
#include <hip/hip_runtime.h>
#include <hip/hip_cooperative_groups.h>
#include <cstdio>
#include <cstdint>
#include <cmath>
namespace pg8 {
#define PG8_LAS __attribute__((address_space(3)))
typedef unsigned short bf16_t;
typedef short bf16x8 __attribute__((ext_vector_type(8)));
typedef float f32x4 __attribute__((ext_vector_type(4)));
typedef unsigned u32x4 __attribute__((ext_vector_type(4)));
constexpr int BM = 256, BK = 64, HALF = 128, HTB = HALF * BK * 2  , STAGE_BYTES = 8 * HTB, NXCD = 8, WGM = 8;

__host__ __device__ __forceinline__ int lds_byte(int r, int c) { const int st = (r >> 4) * 2 + (c >> 5), rr = r & 15, cc = c & 31, ob = rr * 64 + cc * 2; return st * 1024 + (ob ^ (((ob >> 9) & 1) << 5)); }
__host__ __device__ __forceinline__ void stage_rc(int b, int& R, int& C) { const int st = b / 1024, sb = b % 1024, swz = sb ^ (((sb >> 9) & 1) << 5); R = (st >> 1) * 16 + swz / 64; C = (st & 1) * 32 + (swz % 64) / 2; }
__host__ __device__ __forceinline__ int perm32(int rho) { const int n = rho >> 4, i = rho & 15; return 8 * (i >> 2) + 4 * n + (i & 3); }

struct Unit { int pm, pn; };
struct Gemm { const bf16_t* A; const bf16_t* Bt; int M, N, K; };

struct StaticOrder {
    int nM, nN, nwg, G, c;
    __host__ __device__ void init(int M, int N, int G_, int c_) { nM = M / BM; nN = N / BM; nwg = nM * nN; G = G_; c = c_; }
    __host__ __device__ bool next(int i, Unit& u) const {
        const long L = (long)i * G + c; if (L >= nwg) return false;
        int wgid = (int)L; { const int q = nwg / NXCD, r = nwg % NXCD, xcd = wgid % NXCD, off = wgid / NXCD; wgid = (xcd < r ? xcd * (q + 1) : r * (q + 1) + (xcd - r) * q) + off; }
        const int nig = WGM * nN, gid = wgid / nig, fm = gid * WGM, gsz = (nM - fm) < WGM ? (nM - fm) : WGM;
        u.pm = fm + ((wgid % nig) % gsz); u.pn = (wgid % nig) / gsz; return true;
    }
    __device__ __forceinline__ void a_ready(const Unit&) const {}
    __device__ __forceinline__ void done(const Unit&) const {}
};
__device__ __forceinline__ unsigned cvt_pk_bf16(float lo, float hi) { unsigned r; asm volatile("v_cvt_pk_bf16_f32 %0, %1, %2" : "=v"(r) : "v"(lo), "v"(hi)); return r; }
typedef float f32x2 __attribute__((ext_vector_type(2)));
__device__ __forceinline__ f32x2 gelu_pk(f32x2 v) {
    const f32x2 av = __builtin_elementwise_abs(v), d = av * 0.2316418882f + 1.0f;
    f32x2 t; t.x = __builtin_amdgcn_rcpf(d.x); t.y = __builtin_amdgcn_rcpf(d.y);
    f32x2 q = t * 0.5307027145f + (-0.7265760135f); q = q * t + 0.7107068705f; q = q * t + (-0.142248368f); q = q * t + 0.127414796f; q = q * t;
    const f32x2 s = (v * v) * (-0.72134752044f);
    f32x2 e; e.x = __builtin_amdgcn_exp2f(s.x); e.y = __builtin_amdgcn_exp2f(s.y);
    const f32x2 m = v * (q * e), r = v - m;
    f32x2 o; o.x = v.x < 0.f ? m.x : r.x; o.y = v.y < 0.f ? m.y : r.y; return o;
}
typedef unsigned u32x2 __attribute__((ext_vector_type(2)));
typedef __bf16 bf16x2_t __attribute__((ext_vector_type(2)));
__device__ __forceinline__ unsigned pk2(float lo, float hi) { f32x2 v = {lo, hi}; bf16x2_t b = __builtin_convertvector(v, bf16x2_t); return __builtin_bit_cast(unsigned, b); }
__device__ __forceinline__ float fast_sigmoid(float x) { return __builtin_amdgcn_rcpf(1.0f + __builtin_amdgcn_exp2f(-1.4426950408889634f * x)); }

__device__ __forceinline__ float row_rs(const float* ss, int r, int fq) { const f32x4 a = *(const f32x4*)(ss + (size_t)r * 16 + 4 * fq);
    float t = (a[0] + a[1]) + (a[2] + a[3]); t += __shfl_xor(t, 16); t += __shfl_xor(t, 32); return __builtin_amdgcn_rsqf(t * (1.0f / 1024.0f) + 1e-6f); }
struct EpiSwiglu {
    static constexpr bool PERM = true, AFTER_DRAIN = false, WIDE = false;
    bf16_t* H; int ldh; const float* ss;
    __device__ __forceinline__ void operator()(const f32x4 (&acc)[2][2][4][2], const Unit& u, int wr, int wc, int fr, int fq) const {
        const int row0 = u.pm * BM + wr * 64 + fr; const int col0 = u.pn * HALF + wc * 32 + 8 * fq;
        float rsv[2][4];
#pragma unroll
        for (int ai = 0; ai < 2; ++ai)
#pragma unroll
            for (int m = 0; m < 4; ++m) rsv[ai][m] = row_rs(ss, row0 + ai * HALF + m * 16, fq);
#pragma unroll
        for (int ai = 0; ai < 2; ++ai)
#pragma unroll
            for (int m = 0; m < 4; ++m) { const int r = row0 + ai * HALF + m * 16; const float rs = rsv[ai][m], rs2 = rs * rs, nl = -1.4426950408889634f * rs;
                unsigned w[4];
#pragma unroll
                for (int n = 0; n < 2; ++n) { const f32x4 g = acc[ai][0][m][n], gu = g * acc[ai][1][m][n] * rs2, ge = g * nl; float hv[4];
#pragma unroll
                    for (int e = 0; e < 4; ++e) hv[e] = gu[e] * __builtin_amdgcn_rcpf(1.0f + __builtin_amdgcn_exp2f(ge[e]));
                    w[2 * n] = pk2(hv[0], hv[1]); w[2 * n + 1] = pk2(hv[2], hv[3]); }
                *(u32x4*)(H + (size_t)r * ldh + col0) = (u32x4){w[0], w[1], w[2], w[3]}; }
    }
};
struct EpiResid {
    static constexpr bool PERM = true, AFTER_DRAIN = false, WIDE = true;
    const float* xin;
    bf16_t* hi; const bf16_t* lo_in; bf16_t* lo_out;
    float* fout;
    float* ssn; const float* bias; float scale;
    __device__ __forceinline__ void operator()(const f32x4 (&acc)[2][2][4][2], const Unit& u, int wr, int wc, int fr, int fq) const {
        const int row0 = u.pm * BM + wr * 64 + fr; const int col0 = u.pn * BM + wc * 64 + 8 * fq;
        f32x4 bv[2][2];
#pragma unroll
        for (int bj = 0; bj < 2; ++bj)
#pragma unroll
            for (int n = 0; n < 2; ++n) bv[bj][n] = bias ? *(const f32x4*)(bias + col0 + bj * 32 + 4 * n) : (f32x4){0.f, 0.f, 0.f, 0.f};
#pragma unroll
        for (int q = 0; q < 4; ++q) { const int ai = q >> 1, mh = (q & 1) * 2;
            u32x4 rh[2][2], rl[2][2];
#pragma unroll
            for (int m = 0; m < 2; ++m)
#pragma unroll
                for (int bj = 0; bj < 2; ++bj) { const size_t c = (size_t)(row0 + ai * HALF + (mh + m) * 16) * 1024 + col0 + bj * 32;
                    if (xin) { rh[m][bj] = __builtin_bit_cast(u32x4, *(const f32x4*)(xin + c)); rl[m][bj] = __builtin_bit_cast(u32x4, *(const f32x4*)(xin + c + 4)); }
                    else { rh[m][bj] = *(const u32x4*)(hi + c); rl[m][bj] = *(const u32x4*)(lo_in + c); } }
#pragma unroll
            for (int m = 0; m < 2; ++m) { const int r = row0 + ai * HALF + (mh + m) * 16; float s = 0.f;
#pragma unroll
                for (int bj = 0; bj < 2; ++bj) { const size_t c = (size_t)r * 1024 + col0 + bj * 32; const u32x4 h = rh[m][bj], l = rl[m][bj]; f32x4 b0, b1;
                    if (xin) { b0 = __builtin_bit_cast(f32x4, h); b1 = __builtin_bit_cast(f32x4, l); }
                    else { b0 = (f32x4){__uint_as_float(h.x << 16) + __uint_as_float(l.x << 16), __uint_as_float(h.x & 0xffff0000u) + __uint_as_float(l.x & 0xffff0000u),
                                        __uint_as_float(h.y << 16) + __uint_as_float(l.y << 16), __uint_as_float(h.y & 0xffff0000u) + __uint_as_float(l.y & 0xffff0000u)};
                           b1 = (f32x4){__uint_as_float(h.z << 16) + __uint_as_float(l.z << 16), __uint_as_float(h.z & 0xffff0000u) + __uint_as_float(l.z & 0xffff0000u),
                                        __uint_as_float(h.w << 16) + __uint_as_float(l.w << 16), __uint_as_float(h.w & 0xffff0000u) + __uint_as_float(l.w & 0xffff0000u)}; }
                    const f32x4 v0 = b0 + acc[ai][bj][mh + m][0] * scale + bv[bj][0], v1 = b1 + acc[ai][bj][mh + m][1] * scale + bv[bj][1];
                    if (fout) { *(f32x4*)(fout + c) = v0; *(f32x4*)(fout + c + 4) = v1; }
                    else { const unsigned h0 = pk2(v0[0], v0[1]), h1 = pk2(v0[2], v0[3]), h2 = pk2(v1[0], v1[1]), h3 = pk2(v1[2], v1[3]);
                        const unsigned l0 = pk2(v0[0] - __uint_as_float(h0 << 16), v0[1] - __uint_as_float(h0 & 0xffff0000u)), l1 = pk2(v0[2] - __uint_as_float(h1 << 16), v0[3] - __uint_as_float(h1 & 0xffff0000u)),
                                       l2 = pk2(v1[0] - __uint_as_float(h2 << 16), v1[1] - __uint_as_float(h2 & 0xffff0000u)), l3 = pk2(v1[2] - __uint_as_float(h3 << 16), v1[3] - __uint_as_float(h3 & 0xffff0000u));
                        *(u32x4*)(hi + c) = (u32x4){h0, h1, h2, h3}; *(u32x4*)(lo_out + c) = (u32x4){l0, l1, l2, l3}; }
                    s += ((v0[0] * v0[0] + v0[1] * v0[1]) + (v0[2] * v0[2] + v0[3] * v0[3])) + ((v1[0] * v1[0] + v1[1] * v1[1]) + (v1[2] * v1[2] + v1[3] * v1[3])); }
                s += __shfl_xor(s, 16); s += __shfl_xor(s, 32);
                if (fq == 0) ssn[(size_t)r * 16 + u.pn * 4 + wc] = s; }
        }
    }
};
struct EpiBf {
    static constexpr bool PERM = true, AFTER_DRAIN = false, WIDE = true;
    bf16_t* O; int ldc; const float* ss; const float* bias; int mode;
    __device__ __forceinline__ void operator()(const f32x4 (&acc)[2][2][4][2], const Unit& u, int wr, int wc, int fr, int fq) const {
        const int row0 = u.pm * BM + wr * 64 + fr; const int col0 = u.pn * BM + wc * 64 + 8 * fq;
        const int seg = (mode == 1) ? (u.pn >> 1) : 3;
        f32x4 bv[2][2];
#pragma unroll
        for (int bj = 0; bj < 2; ++bj)
#pragma unroll
            for (int n = 0; n < 2; ++n) bv[bj][n] = bias ? *(const f32x4*)(bias + col0 + bj * 32 + 4 * n) : (f32x4){0.f, 0.f, 0.f, 0.f};
        float rsv[2][4];
#pragma unroll
        for (int ai = 0; ai < 2; ++ai)
#pragma unroll
            for (int m = 0; m < 4; ++m) rsv[ai][m] = ss ? row_rs(ss, row0 + ai * HALF + m * 16, fq) : 1.0f;
#pragma unroll
        for (int ai = 0; ai < 2; ++ai)
#pragma unroll
            for (int m = 0; m < 4; ++m) { const int r = row0 + ai * HALF + m * 16; const float rs = rsv[ai][m];
                bf16_t* rowp = O + (size_t)r * ldc + col0;
#pragma unroll
                for (int bj = 0; bj < 2; ++bj) { f32x4 v0 = acc[ai][bj][m][0] * rs + bv[bj][0], v1 = acc[ai][bj][m][1] * rs + bv[bj][1];
                    if (seg < 2) { const float sc = (seg == 0) ? 0.60653065971263342f : 1.0f;
#pragma unroll
                        for (int e = 0; e < 4; ++e) { v0[e] = sc * fast_sigmoid(v0[e]); v1[e] = sc * fast_sigmoid(v1[e]); } }
                    *(u32x4*)(rowp + bj * 32) = (u32x4){pk2(v0[0], v0[1]), pk2(v0[2], v0[3]), pk2(v1[0], v1[1]), pk2(v1[2], v1[3])}; } }
    }
};

template <class Epi, class Sched, bool ALIGN_EPI = false, bool SP2 = false>
__device__ __forceinline__ void gemm_phase(PG8_LAS unsigned char* lds, const Gemm g, const Sched& S, const Epi& E, const int tid_) {
    const int tid = tid_, wid = __builtin_amdgcn_readfirstlane(tid >> 6), lane = tid & 63, wr = wid >> 2, wc = wid & 3, fr = lane & 15, fq = lane >> 4;
    const int K = g.K, nt = K / BK;
    unsigned voffA[2], voffB[2];
#pragma unroll
    for (int i = 0; i < 2; ++i) { int R, C; stage_rc(tid * 16 + i * 8192, R, C); const int Rb = Epi::WIDE ? (64 * (R >> 5) + (Epi::PERM ? perm32(R & 31) : (R & 31))) : (Epi::PERM ? ((R & ~31) + perm32(R & 31)) : R);
        voffA[i] = (unsigned)(R * K + C) * 2u; voffB[i] = (unsigned)(Rb * K + C) * 2u; }
    const size_t kstep = (size_t)(BK * 2);
    const size_t hstep = (size_t)HALF * K * 2;
    const size_t tstep = 2 * hstep;
    const size_t hstepB = Epi::WIDE ? (size_t)32 * K * 2 : hstep;
    const unsigned ldsw = (unsigned)wid * 1024u;
    const int aoff = lds_byte(wr * 64 + fr, fq * 8), boff = lds_byte(wc * 32 + fr, fq * 8);
#define PG8_SA(b, h) (((b) * 2 + (h)) * HTB)
#define PG8_SB(b, h) ((4 + (b) * 2 + (h)) * HTB)
#define PG8_STAGE(bufoff, gbase, voff) do { _Pragma("unroll") for (int _i = 0; _i < 2; ++_i) \
        __builtin_amdgcn_global_load_lds((const unsigned*)((const char*)(gbase) + (voff)[_i]), (PG8_LAS unsigned*)(lds + (bufoff) + ldsw + _i * 8192), 16, 0, 0); } while (0)
#define PG8_LDA(dst, b, h) do { _Pragma("unroll") for (int m = 0; m < 4; ++m) _Pragma("unroll") for (int k = 0; k < 2; ++k) dst[m][k] = *(const PG8_LAS bf16x8*)(lds + PG8_SA(b, h) + aoff + m * 2048 + k * 1024); } while (0)
#define PG8_LDB(dst, b, h) do { _Pragma("unroll") for (int n = 0; n < 2; ++n) _Pragma("unroll") for (int k = 0; k < 2; ++k) dst[n][k] = *(const PG8_LAS bf16x8*)(lds + PG8_SB(b, h) + boff + n * 2048 + k * 1024); } while (0)
#define PG8_MMA(ai, bj, At, Bt) do { __builtin_amdgcn_s_setprio(1); _Pragma("unroll") for (int m = 0; m < 4; ++m) _Pragma("unroll") for (int n = 0; n < 2; ++n) _Pragma("unroll") for (int k = 0; k < 2; ++k) \
        acc[ai][bj][m][n] = __builtin_amdgcn_mfma_f32_16x16x32_bf16(Bt[n][k], At[m][k], acc[ai][bj][m][n], 0, 0, 0); __builtin_amdgcn_s_setprio(0); } while (0)
#define PG8_WAIT_V(n) asm volatile("s_waitcnt vmcnt(" #n ")" ::: "memory")
#define PG8_WAIT_L(n) asm volatile("s_waitcnt lgkmcnt(" #n ")" ::: "memory")
#define PG8_BAR __builtin_amdgcn_s_barrier()
#define PG8_SCHED __builtin_amdgcn_sched_barrier(0)
    Unit cur, nxt; int ui = 0;
    if (!S.next(0, cur)) return;
    f32x4 acc[2][2][4][2];
#pragma unroll
    for (int a = 0; a < 2; ++a)
#pragma unroll
        for (int b = 0; b < 2; ++b)
#pragma unroll
            for (int m = 0; m < 4; ++m)
#pragma unroll
                for (int n = 0; n < 2; ++n) acc[a][b][m][n] = (f32x4){0.f, 0.f, 0.f, 0.f};
    bf16x8 At[4][2], B0[2][2], B1[2][2];
    const char* cA = (const char*)g.A + (size_t)cur.pm * tstep; const char* cB = (const char*)g.Bt + (size_t)cur.pn * tstep;
    S.a_ready(cur);
    if constexpr (SP2) {
        PG8_STAGE(PG8_SB(0, 0), cB, voffB); PG8_STAGE(PG8_SB(0, 1), cB + hstepB, voffB); PG8_STAGE(PG8_SA(0, 0), cA, voffA); PG8_STAGE(PG8_SA(0, 1), cA + hstep, voffA);
        if (wr == 1) PG8_BAR;
        PG8_WAIT_V(2); PG8_BAR;
        PG8_STAGE(PG8_SB(1, 0), cB + kstep, voffB); PG8_STAGE(PG8_SA(1, 0), cA + kstep, voffA); PG8_STAGE(PG8_SB(1, 1), cB + hstepB + kstep, voffB);
        PG8_WAIT_V(6); PG8_BAR;
    } else {
        PG8_STAGE(PG8_SB(0, 0), cB, voffB); PG8_STAGE(PG8_SA(0, 0), cA, voffA); PG8_STAGE(PG8_SB(0, 1), cB + hstepB, voffB); PG8_STAGE(PG8_SA(0, 1), cA + hstep, voffA);
        if (wr == 1) PG8_BAR;
        PG8_WAIT_V(4); PG8_BAR;
        PG8_STAGE(PG8_SB(1, 0), cB + kstep, voffB); PG8_STAGE(PG8_SA(1, 0), cA + kstep, voffA); PG8_STAGE(PG8_SB(1, 1), cB + hstepB + kstep, voffB);
        PG8_WAIT_V(6); PG8_BAR;
    }
    for (;;) {
        const bool has_next = S.next(ui + 1, nxt);
        const char* nA = has_next ? (const char*)g.A + (size_t)nxt.pm * tstep : cA; const char* nB = has_next ? (const char*)g.Bt + (size_t)nxt.pn * tstep : cB;
        for (int t = 0; t < nt; t += 2) {
            const bool last = (t == nt - 2);
            const char* a1 = cA + (size_t)(t + 1) * kstep;
            const char* a2 = last ? nA : cA + (size_t)(t + 2) * kstep; const char* b2 = last ? nB : cB + (size_t)(t + 2) * kstep;
            const char* a3 = a2 + kstep; const char* b3 = b2 + kstep;
            if (last && has_next) S.a_ready(nxt);
            if constexpr (SP2) {
            PG8_LDB(B0, 0, 0); PG8_LDB(B1, 0, 1); PG8_SCHED; PG8_LDA(At, 0, 0); PG8_STAGE(PG8_SA(1, 1), a1 + hstep, voffA);
            PG8_WAIT_V(8); PG8_WAIT_L(0); PG8_BAR; PG8_MMA(0, 0, At, B0); PG8_MMA(0, 1, At, B1); PG8_BAR; PG8_SCHED;
            PG8_LDA(At, 0, 1); PG8_STAGE(PG8_SB(0, 0), b2, voffB); PG8_STAGE(PG8_SB(0, 1), b2 + hstepB, voffB); PG8_STAGE(PG8_SA(0, 0), a2, voffA);
            PG8_WAIT_V(8); PG8_WAIT_L(0); PG8_BAR; PG8_MMA(1, 0, At, B0); PG8_MMA(1, 1, At, B1); PG8_BAR; PG8_SCHED;
            PG8_LDB(B0, 1, 0); PG8_LDB(B1, 1, 1); PG8_SCHED; PG8_LDA(At, 1, 0); PG8_STAGE(PG8_SA(0, 1), a2 + hstep, voffA);
            PG8_WAIT_V(8); PG8_WAIT_L(0); PG8_BAR; PG8_MMA(0, 0, At, B0); PG8_MMA(0, 1, At, B1); PG8_BAR; PG8_SCHED;
            PG8_LDA(At, 1, 1); PG8_STAGE(PG8_SB(1, 0), b3, voffB); PG8_STAGE(PG8_SB(1, 1), b3 + hstepB, voffB); PG8_STAGE(PG8_SA(1, 0), a3, voffA);
            PG8_WAIT_V(8); PG8_WAIT_L(0); PG8_BAR; PG8_MMA(1, 0, At, B0); PG8_MMA(1, 1, At, B1); PG8_BAR; PG8_SCHED;
            } else {
            PG8_LDB(B0, 0, 0); PG8_SCHED; PG8_LDA(At, 0, 0); PG8_STAGE(PG8_SA(1, 1), a1 + hstep, voffA);
            PG8_WAIT_L(8); PG8_BAR; PG8_WAIT_L(0); PG8_MMA(0, 0, At, B0); PG8_BAR; PG8_SCHED;
            PG8_LDB(B1, 0, 1); PG8_STAGE(PG8_SB(0, 0), b2, voffB);
            PG8_BAR; PG8_WAIT_L(0); PG8_MMA(0, 1, At, B1); PG8_BAR;
            PG8_LDA(At, 0, 1); PG8_STAGE(PG8_SA(0, 0), a2, voffA);
            PG8_BAR; PG8_WAIT_L(0); PG8_MMA(1, 0, At, B0); PG8_BAR; PG8_SCHED;
            PG8_STAGE(PG8_SB(0, 1), b2 + hstepB, voffB);
            PG8_WAIT_V(6); PG8_BAR; PG8_MMA(1, 1, At, B1); PG8_BAR;
            PG8_LDB(B0, 1, 0); PG8_SCHED; PG8_LDA(At, 1, 0); PG8_STAGE(PG8_SA(0, 1), a2 + hstep, voffA);
            PG8_WAIT_L(8); PG8_BAR; PG8_WAIT_L(0); PG8_MMA(0, 0, At, B0); PG8_BAR; PG8_SCHED;
            PG8_LDB(B1, 1, 1); PG8_STAGE(PG8_SB(1, 0), b3, voffB);
            PG8_BAR; PG8_WAIT_L(0); PG8_MMA(0, 1, At, B1); PG8_BAR;
            PG8_LDA(At, 1, 1); PG8_STAGE(PG8_SA(1, 0), a3, voffA);
            PG8_BAR; PG8_WAIT_L(0); PG8_MMA(1, 0, At, B0); PG8_BAR; PG8_SCHED;
            PG8_STAGE(PG8_SB(1, 1), b3 + hstepB, voffB);
            PG8_WAIT_V(6); PG8_BAR; PG8_MMA(1, 1, At, B1); PG8_BAR;
            }
        }
        if constexpr (ALIGN_EPI) { if (wr == 0) PG8_BAR; }
        if constexpr (!Epi::AFTER_DRAIN) { E(acc, cur, wr, wc, fr, fq); S.done(cur); }
        if (!has_next) break;
#pragma unroll
        for (int a = 0; a < 2; ++a)
#pragma unroll
            for (int b = 0; b < 2; ++b)
#pragma unroll
                for (int m = 0; m < 4; ++m)
#pragma unroll
                    for (int n = 0; n < 2; ++n) acc[a][b][m][n] = (f32x4){0.f, 0.f, 0.f, 0.f};
        cur = nxt; cA = nA; cB = nB; ++ui;
        if constexpr (ALIGN_EPI) { if (wr == 1) PG8_BAR; }
    }
    PG8_WAIT_V(0);
    if constexpr (!ALIGN_EPI) { if (wr == 0) PG8_BAR; }
    PG8_BAR;
    if constexpr (Epi::AFTER_DRAIN) { E.fused(acc, cur, wr, wc, fr, fq, lds, wid, lane); S.done(cur); }
#undef PG8_SA
#undef PG8_SB
#undef PG8_STAGE
#undef PG8_LDA
#undef PG8_LDB
#undef PG8_MMA
#undef PG8_WAIT_V
#undef PG8_WAIT_L
#undef PG8_BAR
#undef PG8_SCHED
}
}
namespace cg = cooperative_groups;
#define LAS __attribute__((address_space(3)))
using pg8::bf16_t; using pg8::bf16x8; using pg8::f32x4; using pg8::u32x4; using pg8::f32x2; using pg8::u32x2; using pg8::pk2; using pg8::fast_sigmoid;

constexpr int M = 65536, T = 4096, D = 1024, FF = 2816, ZC = 2816, QKVC = 1536, LOC = 1536, LAC = 256;
constexpr size_t MiB = (size_t)1 << 20;
constexpr size_t WS_SS = 1 * MiB;
constexpr size_t WS_LB = 5 * MiB;
constexpr size_t WS_RKB = 6 * MiB;
constexpr size_t WS_ROPE = 8 * MiB;
constexpr size_t WS_W = 24 * MiB;
constexpr size_t FFN_STRIDE = 16 * MiB + MiB / 2, WD_OFF = 11 * MiB;
constexpr size_t WS_WMIX = WS_W + 8 * FFN_STRIDE;
constexpr size_t EVEN_STRIDE = 8 * MiB + MiB / 4, WOUT_OFF = 5 * MiB + MiB / 2, WLORA_OFF = 7 * MiB + MiB / 2;
constexpr size_t WS_WODD = WS_WMIX + 2 * EVEN_STRIDE, ODD_STRIDE = 5 * MiB, WO_OFF = 3 * MiB;
constexpr size_t WS_XB = 184 * MiB;
constexpr size_t OUT_XL = 0, OUT_LA = 128 * MiB, OUT_YRAW = 160 * MiB;
constexpr size_t WS_HZ = 312 * MiB;
constexpr size_t WS_Y = 664 * MiB;
constexpr size_t WS_LO = 792 * MiB;
constexpr size_t WS_END = 984 * MiB;
static_assert(WS_WODD + 2 * ODD_STRIDE <= WS_XB, "ws map");
constexpr int LDS_BYTES = 147456;

struct Args {
    const float* x; const int* pos;
    const float *f1n, *f1g, *f1u, *f1d, *mixn, *f2n, *f2g, *f2u, *f2d;
    const float *win, *mu, *w0, *wdec, *a0, *waaa, *wgate, *kk, *ka, *rk, *gng, *gnb, *lng, *lnb, *wsp, *bsp, *wout;
    const float *wqkv, *bqkv, *qn, *kn, *sinks, *wo, *bo;
    float* out; unsigned char* ws;
    float inv_freq[32];
    int ph_lo, ph_hi;
};

#define KAS __attribute__((address_space(4)))
__device__ __forceinline__ const KAS Args* kargs(int off) { return (const KAS Args*)((const KAS char*)__builtin_amdgcn_kernarg_segment_ptr() + off); }
__device__ __forceinline__ float bf2f(unsigned short h) { return __uint_as_float((unsigned)h << 16); }
__device__ __forceinline__ float bflo(unsigned w) { return __uint_as_float(w << 16); }
__device__ __forceinline__ float bfhi(unsigned w) { return __uint_as_float(w & 0xffff0000u); }
__device__ __forceinline__ void unpack8(const u32x4 w, float (&f)[8]) { f[0] = bflo(w.x); f[1] = bfhi(w.x); f[2] = bflo(w.y); f[3] = bfhi(w.y); f[4] = bflo(w.z); f[5] = bfhi(w.z); f[6] = bflo(w.w); f[7] = bfhi(w.w); }
__device__ __forceinline__ u32x4 pack8(const float (&f)[8]) { return (u32x4){pk2(f[0], f[1]), pk2(f[2], f[3]), pk2(f[4], f[5]), pk2(f[6], f[7])}; }
__device__ __forceinline__ float wave_sum(float v) {
#pragma unroll
    for (int o = 1; o < 64; o <<= 1) v += __shfl_xor(v, o);
    return v;
}
template <int CTRL> __device__ __forceinline__ float dpp_mov(float x) { return __int_as_float(__builtin_amdgcn_update_dpp(0, __float_as_int(x), CTRL, 0xF, 0xF, false)); }
__device__ __forceinline__ float row16_sum(float x) { x += dpp_mov<0xB1>(x); x += dpp_mov<0x4E>(x); x += dpp_mov<0x124>(x); x += dpp_mov<0x128>(x); return x; }
__device__ __forceinline__ float row16_max(float x) { x = fmaxf(x, dpp_mov<0xB1>(x)); x = fmaxf(x, dpp_mov<0x4E>(x)); x = fmaxf(x, dpp_mov<0x124>(x)); x = fmaxf(x, dpp_mov<0x128>(x)); return x; }
__device__ __forceinline__ float wave_sum_dpp(float x) { x = row16_sum(x);
    return __int_as_float(__builtin_amdgcn_readlane(__float_as_int(x), 0)) + __int_as_float(__builtin_amdgcn_readlane(__float_as_int(x), 16)) + (__int_as_float(__builtin_amdgcn_readlane(__float_as_int(x), 32)) + __int_as_float(__builtin_amdgcn_readlane(__float_as_int(x), 48))); }
#define LDS_FENCE() asm volatile("s_waitcnt lgkmcnt(0)" ::: "memory")

__device__ __forceinline__ void tr_item(const float* W, int N, const float* gk, bf16_t* WT, int ldk, int drow, int k0, int n0, LAS float* scr, int lane) {
    f32x4 v[8];
#pragma unroll
    for (int i = 0; i < 8; ++i) { const int kk = 8 * i + (lane >> 3); v[i] = *(const f32x4*)(W + (size_t)(k0 + kk) * N + n0 + 4 * (lane & 7)); }
#pragma unroll
    for (int i = 0; i < 8; ++i) { const int kk = 8 * i + (lane >> 3); const float g = gk ? gk[k0 + kk] : 1.0f; *(LAS f32x4*)(scr + kk * 36 + 4 * (lane & 7)) = v[i] * g; }
    LDS_FENCE();
    const int c = lane & 7;
#pragma unroll
    for (int j = 0; j < 4; ++j) { const int n = (lane >> 3) + 8 * j; const LAS float* s = scr + (8 * c) * 36 + n;
        u32x4 o; o.x = pk2(s[0 * 36], s[1 * 36]); o.y = pk2(s[2 * 36], s[3 * 36]); o.z = pk2(s[4 * 36], s[5 * 36]); o.w = pk2(s[6 * 36], s[7 * 36]);
        *(u32x4*)(WT + (size_t)(drow + n) * ldk + k0 + 8 * c) = o; }
    LDS_FENCE();
}
__device__ __forceinline__ void prologue(const KAS Args& a, LAS unsigned char* lds, const int tid_, const int bid, const int nblk) {
    unsigned char* ws = a.ws;
    const int tid = tid_, lane = tid & 63, wave = tid >> 6;
    LAS float* scr = (LAS float*)(lds + wave * 16384);
    const int gw = bid * 8 + wave, NGW = nblk * 8;
    const int gt = bid * 512 + tid, NGT = nblk * 512;
    constexpr int I_GU = 16 * 88, I_DN = 44 * 32, I_FFN = 2 * I_GU + I_DN, N_FFN = 8 * I_FFN;
    constexpr int I_IN = 16 * 88, I_OUT = 16 * 32, I_QKV = 16 * 48, I_O = 16 * 32, I_MIX = I_IN + I_OUT + I_QKV + I_O;
    for (int it = gw; it < N_FFN + 2 * I_MIX; it += NGW) {
        if (it < N_FFN) {
            const int f = it / I_FFN, r = it % I_FFN, l = f >> 1, second = f & 1;
            bf16_t* wgu = (bf16_t*)(ws + WS_W + (size_t)f * FFN_STRIDE); bf16_t* wd = (bf16_t*)(ws + WS_W + (size_t)f * FFN_STRIDE + WD_OFF);
            if (r < 2 * I_GU) { const int part = r / I_GU, loc = r % I_GU, kb = loc / 88, nb = loc % 88, n0 = 32 * nb;
                const float* src = (part == 0 ? (second ? a.f2g : a.f1g) : (second ? a.f2u : a.f1u)) + (size_t)l * D * FF;
                const float* gk = (second ? a.f2n : a.f1n) + l * D;
                tr_item(src, FF, gk, wgu, D, (n0 >> 7) * 256 + (n0 & 127) + part * 128, 64 * kb, n0, scr, lane);
            } else { const int loc = r - 2 * I_GU, kb = loc / 32, nb = loc % 32;
                const float* src = (second ? a.f2d : a.f1d) + (size_t)l * FF * D;
                tr_item(src, D, nullptr, wd, FF, 32 * nb, 64 * kb, 32 * nb, scr, lane); }
        } else {
            const int r = it - N_FFN, i = r / I_MIX, q = r % I_MIX;
            if (q < I_IN) { const int kb = q / 88, nb = q % 88;
                tr_item(a.win + (size_t)i * D * ZC, ZC, a.mixn + (2 * i) * D, (bf16_t*)(ws + WS_WMIX + i * EVEN_STRIDE), D, 32 * nb, 64 * kb, 32 * nb, scr, lane);
            } else if (q < I_IN + I_OUT) { const int loc = q - I_IN, kb = loc / 32, nb = loc % 32;
                tr_item(a.wout + (size_t)i * D * D, D, nullptr, (bf16_t*)(ws + WS_WMIX + i * EVEN_STRIDE + WOUT_OFF), D, 32 * nb, 64 * kb, 32 * nb, scr, lane);
            } else if (q < I_IN + I_OUT + I_QKV) { const int loc = q - I_IN - I_OUT, kb = loc / 48, nb = loc % 48;
                tr_item(a.wqkv + (size_t)i * D * QKVC, QKVC, a.mixn + (2 * i + 1) * D, (bf16_t*)(ws + WS_WODD + i * ODD_STRIDE), D, 32 * nb, 64 * kb, 32 * nb, scr, lane);
            } else { const int loc = q - I_IN - I_OUT - I_QKV, kb = loc / 32, nb = loc % 32;
                tr_item(a.wo + (size_t)i * D * D, D, nullptr, (bf16_t*)(ws + WS_WODD + i * ODD_STRIDE + WO_OFF), D, 32 * nb, 64 * kb, 32 * nb, scr, lane); }
        }
    }
    for (int idx = gt; idx < 2 * LOC * LAC; idx += NGT) {
        const int i = idx / (LOC * LAC), e = idx % (LOC * LAC), n = e / LAC, k = e % LAC, seg = n >> 9, nn = n & 511;
        float v = 0.f;
        if (seg == 0) { if (k < 64) v = a.wdec[(size_t)i * 64 * 512 + k * 512 + nn]; }
        else if (seg == 1) { if (k >= 64 && k < 128) v = a.waaa[(size_t)i * 64 * 512 + (k - 64) * 512 + nn]; }
        else { if (k >= 128) v = a.wgate[(size_t)i * 128 * 512 + (k - 128) * 512 + nn]; }
        ((bf16_t*)(ws + WS_WMIX + i * EVEN_STRIDE + WLORA_OFF))[e] = (bf16_t)(pk2(v, 0.f) & 0xffffu);
    }
    for (int idx = gt; idx < 2 * LOC; idx += NGT) { const int i = idx / LOC, n = idx % LOC;
        ((float*)(ws + WS_LB))[idx] = (n < 512) ? a.w0[i * 512 + n] : (n < 1024 ? a.a0[i * 512 + n - 512] : 0.f); }
    { bf16_t* xb = (bf16_t*)(ws + WS_XB); bf16_t* xl = (bf16_t*)((unsigned char*)a.out + OUT_XL); float* ss0 = (float*)(ws + WS_SS);
      for (int mb = gw; mb < M; mb += 2 * NGW) { f32x4 v[2][4]; const int m1 = (mb + NGW < M) ? mb + NGW : mb;
#pragma unroll
          for (int j = 0; j < 4; ++j) { v[0][j] = ((const f32x4*)(a.x + (size_t)mb * D) + lane)[64 * j]; v[1][j] = ((const f32x4*)(a.x + (size_t)m1 * D) + lane)[64 * j]; }
#pragma unroll
          for (int k = 0; k < 2; ++k) { const int m = k ? m1 : mb; if (k && m1 == mb) break; float s = 0.f;
#pragma unroll
              for (int j = 0; j < 4; ++j) { const f32x4 w = v[k][j]; s += (w[0] * w[0] + w[1] * w[1]) + (w[2] * w[2] + w[3] * w[3]);
                  const unsigned h01 = pk2(w[0], w[1]), h23 = pk2(w[2], w[3]);
                  const unsigned l01 = pk2(w[0] - bflo(h01), w[1] - bfhi(h01)), l23 = pk2(w[2] - bflo(h23), w[3] - bfhi(h23));
                  *(u32x2*)(xb + (size_t)m * D + 4 * (lane + 64 * j)) = (u32x2){h01, h23}; *(u32x2*)(xl + (size_t)m * D + 4 * (lane + 64 * j)) = (u32x2){l01, l23}; }
              s = wave_sum(s); if (lane < 16) ss0[(size_t)m * 16 + lane] = (lane == 0) ? s : 0.f; } } }
    { float* tab = (float*)(ws + WS_ROPE);
      for (int idx = gt; idx < M * 32; idx += NGT) { const int m = idx >> 5, d = idx & 31; const float ang = (float)a.pos[m] * a.inv_freq[d];
          const double rev = (double)ang * 0.15915494309189535; const float fr = (float)(rev - __builtin_rint(rev));
          tab[(size_t)m * 64 + d] = __builtin_amdgcn_cosf(fr); tab[(size_t)m * 64 + 32 + d] = __builtin_amdgcn_sinf(fr); } }
}

__device__ __forceinline__ void el_phase(const KAS Args& a, int i, const int tid_, const int bid, const int nblk) {
    const bf16_t* Z = (const bf16_t*)(a.ws + WS_HZ); bf16_t* LA = (bf16_t*)((unsigned char*)a.out + OUT_LA);
    const float* mu = a.mu + i * 1792 + 1536;
    const int gt = bid * 512 + tid_, NGT = nblk * 512;
    for (int ib = gt; ib < M * 32; ib += 4 * NGT) { u32x4 rc[4], rp[4];
#pragma unroll
        for (int k = 0; k < 4; ++k) { const int idx = ib + k * NGT; const int ii = idx < M * 32 ? idx : ib; const int m = ii >> 5, c0 = (ii & 31) * 8, t = m & (T - 1);
            rc[k] = *(const u32x4*)(Z + (size_t)m * ZC + 1536 + c0); rp[k] = (t > 0) ? *(const u32x4*)(Z + (size_t)(m - 1) * ZC + 1536 + c0) : (u32x4){0u, 0u, 0u, 0u}; }
#pragma unroll
        for (int k = 0; k < 4; ++k) { const int idx = ib + k * NGT; if (idx >= M * 32) break; const int m = idx >> 5, c0 = (idx & 31) * 8;
            float zc[8], zp[8], o[8]; unpack8(rc[k], zc); unpack8(rp[k], zp);
#pragma unroll
            for (int e = 0; e < 8; ++e) { const float z = zc[e] + (zp[e] - zc[e]) * mu[c0 + e];
                o[e] = (c0 < 64) ? (2.0f * fast_sigmoid(2.0f * z) - 1.0f) : (c0 < 128 ? z : fast_sigmoid(z)); }
            *(u32x4*)(LA + (size_t)m * LAC + c0) = pack8(o); } }
}

constexpr int TC = 32, SST = 352;
__device__ __forceinline__ void scan_load(const bf16_t* Z, const bf16_t* LO, size_t mrow0, int t0, int tid, int colb, u32x2 (&pz)[8]) {
    const int t = t0 + (tid >> 4); const size_t m = mrow0 + t; const bf16_t* zr = Z + m * ZC + colb; const bf16_t* lo = LO + m * LOC + colb;
    pz[0] = *(const u32x2*)(zr); pz[1] = *(const u32x2*)(zr + 512); pz[2] = *(const u32x2*)(zr + 1024);
    if (t > 0) { pz[3] = *(const u32x2*)(zr - ZC); pz[4] = *(const u32x2*)(zr + 512 - ZC); pz[5] = *(const u32x2*)(zr + 1024 - ZC); } else { pz[3] = (u32x2){0u, 0u}; pz[4] = (u32x2){0u, 0u}; pz[5] = (u32x2){0u, 0u}; }
    pz[6] = *(const u32x2*)(lo); pz[7] = *(const u32x2*)(lo + 512);
}
__device__ __forceinline__ void up4(const u32x2 w, float (&f)[4]) { f[0] = bflo(w.x); f[1] = bfhi(w.x); f[2] = bflo(w.y); f[3] = bfhi(w.y); }
__device__ __forceinline__ void scan_stage(const u32x2 (&pz)[8], LAS float* buf, float* RKB, size_t mrow0, int t0, int tid, int h, int half,
                                           const float (&mu_r)[4], const float (&mu_k)[4], const float (&mu_v)[4], const float (&kkc)[4], const float (&kac)[4], const float (&rkc)[4]) {
    const int tl = tid >> 4, cgp = tid & 15;
    float zr[4], zk[4], zv[4], zrp[4], zkp[4], zvp[4], ew[4], ic[4];
    up4(pz[0], zr); up4(pz[1], zk); up4(pz[2], zv); up4(pz[3], zrp); up4(pz[4], zkp); up4(pz[5], zvp); up4(pz[6], ew); up4(pz[7], ic);
    f32x4 r, k2, v, kkv, w; float n2 = 0.f, rkb = 0.f;
#pragma unroll
    for (int e = 0; e < 4; ++e) { r[e] = zr[e] + (zrp[e] - zr[e]) * mu_r[e]; const float k = zk[e] + (zkp[e] - zk[e]) * mu_k[e]; v[e] = zv[e] + (zvp[e] - zv[e]) * mu_v[e];
        kkv[e] = k * kkc[e]; n2 += kkv[e] * kkv[e]; k2[e] = k * (1.0f + (ic[e] - 1.0f) * kac[e]); w[e] = __builtin_amdgcn_exp2f(-1.4426950408889634f * ew[e]); rkb += r[e] * k2[e] * rkc[e]; }
    n2 = row16_sum(n2); rkb = row16_sum(rkb);
    const float inv = __builtin_amdgcn_rsqf(fmaxf(n2, 1e-24f));
    const f32x4 kkn = kkv * inv; f32x4 nb;
#pragma unroll
    for (int e = 0; e < 4; ++e) nb[e] = -kkn[e] * ic[e];
    if (half == 0 && cgp == 0) RKB[(mrow0 + t0 + tl) * 8 + h] = rkb;
    LAS float* sb = buf + tl * SST + 4 * cgp;
    *(LAS f32x4*)(sb) = kkn; *(LAS f32x4*)(sb + 64) = nb; *(LAS f32x4*)(sb + 128) = w; *(LAS f32x4*)(sb + 192) = k2; *(LAS f32x4*)(sb + 256) = r;
    if ((cgp >> 3) == half) *(LAS f32x4*)(buf + tl * SST + 320 + 4 * (cgp & 7)) = v;
}
__device__ __forceinline__ void scan_phase(const KAS Args& a, LAS unsigned char* lds, int i, const int tid_, const int bid, const int nblk) {
    const int tid = tid_, lane = tid & 63, wave = __builtin_amdgcn_readfirstlane(tid >> 6);
    const bf16_t* Z = (const bf16_t*)(a.ws + WS_HZ); const bf16_t* LO = (const bf16_t*)(a.ws + WS_LO);
    bf16_t* YR = (bf16_t*)((unsigned char*)a.out + OUT_YRAW); float* RKB = (float*)(a.ws + WS_RKB);
    LAS float* bufs = (LAS float*)lds; LAS float* ybuf = bufs + 2 * TC * SST;
    for (int unit = bid; unit < 256; unit += nblk) {
        const int bh = unit >> 1, half = unit & 1, b = bh >> 3, h = bh & 7, colb = h * 64 + 4 * (tid & 15);
        float mu_r[4], mu_k[4], mu_v[4], kkc[4], kac[4], rkc[4];
#pragma unroll
        for (int e = 0; e < 4; ++e) { mu_r[e] = a.mu[i * 1792 + colb + e]; mu_k[e] = a.mu[i * 1792 + 512 + colb + e]; mu_v[e] = a.mu[i * 1792 + 1024 + colb + e];
            kkc[e] = a.kk[i * 512 + colb + e]; kac[e] = a.ka[i * 512 + colb + e]; rkc[e] = a.rk[i * 512 + colb + e]; }
        const size_t mrow0 = (size_t)b * T;
        const int rl = wave * 4 + (lane >> 4), cgp = lane & 15;
        f32x4 S = {0.f, 0.f, 0.f, 0.f};
        u32x2 pz[8];
        __syncthreads();
        scan_load(Z, LO, mrow0, 0, tid, colb, pz);
        scan_stage(pz, bufs, RKB, mrow0, 0, tid, h, half, mu_r, mu_k, mu_v, kkc, kac, rkc);
        __syncthreads();
        for (int c = 0; c < T / TC; ++c) {
            const bool more = (c + 1 < T / TC);
            if (more) scan_load(Z, LO, mrow0, (c + 1) * TC, tid, colb, pz);
            const LAS float* buf = bufs + (c & 1) * (TC * SST); LAS float* yb = ybuf + (c & 1) * (TC * 32);
            {
                const LAS float* sb = buf + 4 * cgp; const LAS float* vb = buf + 320 + rl;
                f32x4 kk4 = *(const LAS f32x4*)(sb), nb4 = *(const LAS f32x4*)(sb + 64), w4 = *(const LAS f32x4*)(sb + 128), k4 = *(const LAS f32x4*)(sb + 192), r4 = *(const LAS f32x4*)(sb + 256);
                float v = vb[0], ysel = 0.f;
#pragma unroll
                for (int t = 0; t < TC; ++t) {
                    f32x4 kk4n = kk4, nb4n = nb4, w4n = w4, k4n = k4, r4n = r4; float vn = v;
                    if (t + 1 < TC) { const LAS float* sn = sb + (t + 1) * SST;
                        kk4n = *(const LAS f32x4*)(sn); nb4n = *(const LAS f32x4*)(sn + 64); w4n = *(const LAS f32x4*)(sn + 128); k4n = *(const LAS f32x4*)(sn + 192); r4n = *(const LAS f32x4*)(sn + 256); vn = vb[(t + 1) * SST]; }
                    __builtin_amdgcn_sched_barrier(0x6);
                    float sa = fmaf(S[3], kk4[3], fmaf(S[2], kk4[2], fmaf(S[1], kk4[1], S[0] * kk4[0])));
                    const f32x4 Tm = S * w4 + k4 * v;
                    sa = row16_sum(sa);
                    S = Tm + nb4 * sa;
                    float y = fmaf(S[3], r4[3], fmaf(S[2], r4[2], fmaf(S[1], r4[1], S[0] * r4[0]))); y = row16_sum(y);
                    ysel = (cgp == (t & 15)) ? y : ysel;
                    if ((t & 15) == 15) yb[(t - 15 + cgp) * 32 + rl] = ysel;
                    kk4 = kk4n; nb4 = nb4n; w4 = w4n; k4 = k4n; r4 = r4n; v = vn; }
            }
            if (more) scan_stage(pz, bufs + ((c + 1) & 1) * (TC * SST), RKB, mrow0, (c + 1) * TC, tid, h, half, mu_r, mu_k, mu_v, kkc, kac, rkc);
            __syncthreads();
#pragma unroll
            for (int q = 0; q < 2; ++q) { const int idx = tid + 512 * q, t = idx >> 5, r = idx & 31;
                YR[(mrow0 + c * TC + t) * 512 + h * 64 + half * 32 + r] = (bf16_t)(pk2(yb[t * 32 + r], 0.f) & 0xffffu); }
        }
    }
}

__device__ __forceinline__ void post_phase(const KAS Args& a, LAS unsigned char* lds, int i, const int tid_, const int bid, const int nblk) {
    const int tid = tid_, lane = tid & 63, wave = __builtin_amdgcn_readfirstlane(tid >> 6);
    const bf16_t* Z = (const bf16_t*)(a.ws + WS_HZ); const bf16_t* LO = (const bf16_t*)(a.ws + WS_LO); const bf16_t* YR = (const bf16_t*)((unsigned char*)a.out + OUT_YRAW);
    const float* RKB = (const float*)(a.ws + WS_RKB); bf16_t* Y = (bf16_t*)(a.ws + WS_Y);
    { const int c0 = 8 * lane; float gg[8], gb[8], muv[8];
#pragma unroll
      for (int e = 0; e < 8; ++e) { gg[e] = a.gng[i * 512 + c0 + e]; gb[e] = a.gnb[i * 512 + c0 + e]; muv[e] = a.mu[i * 1792 + 1024 + c0 + e]; }
      const int stride = nblk * 8;
      for (int mb = bid * 8 + wave; mb < M; mb += 2 * stride) {
          u32x4 ry[2], rvc[2], rvp[2], rg[2]; float bon[2]; bool has[2];
#pragma unroll
          for (int k = 0; k < 2; ++k) { const int m = mb + k * stride; has[k] = (m < M); const int mm = has[k] ? m : mb; const int t = mm & (T - 1);
              ry[k] = *(const u32x4*)(YR + (size_t)mm * 512 + c0); rvc[k] = *(const u32x4*)(Z + (size_t)mm * ZC + 1024 + c0);
              rvp[k] = (t > 0) ? *(const u32x4*)(Z + (size_t)(mm - 1) * ZC + 1024 + c0) : (u32x4){0u, 0u, 0u, 0u};
              rg[k] = *(const u32x4*)(LO + (size_t)mm * LOC + 1024 + c0); bon[k] = RKB[(size_t)mm * 8 + (lane >> 3)]; }
#pragma unroll
          for (int k = 0; k < 2; ++k) { const int m = mb + k * stride;
              float y[8], vc[8], vp[8], g[8], o[8];
              unpack8(ry[k], y); unpack8(rvc[k], vc); unpack8(rvp[k], vp); unpack8(rg[k], g);
              float s = 0.f;
#pragma unroll
              for (int e = 0; e < 8; ++e) s += y[e];
              s += __shfl_xor(s, 1); s += __shfl_xor(s, 2); s += __shfl_xor(s, 4);
              const float mean = s * (1.0f / 64.0f); float q = 0.f;
#pragma unroll
              for (int e = 0; e < 8; ++e) { const float d = y[e] - mean; q += d * d; }
              q += __shfl_xor(q, 1); q += __shfl_xor(q, 2); q += __shfl_xor(q, 4);
              const float rstd = 1.0f / sqrtf(q * (1.0f / 64.0f) + 64e-5f);
#pragma unroll
              for (int e = 0; e < 8; ++e) { const float vs = vc[e] + (vp[e] - vc[e]) * muv[e]; o[e] = ((y[e] - mean) * rstd * gg[e] + gb[e] + bon[k] * vs) * g[e]; }
              if (has[k]) *(u32x4*)(Y + (size_t)m * D + c0) = pack8(o); } } }
    LAS float* stat = (LAS float*)lds;
    LAS bf16_t* Wl = (LAS bf16_t*)(lds + 1024);
    LAS bf16_t* St = (LAS bf16_t*)(lds + 1024 + 128 * 136 * 2);
    const int l15 = lane & 15, l4 = lane >> 4;
    for (int ch = bid; ch < M / 128; ch += nblk) { const size_t m0 = (size_t)ch * 128;
        __syncthreads();
#pragma unroll 1
        for (int tb = 0; tb < 16; tb += 4) { u32x4 raw[4];
#pragma unroll
            for (int k = 0; k < 4; ++k) raw[k] = *(const u32x4*)(Z + (m0 + wave * 16 + tb + k) * ZC + 2304 + 8 * lane);
#pragma unroll
            for (int k = 0; k < 4; ++k) { const int tok = wave * 16 + tb + k; float sv[8]; unpack8(raw[k], sv); float s = 0.f;
#pragma unroll
                for (int e = 0; e < 8; e += 2) { const f32x2 gq = pg8::gelu_pk((f32x2){sv[e], sv[e + 1]}); sv[e] = gq.x; sv[e + 1] = gq.y; s += gq.x + gq.y; }
                const float mean = wave_sum(s) * (1.0f / 512.0f); float q = 0.f;
#pragma unroll
                for (int e = 0; e < 8; ++e) { const float d = sv[e] - mean; q += d * d; }
                const float rstd = 1.0f / sqrtf(wave_sum(q) * (1.0f / 512.0f) + 1e-5f);
                if (lane == 0) { stat[2 * tok] = mean; stat[2 * tok + 1] = rstd; } } }
        const int stok = tid >> 2, spart = tid & 3, etok = 16 * wave + l15;
        u32x4 raw[4]; f32x4 wr0[4], wr1[4];
#define GM_LOAD(G) do { const float* wsrc_ = a.wsp + ((size_t)(i * 4 + (G)) * 128 + stok) * 128 + 32 * spart; _Pragma("unroll") for (int q = 0; q < 4; ++q) { \
        raw[q] = *(const u32x4*)(Z + (m0 + stok) * ZC + 2304 + (G) * 128 + 32 * spart + 8 * q); wr0[q] = *(const f32x4*)(wsrc_ + 8 * q); wr1[q] = *(const f32x4*)(wsrc_ + 8 * q + 4); } } while (0)
        GM_LOAD(0);
#pragma unroll 1
        for (int g = 0; g < 4; ++g) {
            __syncthreads();
            { const float mean = stat[2 * stok], rstd = stat[2 * stok + 1];
#pragma unroll
              for (int q = 0; q < 4; ++q) { float sv[8], wv[8]; const int d0 = 32 * spart + 8 * q;
                  unpack8(raw[q], sv);
#pragma unroll
                  for (int e = 0; e < 8; e += 2) { const f32x2 gq = pg8::gelu_pk((f32x2){sv[e], sv[e + 1]}); sv[e] = gq.x; sv[e + 1] = gq.y; }
#pragma unroll
                  for (int e = 0; e < 8; ++e) { const int dd = g * 128 + d0 + e; const float sn = (sv[e] - mean) * rstd * a.lng[i * 512 + dd] + a.lnb[i * 512 + dd];
                      St[(d0 + e) * 136 + stok] = (bf16_t)(pk2(sn, 0.f) & 0xffffu); }
#pragma unroll
                  for (int e = 0; e < 4; ++e) { wv[e] = (d0 + e <= stok) ? wr0[q][e] : 0.f; wv[4 + e] = (d0 + 4 + e <= stok) ? wr1[q][e] : 0.f; }
                  *(LAS u32x4*)(Wl + stok * 136 + d0) = pack8(wv); } }
            if (g < 3) GM_LOAD(g + 1);
            u32x2 uz[8];
#pragma unroll
            for (int dt = 0; dt < 8; ++dt) uz[dt] = *(const u32x2*)(Z + (m0 + etok) * ZC + 1792 + g * 128 + 16 * dt + 4 * l4);
            const float bs = a.bsp[(i * 4 + g) * 128 + etok];
            __syncthreads();
            f32x4 acc[8];
#pragma unroll
            for (int dt = 0; dt < 8; ++dt) acc[dt] = (f32x4){0.f, 0.f, 0.f, 0.f};
#pragma unroll
            for (int ks = 0; ks < 4; ++ks) { const bf16x8 wf = *(const LAS bf16x8*)(Wl + (16 * wave + l15) * 136 + 32 * ks + 8 * l4);
#pragma unroll
                for (int dt = 0; dt < 8; ++dt) { const bf16x8 sf = *(const LAS bf16x8*)(St + (16 * dt + l15) * 136 + 32 * ks + 8 * l4);
                    acc[dt] = __builtin_amdgcn_mfma_f32_16x16x32_bf16(sf, wf, acc[dt], 0, 0, 0); } }
#pragma unroll
            for (int dt = 0; dt < 8; ++dt) { const f32x2 u0 = pg8::gelu_pk((f32x2){bflo(uz[dt].x), bfhi(uz[dt].x)}), u1 = pg8::gelu_pk((f32x2){bflo(uz[dt].y), bfhi(uz[dt].y)});
                *(u32x2*)(Y + (m0 + etok) * D + 512 + g * 128 + 16 * dt + 4 * l4) = (u32x2){pk2(u0.x * (acc[dt][0] + bs), u0.y * (acc[dt][1] + bs)), pk2(u1.x * (acc[dt][2] + bs), u1.y * (acc[dt][3] + bs))}; }
        }
#undef GM_LOAD
    }
}

__device__ __forceinline__ void attn_phase(const KAS Args& a, LAS unsigned char* lds, int i, const int tid_, const int bid, const int nblk) {
    const int tid = tid_, lane = tid & 63, wave = __builtin_amdgcn_readfirstlane(tid >> 6);
    const int l15 = lane & 15, l4 = lane >> 4;
    const bf16_t* QKV = (const bf16_t*)(a.ws + WS_HZ); bf16_t* Y = (bf16_t*)(a.ws + WS_Y); const float* tab = (const float*)(a.ws + WS_ROPE);
    LAS bf16_t* Ks = (LAS bf16_t*)lds;
    LAS bf16_t* Vt = (LAS bf16_t*)(lds + 36864);
    LAS bf16_t* Pb = (LAS bf16_t*)(lds + 36864 + 33792) + wave * (16 * 168);
    const float* qn = a.qn + i * 64; const float* kn = a.kn + i * 64;
    for (int unit = bid; unit < 16 * 4 * 32; unit += nblk) {
        const int b = unit >> 7, kvh = (unit >> 5) & 3, n = unit & 31;
        const size_t m0 = (size_t)b * T + n * 128;
        __syncthreads();
        { const int key = tid >> 1, hh = tid & 1; const bool valid = (n > 0) || (key >= 128); const size_t mk = m0 + key - 128;
          float x1[16], x2[16];
          if (valid) { const bf16_t* kp = QKV + mk * QKVC + 1024 + kvh * 64 + 16 * hh; float t8[8];
              unpack8(*(const u32x4*)(kp), t8);
#pragma unroll
              for (int e = 0; e < 8; ++e) x1[e] = t8[e];
              unpack8(*(const u32x4*)(kp + 8), t8);
#pragma unroll
              for (int e = 0; e < 8; ++e) x1[8 + e] = t8[e];
              unpack8(*(const u32x4*)(kp + 32), t8);
#pragma unroll
              for (int e = 0; e < 8; ++e) x2[e] = t8[e];
              unpack8(*(const u32x4*)(kp + 40), t8);
#pragma unroll
              for (int e = 0; e < 8; ++e) x2[8 + e] = t8[e];
          } else {
#pragma unroll
              for (int e = 0; e < 16; ++e) { x1[e] = 0.f; x2[e] = 0.f; } }
          float s = 0.f;
#pragma unroll
          for (int e = 0; e < 16; ++e) s += x1[e] * x1[e] + x2[e] * x2[e];
          s += __shfl_xor(s, 1);
          const float rms = 1.0f / sqrtf(s * (1.0f / 64.0f) + 1e-6f);
          float o1[16], o2[16];
#pragma unroll
          for (int e = 0; e < 16; ++e) { const int d = 16 * hh + e; float c = 1.f, sn = 0.f; if (valid) { c = tab[mk * 64 + d]; sn = tab[mk * 64 + 32 + d]; }
              const float a1 = x1[e] * rms * kn[d], a2 = x2[e] * rms * kn[32 + d]; o1[e] = a1 * c - a2 * sn; o2[e] = a2 * c + a1 * sn; }
          LAS bf16_t* kd = Ks + key * 72 + 16 * hh;
          *(LAS u32x4*)(kd) = (u32x4){pk2(o1[0], o1[1]), pk2(o1[2], o1[3]), pk2(o1[4], o1[5]), pk2(o1[6], o1[7])};
          *(LAS u32x4*)(kd + 8) = (u32x4){pk2(o1[8], o1[9]), pk2(o1[10], o1[11]), pk2(o1[12], o1[13]), pk2(o1[14], o1[15])};
          *(LAS u32x4*)(kd + 32) = (u32x4){pk2(o2[0], o2[1]), pk2(o2[2], o2[3]), pk2(o2[4], o2[5]), pk2(o2[6], o2[7])};
          *(LAS u32x4*)(kd + 40) = (u32x4){pk2(o2[8], o2[9]), pk2(o2[10], o2[11]), pk2(o2[12], o2[13]), pk2(o2[14], o2[15])};
        }
        { const int kp = (wave & 1) * 64 + lane, dq = wave >> 1; const bool valid = (n > 0) || (kp >= 64); const size_t mk = m0 + 2 * kp - 128;
          u32x4 va0 = {0u, 0u, 0u, 0u}, va1 = va0, vb0 = va0, vb1 = va0;
          if (valid) { const bf16_t* vp = QKV + mk * QKVC + 1280 + kvh * 64 + 16 * dq; va0 = *(const u32x4*)(vp); va1 = *(const u32x4*)(vp + 8); vb0 = *(const u32x4*)(vp + QKVC); vb1 = *(const u32x4*)(vp + QKVC + 8); }
          LAS unsigned* vt32 = (LAS unsigned*)Vt;
#define VT_ST(dd, A, B) vt32[((16 * dq + (dd)) * 264 + 2 * kp) >> 1] = ((A) & 0xffffu) | ((B) << 16); vt32[((16 * dq + (dd) + 1) * 264 + 2 * kp) >> 1] = ((A) >> 16) | ((B) & 0xffff0000u)
          VT_ST(0, va0.x, vb0.x); VT_ST(2, va0.y, vb0.y); VT_ST(4, va0.z, vb0.z); VT_ST(6, va0.w, vb0.w);
          VT_ST(8, va1.x, vb1.x); VT_ST(10, va1.y, vb1.y); VT_ST(12, va1.z, vb1.z); VT_ST(14, va1.w, vb1.w);
#undef VT_ST
        }
        __syncthreads();
        const int g = wave >> 1, qh = kvh * 4 + g; const float sink = a.sinks[i * 16 + qh];
#pragma unroll 1
        for (int pass = 0; pass < 2; ++pass) { const int i0 = (wave & 1) * 64 + pass * 32;
            bf16x8 qf[2][2];
#pragma unroll
            for (int rt = 0; rt < 2; ++rt) { const size_t mq = m0 + i0 + 16 * rt + l15; const bf16_t* qp = QKV + mq * QKVC + qh * 64 + 8 * l4; float x1[8], x2[8];
                unpack8(*(const u32x4*)(qp), x1); unpack8(*(const u32x4*)(qp + 32), x2);
                float s = 0.f;
#pragma unroll
                for (int e = 0; e < 8; ++e) s += x1[e] * x1[e] + x2[e] * x2[e];
                s += __shfl_xor(s, 16); s += __shfl_xor(s, 32);
                const float rms = 0.125f * __builtin_amdgcn_rsqf(s * (1.0f / 64.0f) + 1e-6f);
                float o1[8], o2[8];
#pragma unroll
                for (int e = 0; e < 8; ++e) { const int d = 8 * l4 + e; const float c = tab[mq * 64 + d], sn = tab[mq * 64 + 32 + d];
                    const float a1 = x1[e] * rms * qn[d], a2 = x2[e] * rms * qn[32 + d]; o1[e] = a1 * c - a2 * sn; o2[e] = a2 * c + a1 * sn; }
                qf[rt][0] = __builtin_bit_cast(bf16x8, pack8(o1)); qf[rt][1] = __builtin_bit_cast(bf16x8, pack8(o2)); }
            f32x4 sc[2][10];
#pragma unroll
            for (int rt = 0; rt < 2; ++rt)
#pragma unroll
                for (int kt = 0; kt < 10; ++kt) sc[rt][kt] = (f32x4){0.f, 0.f, 0.f, 0.f};
#pragma unroll
            for (int kt = 0; kt < 10; ++kt)
#pragma unroll
                for (int ks = 0; ks < 2; ++ks) { const bf16x8 kf = *(const LAS bf16x8*)(Ks + (i0 + 16 * kt + l15) * 72 + 32 * ks + 8 * l4);
#pragma unroll
                    for (int rt = 0; rt < 2; ++rt) if (kt - rt >= 0 && kt - rt <= 8) sc[rt][kt] = __builtin_amdgcn_mfma_f32_16x16x32_bf16(kf, qf[rt][ks], sc[rt][kt], 0, 0, 0); }
#pragma unroll
            for (int rt = 0; rt < 2; ++rt) {
                float mx = -INFINITY;
#pragma unroll
                for (int kt = 0; kt < 10; ++kt) { const int dk = kt - rt;
                    if (dk < 0 || dk > 8) continue;
#pragma unroll
                    for (int reg = 0; reg < 4; ++reg) { float sv = sc[rt][kt][reg];
                        if (dk == 0) sv = (4 * l4 + reg > l15) ? sv : -INFINITY;
                        if (dk == 8) sv = (4 * l4 + reg <= l15) ? sv : -INFINITY;
                        if (n == 0) sv = (i0 + 16 * kt + 4 * l4 + reg >= 128) ? sv : -INFINITY;
                        sc[rt][kt][reg] = sv; mx = fmaxf(mx, sv); } }
                mx = fmaxf(mx, __shfl_xor(mx, 16)); mx = fmaxf(mx, __shfl_xor(mx, 32)); mx = fmaxf(mx, sink);
                const float mneg = -mx * 1.4426950408889634f; float sum = 0.f;
#pragma unroll
                for (int kt = 0; kt < 10; ++kt) { const int dk = kt - rt;
                    if (dk < 0 || dk > 8) { sc[rt][kt] = (f32x4){0.f, 0.f, 0.f, 0.f}; continue; }
#pragma unroll
                    for (int reg = 0; reg < 4; ++reg) { const float p = __builtin_amdgcn_exp2f(fmaf(sc[rt][kt][reg], 1.4426950408889634f, mneg)); sc[rt][kt][reg] = p; sum += p; } }
                sum += __shfl_xor(sum, 16); sum += __shfl_xor(sum, 32);
                sum += __builtin_amdgcn_exp2f(fmaf(sink, 1.4426950408889634f, mneg));
                const float rden = __builtin_amdgcn_rcpf(sum);
                f32x4 o[4];
#pragma unroll
                for (int dt = 0; dt < 4; ++dt) o[dt] = (f32x4){0.f, 0.f, 0.f, 0.f};
#pragma unroll
                for (int ks = 0; ks < 5; ++ks) { const f32x4 pa = sc[rt][2 * ks], pb = sc[rt][2 * ks + 1];
                    const bf16x8 pf = __builtin_bit_cast(bf16x8, (u32x4){pk2(pa[0], pa[1]), pk2(pa[2], pa[3]), pk2(pb[0], pb[1]), pk2(pb[2], pb[3])});
#pragma unroll
                    for (int dt = 0; dt < 4; ++dt) { const LAS bf16_t* vp = Vt + (16 * dt + l15) * 264 + i0 + 32 * ks + 4 * l4;
                        const u32x2 v0 = *(const LAS u32x2*)(vp), v1 = *(const LAS u32x2*)(vp + 16);
                        const bf16x8 vf = __builtin_bit_cast(bf16x8, (u32x4){v0.x, v0.y, v1.x, v1.y});
                        o[dt] = __builtin_amdgcn_mfma_f32_16x16x32_bf16(vf, pf, o[dt], 0, 0, 0); } }
                { const size_t mq = m0 + i0 + 16 * rt + l15;
#pragma unroll
                  for (int dt = 0; dt < 4; ++dt) *(u32x2*)(Y + mq * D + qh * 64 + 16 * dt + 4 * l4) = (u32x2){pk2(o[dt][0] * rden, o[dt][1] * rden), pk2(o[dt][2] * rden, o[dt][3] * rden)}; }
            }
        }
    }
}

#define XB_TMO      128
#define XB_XCNT(j)  (256  + 64 * (j))
#define XB_XSUB(j)  (1280 + 64 * (j))
#define XB_XGEN(j)  (2304 + 64 * (j))
#define XB_TOP      3328
#define XB_TOPGEN   3392
#define XCD_BAR_WORDS 3456
#define XB_SPIN_CAP (1u << 18)

__device__ __forceinline__ unsigned xb_ld(unsigned* p)              { return __hip_atomic_load(p, __ATOMIC_RELAXED, __HIP_MEMORY_SCOPE_AGENT); }
__device__ __forceinline__ unsigned xb_add(unsigned* p, unsigned v) { return __hip_atomic_fetch_add(p, v, __ATOMIC_RELAXED, __HIP_MEMORY_SCOPE_AGENT); }
__device__ __forceinline__ unsigned xb_xcc_id() { return (unsigned)__builtin_amdgcn_s_getreg((3 << 11) | 20) & 0xFu; }
#define XB_SPIN(cond, bar) do { unsigned _sp = 0; while (cond) { __builtin_amdgcn_s_sleep(1); \
    if ((++_sp & 255u) == 0u) { if (xb_ld(&(bar)[XB_TMO])) break; if (_sp > XB_SPIN_CAP) { atomicAdd(&(bar)[XB_TMO], 1u); break; } } } } while (0)

struct XcdBarrier {
    unsigned* bar; unsigned x;
    volatile LAS unsigned* st;
};

__device__ __forceinline__ XcdBarrier xcd_barrier_post(unsigned* bar, volatile LAS unsigned* st) {
    XcdBarrier b; b.bar = bar; b.x = xb_xcc_id(); b.st = st;
    if (threadIdx.x == 0) (void)xb_add(&bar[XB_XCNT(b.x)], 1u);
    return b;
}
__device__ __forceinline__ void xcd_barrier_complete(unsigned* bar, unsigned x, unsigned& nloc, unsigned& nx) {
    const unsigned G = gridDim.x * gridDim.y * gridDim.z;
    unsigned sum, cnt, mine, sp = 0u;
    for (;;) {
        sum = 0u; cnt = 0u; mine = 0u;
#pragma unroll
        for (unsigned j = 0; j < 16; ++j) { const unsigned c = xb_ld(&bar[XB_XCNT(j)]); sum += c; cnt += (c > 0u) ? 1u : 0u; mine = (j == x) ? c : mine; }
        if (sum == G) break;
        __builtin_amdgcn_s_sleep(1);
        if ((++sp & 255u) == 0u) { if (xb_ld(&bar[XB_TMO])) break; if (sp > XB_SPIN_CAP) { atomicAdd(&bar[XB_TMO], 1u); break; } }
    }
    nloc = mine > 0u ? mine : 1u; nx = cnt > 0u ? cnt : 1u;
}

__device__ __forceinline__ void xcd_barrier(const XcdBarrier& b) {
    asm volatile("s_waitcnt vmcnt(0)" ::: "memory");
    __syncthreads();
    if (threadIdx.x == 0) {
        unsigned* bar = b.bar;
        __builtin_amdgcn_s_waitcnt(0);
        unsigned nloc = b.st[0], nx = b.st[1];
        if (nloc == 0u) { xcd_barrier_complete(bar, b.x, nloc, nx); b.st[0] = nloc; b.st[1] = nx; }
        const unsigned old = xb_add(&bar[XB_XSUB(b.x)], 1u);
        const unsigned gen = old / nloc;
        if (old + 1u == (gen + 1u) * nloc) {
            __builtin_amdgcn_fence(__ATOMIC_RELEASE, "agent");
            asm volatile("s_waitcnt vmcnt(0)" ::: "memory");
            const unsigned og = xb_add(&bar[XB_TOP], 1u);
            const unsigned tg = og / nx;
            if (og + 1u == (tg + 1u) * nx) xb_add(&bar[XB_TOPGEN], 1u);
            else XB_SPIN(xb_ld(&bar[XB_TOPGEN]) == tg, bar);
            __builtin_amdgcn_fence(__ATOMIC_ACQUIRE, "agent");
            xb_add(&bar[XB_XGEN(b.x)], 1u);
            asm volatile("s_waitcnt vmcnt(0)" ::: "memory");
        } else {
            XB_SPIN(xb_ld(&bar[XB_XGEN(b.x)]) == gen, bar);
            __builtin_amdgcn_fence(__ATOMIC_ACQUIRE, "agent");
            asm volatile("s_waitcnt vmcnt(0)" ::: "memory");
        }
    }
    __syncthreads();
}
#ifndef PROBE_KIND
#define PROBE_KIND -1
#endif
#if PROBE_KIND == 6
constexpr int NE = 11, NO = 7; __device__ const signed char EVEN_K[NE] = {1, 2, 3, 4, 5, 6, 6, 7, 8, 1, 2}, EVEN_S[NE] = {0, 0, 0, 0, 0, 0, 0, 0, 0, 1, 1}, ODD_K[NO] = {1, 2, 3, 9, 8, 1, 2}, ODD_S[NO] = {0, 0, 0, 0, 0, 1, 1};
#elif PROBE_KIND == 7
constexpr int NE = 11, NO = 7; __device__ const signed char EVEN_K[NE] = {1, 2, 3, 4, 5, 6, 7, 7, 8, 1, 2}, EVEN_S[NE] = {0, 0, 0, 0, 0, 0, 0, 0, 0, 1, 1}, ODD_K[NO] = {1, 2, 3, 9, 8, 1, 2}, ODD_S[NO] = {0, 0, 0, 0, 0, 1, 1};
#elif PROBE_KIND == 9
constexpr int NE = 10, NO = 8; __device__ const signed char EVEN_K[NE] = {1, 2, 3, 4, 5, 6, 7, 8, 1, 2}, EVEN_S[NE] = {0, 0, 0, 0, 0, 0, 0, 0, 1, 1}, ODD_K[NO] = {1, 2, 3, 9, 9, 8, 1, 2}, ODD_S[NO] = {0, 0, 0, 0, 0, 0, 1, 1};
#elif PROBE_KIND == 1
constexpr int NE = 12, NO = 9; __device__ const signed char EVEN_K[NE] = {1, 1, 2, 3, 4, 5, 6, 7, 8, 1, 1, 2}, EVEN_S[NE] = {0, 0, 0, 0, 0, 0, 0, 0, 0, 1, 1, 1}, ODD_K[NO] = {1, 1, 2, 3, 9, 8, 1, 1, 2}, ODD_S[NO] = {0, 0, 0, 0, 0, 0, 1, 1, 1};
#elif PROBE_KIND == 3
constexpr int NE = 12, NO = 8; __device__ const signed char EVEN_K[NE] = {1, 2, 3, 3, 4, 5, 5, 6, 7, 8, 1, 2}, EVEN_S[NE] = {0, 0, 0, 0, 0, 0, 0, 0, 0, 0, 1, 1}, ODD_K[NO] = {1, 2, 3, 3, 9, 8, 1, 2}, ODD_S[NO] = {0, 0, 0, 0, 0, 0, 1, 1};
#else
constexpr int NE = 10, NO = 7; __device__ const signed char EVEN_K[NE] = {1, 2, 3, 4, 5, 6, 7, 8, 1, 2}, EVEN_S[NE] = {0, 0, 0, 0, 0, 0, 0, 0, 1, 1}, ODD_K[NO] = {1, 2, 3, 9, 8, 1, 2}, ODD_S[NO] = {0, 0, 0, 0, 0, 1, 1};
#endif
constexpr int N_PHASES = 1 + 2 * (NE + NO);
__global__ void __launch_bounds__(512) mega_fwd(Args a_) {
    extern __shared__ __attribute__((aligned(16))) unsigned char lds_raw[];
    cg::grid_group grid = cg::this_grid();
    const int ph_lo = a_.ph_lo, ph_hi = a_.ph_hi;
    volatile LAS unsigned* MISC = (volatile LAS unsigned*)((LAS unsigned char*)lds_raw + 131072 + 320);
    if (threadIdx.x < 32) MISC[threadIdx.x] = 0u;
    __syncthreads();
    XcdBarrier xbar; xbar.bar = (unsigned*)a_.ws; xbar.x = 0; xbar.st = nullptr;
    if (ph_hi - ph_lo > 1) xbar = xcd_barrier_post((unsigned*)a_.ws, MISC + 8);
    for (int ph = ph_lo; ph < ph_hi; ++ph) {
        int koff = 0, bid = blockIdx.x, nblk = gridDim.x, tid_ = threadIdx.x; asm volatile("" : "+s"(koff), "+s"(bid), "+s"(nblk), "+v"(tid_));
        LAS unsigned char* lds = (LAS unsigned char*)lds_raw + koff;
        const KAS Args& a = *kargs(koff);
        unsigned char* ws = a.ws;
        float* ssb = (float*)(ws + WS_SS);
        bf16_t* XB = (bf16_t*)(ws + WS_XB); bf16_t* HZ = (bf16_t*)(ws + WS_HZ); bf16_t* YB = (bf16_t*)(ws + WS_Y);
        int kind = 0, l = 0, second = 0;
        if (ph > 0) { const int p = ph - 1, pair = p / (NE + NO), q = p % (NE + NO);
            if (q < NE) { l = 2 * pair; kind = EVEN_K[q]; second = EVEN_S[q]; }
            else { l = 2 * pair + 1; kind = ODD_K[q - NE]; second = ODD_S[q - NE]; } }
        const int i = l >> 1, odd = l & 1, f = 2 * l + second;
#ifndef PHM
#define PHM 0x3ff
#endif
        if (kind == 0) { if (PHM & 1) prologue(a, lds, tid_, bid, nblk); }
        else if (kind == 1 && (PHM & 2)) {
            pg8::Gemm g{XB, (const bf16_t*)(ws + WS_W + (size_t)f * FFN_STRIDE), M, 2 * FF, D}; pg8::StaticOrder S; S.init(M, 2 * FF, nblk, bid);
            pg8::EpiSwiglu E{HZ, FF, ssb};
            pg8::gemm_phase<pg8::EpiSwiglu, pg8::StaticOrder, true, true>(lds, g, S, E, tid_);
        } else if ((kind == 2 || kind == 8) && (PHM & 4)) {
            pg8::Gemm g; const float* bias = nullptr; float scale = 1.0f; float* ssn;
            if (kind == 2) { g = pg8::Gemm{HZ, (const bf16_t*)(ws + WS_W + (size_t)f * FFN_STRIDE + WD_OFF), M, D, FF}; scale = 0.5f; ssn = ssb; }
            else { g = pg8::Gemm{YB, (const bf16_t*)(odd ? ws + WS_WODD + i * ODD_STRIDE + WO_OFF : ws + WS_WMIX + i * EVEN_STRIDE + WOUT_OFF), M, D, D}; if (odd) bias = a.bo + i * D; ssn = ssb; }
            const bool first = (kind == 2 && l == 0 && !second), last = (kind == 2 && l == 3 && second), prelast = (kind == 8 && l == 3);
            bf16_t* xl = (bf16_t*)((unsigned char*)a.out + OUT_XL); bf16_t* xl2 = (bf16_t*)(ws + WS_LO);
            pg8::StaticOrder S; S.init(M, D, nblk, bid);
            pg8::EpiResid E{first ? a.x : nullptr, XB, last ? xl2 : xl, prelast ? xl2 : xl, last ? a.out : nullptr, ssn, bias, scale};
            pg8::gemm_phase<pg8::EpiResid, pg8::StaticOrder, false, true>(lds, g, S, E, tid_);
        } else if ((kind == 3 || kind == 5) && (PHM & 8)) {
            pg8::Gemm g; pg8::EpiBf E;
            if (kind == 3 && !odd) { g = pg8::Gemm{XB, (const bf16_t*)(ws + WS_WMIX + i * EVEN_STRIDE), M, ZC, D}; E = pg8::EpiBf{HZ, ZC, ssb, nullptr, 0}; }
            else if (kind == 3) { g = pg8::Gemm{XB, (const bf16_t*)(ws + WS_WODD + i * ODD_STRIDE), M, QKVC, D}; E = pg8::EpiBf{HZ, QKVC, ssb, a.bqkv + i * QKVC, 0}; }
            else { g = pg8::Gemm{(const bf16_t*)((unsigned char*)a.out + OUT_LA), (const bf16_t*)(ws + WS_WMIX + i * EVEN_STRIDE + WLORA_OFF), M, LOC, LAC}; E = pg8::EpiBf{(bf16_t*)(ws + WS_LO), LOC, nullptr, (const float*)(ws + WS_LB) + i * LOC, 1}; }
            pg8::StaticOrder S; S.init(M, g.N, nblk, bid);
            pg8::gemm_phase<pg8::EpiBf, pg8::StaticOrder, true, true>(lds, g, S, E, tid_);
        } else if (kind == 4 && (PHM & 16)) el_phase(a, i, tid_, bid, nblk);
        else if (kind == 6 && (PHM & 32)) scan_phase(a, lds, i, tid_, bid, nblk);
        else if (kind == 7 && (PHM & 64)) post_phase(a, lds, i, tid_, bid, nblk);
        else if (kind == 9 && (PHM & 128)) attn_phase(a, lds, i, tid_, bid, nblk);
#ifndef PROBE_SYNC
#define PROBE_SYNC 1
#endif
#ifndef PROBE_PRO2
#define PROBE_PRO2 0
#endif
        if (PROBE_PRO2 && ph == 0) { grid.sync(); prologue(a, lds, tid_, bid, nblk); }
        if (ph + 1 < ph_hi) { if (ph == ph_lo) grid.sync(); else xcd_barrier(xbar); }
    }
}

#ifndef MK_MULTI
#define MK_MULTI 0
#endif
extern "C" void kernel_launch(void* const* d_in, const int* in_sizes, int n_in, void* d_out, int out_size, void* d_ws, size_t ws_size, hipStream_t stream) {
    static int grid = 0;
    if (grid == 0) {
        if (n_in != 35 || in_sizes[0] != M * D || out_size != M * D || ws_size < WS_END) { fprintf(stderr, "kernel_launch: unexpected shapes (n_in %d, in0 %d, out %d, ws %zu); nothing launched\n", n_in, n_in > 0 ? in_sizes[0] : -1, out_size, ws_size); grid = -1; return; }
        int dev = 0, cus = 0, per_cu = 0;
        hipGetDevice(&dev); hipDeviceGetAttribute(&cus, hipDeviceAttributeMultiprocessorCount, dev);
        if (hipFuncSetAttribute((const void*)mega_fwd, hipFuncAttributeMaxDynamicSharedMemorySize, LDS_BYTES) != hipSuccess) { fprintf(stderr, "kernel_launch: hipFuncSetAttribute failed\n"); grid = -1; return; }
        if (hipOccupancyMaxActiveBlocksPerMultiprocessor(&per_cu, (const void*)mega_fwd, 512, LDS_BYTES) != hipSuccess || per_cu < 1) { fprintf(stderr, "kernel_launch: occupancy query says %d\n", per_cu); per_cu = 1; }
        (void)hipGetLastError();
        grid = cus * per_cu;
        if (grid > 256) grid = 256;
    }
    if (grid < 0) return;
    Args a{};
    const float** fp = (const float**)&a.f1n;
    a.x = (const float*)d_in[0]; a.pos = (const int*)d_in[1];
    for (int k = 2; k < 35; ++k) fp[k - 2] = (const float*)d_in[k];
    a.out = (float*)d_out; a.ws = (unsigned char*)d_ws;
    for (int d = 0; d < 32; ++d) a.inv_freq[d] = (float)pow(10000.0, -(double)(2 * d) / 64.0);
#if MK_MULTI
    for (int ph = 0; ph < N_PHASES; ++ph) { a.ph_lo = ph; a.ph_hi = ph + 1; hipLaunchKernelGGL(mega_fwd, dim3(grid), dim3(512), LDS_BYTES, stream, a); }
#else
    a.ph_lo = 0; a.ph_hi = N_PHASES;
    if (hipMemsetAsync(d_ws, 0, 16384, stream) != hipSuccess) { fprintf(stderr, "kernel_launch: memset of the barrier words failed\n"); return; }
    void* args[] = {&a};
    hipError_t e = hipLaunchCooperativeKernel((const void*)mega_fwd, dim3(grid), dim3(512), args, LDS_BYTES, stream);
    if (e != hipSuccess) fprintf(stderr, "cooperative launch failed: %s (grid %d)\n", hipGetErrorString(e), grid);
#endif
}
```

```cpp
#include <hip/hip_runtime.h>
#include <hip/hip_cooperative_groups.h>
#include <cstdio>
#include <cstdint>
#include <cmath>
namespace pg8 {
#define PG8_LAS __attribute__((address_space(3)))
typedef unsigned short bf16_t;
typedef short bf16x8 __attribute__((ext_vector_type(8)));
typedef float f32x4 __attribute__((ext_vector_type(4)));
typedef unsigned u32x4 __attribute__((ext_vector_type(4)));
constexpr int BM = 256, BK = 64, HALF = 128, HTB = HALF * BK * 2  , STAGE_BYTES = 8 * HTB, NXCD = 8, WGM = 8;

__host__ __device__ __forceinline__ int lds_byte(int r, int c) { const int st = (r >> 4) * 2 + (c >> 5), rr = r & 15, cc = c & 31, ob = rr * 64 + cc * 2; return st * 1024 + (ob ^ (((ob >> 9) & 1) << 5)); }
__host__ __device__ __forceinline__ void stage_rc(int b, int& R, int& C) { const int st = b / 1024, sb = b % 1024, swz = sb ^ (((sb >> 9) & 1) << 5); R = (st >> 1) * 16 + swz / 64; C = (st & 1) * 32 + (swz % 64) / 2; }
__host__ __device__ __forceinline__ int perm32(int rho) { const int n = rho >> 4, i = rho & 15; return 8 * (i >> 2) + 4 * n + (i & 3); }

struct Unit { int pm, pn; };
struct Gemm { const bf16_t* A; const bf16_t* Bt; int M, N, K; };

struct StaticOrder {
    int nM, nN, nwg, G, c;
    __host__ __device__ void init(int M, int N, int G_, int c_) { nM = M / BM; nN = N / BM; nwg = nM * nN; G = G_; c = c_; }
    __host__ __device__ bool next(int i, Unit& u) const {
        const long L = (long)i * G + c; if (L >= nwg) return false;
        int wgid = (int)L; { const int q = nwg / NXCD, r = nwg % NXCD, xcd = wgid % NXCD, off = wgid / NXCD; wgid = (xcd < r ? xcd * (q + 1) : r * (q + 1) + (xcd - r) * q) + off; }
        const int nig = WGM * nN, gid = wgid / nig, fm = gid * WGM, gsz = (nM - fm) < WGM ? (nM - fm) : WGM;
        u.pm = fm + ((wgid % nig) % gsz); u.pn = (wgid % nig) / gsz; return true;
    }
    __device__ __forceinline__ void a_ready(const Unit&) const {}
    __device__ __forceinline__ void done(const Unit&) const {}
};
__device__ __forceinline__ unsigned cvt_pk_bf16(float lo, float hi) { unsigned r; asm volatile("v_cvt_pk_bf16_f32 %0, %1, %2" : "=v"(r) : "v"(lo), "v"(hi)); return r; }
typedef float f32x2 __attribute__((ext_vector_type(2)));
__device__ __forceinline__ f32x2 gelu_pk(f32x2 v) {
    const f32x2 av = __builtin_elementwise_abs(v), d = av * 0.2316418882f + 1.0f;
    f32x2 t; t.x = __builtin_amdgcn_rcpf(d.x); t.y = __builtin_amdgcn_rcpf(d.y);
    f32x2 q = t * 0.5307027145f + (-0.7265760135f); q = q * t + 0.7107068705f; q = q * t + (-0.142248368f); q = q * t + 0.127414796f; q = q * t;
    const f32x2 s = (v * v) * (-0.72134752044f);
    f32x2 e; e.x = __builtin_amdgcn_exp2f(s.x); e.y = __builtin_amdgcn_exp2f(s.y);
    const f32x2 m = v * (q * e), r = v - m;
    f32x2 o; o.x = v.x < 0.f ? m.x : r.x; o.y = v.y < 0.f ? m.y : r.y; return o;
}
typedef unsigned u32x2 __attribute__((ext_vector_type(2)));
typedef __bf16 bf16x2_t __attribute__((ext_vector_type(2)));
__device__ __forceinline__ unsigned pk2(float lo, float hi) { f32x2 v = {lo, hi}; bf16x2_t b = __builtin_convertvector(v, bf16x2_t); return __builtin_bit_cast(unsigned, b); }
__device__ __forceinline__ float fast_sigmoid(float x) { return __builtin_amdgcn_rcpf(1.0f + __builtin_amdgcn_exp2f(-1.4426950408889634f * x)); }

__device__ __forceinline__ float row_rs(const float* ss, int r, int fq) { const f32x4 a = *(const f32x4*)(ss + (size_t)r * 16 + 4 * fq);
    float t = (a[0] + a[1]) + (a[2] + a[3]); t += __shfl_xor(t, 16); t += __shfl_xor(t, 32); return __builtin_amdgcn_rsqf(t * (1.0f / 1024.0f) + 1e-6f); }
struct EpiSwiglu {
    static constexpr bool PERM = true, AFTER_DRAIN = false, WIDE = false;
    bf16_t* H; int ldh; const float* ss;
    __device__ __forceinline__ void operator()(const f32x4 (&acc)[2][2][4][2], const Unit& u, int wr, int wc, int fr, int fq) const {
        const int row0 = u.pm * BM + wr * 64 + fr; const int col0 = u.pn * HALF + wc * 32 + 8 * fq;
        float rsv[2][4];
#pragma unroll
        for (int ai = 0; ai < 2; ++ai)
#pragma unroll
            for (int m = 0; m < 4; ++m) rsv[ai][m] = row_rs(ss, row0 + ai * HALF + m * 16, fq);
#pragma unroll
        for (int ai = 0; ai < 2; ++ai)
#pragma unroll
            for (int m = 0; m < 4; ++m) { const int r = row0 + ai * HALF + m * 16; const float rs = rsv[ai][m], rs2 = rs * rs, nl = -1.4426950408889634f * rs;
                unsigned w[4];
#pragma unroll
                for (int n = 0; n < 2; ++n) { const f32x4 g = acc[ai][0][m][n], gu = g * acc[ai][1][m][n] * rs2, ge = g * nl; float hv[4];
#pragma unroll
                    for (int e = 0; e < 4; ++e) hv[e] = gu[e] * __builtin_amdgcn_rcpf(1.0f + __builtin_amdgcn_exp2f(ge[e]));
                    w[2 * n] = pk2(hv[0], hv[1]); w[2 * n + 1] = pk2(hv[2], hv[3]); }
                *(u32x4*)(H + (size_t)r * ldh + col0) = (u32x4){w[0], w[1], w[2], w[3]}; }
    }
};
struct EpiResid {
    static constexpr bool PERM = true, AFTER_DRAIN = false, WIDE = true;
    const float* xin;
    bf16_t* hi; const bf16_t* lo_in; bf16_t* lo_out;
    float* fout;
    float* ssn; const float* bias; float scale;
    __device__ __forceinline__ void operator()(const f32x4 (&acc)[2][2][4][2], const Unit& u, int wr, int wc, int fr, int fq) const {
        const int row0 = u.pm * BM + wr * 64 + fr; const int col0 = u.pn * BM + wc * 64 + 8 * fq;
        f32x4 bv[2][2];
#pragma unroll
        for (int bj = 0; bj < 2; ++bj)
#pragma unroll
            for (int n = 0; n < 2; ++n) bv[bj][n] = bias ? *(const f32x4*)(bias + col0 + bj * 32 + 4 * n) : (f32x4){0.f, 0.f, 0.f, 0.f};
#pragma unroll
        for (int q = 0; q < 4; ++q) { const int ai = q >> 1, mh = (q & 1) * 2;
            u32x4 rh[2][2], rl[2][2];
#pragma unroll
            for (int m = 0; m < 2; ++m)
#pragma unroll
                for (int bj = 0; bj < 2; ++bj) { const size_t c = (size_t)(row0 + ai * HALF + (mh + m) * 16) * 1024 + col0 + bj * 32;
                    if (xin) { rh[m][bj] = __builtin_bit_cast(u32x4, *(const f32x4*)(xin + c)); rl[m][bj] = __builtin_bit_cast(u32x4, *(const f32x4*)(xin + c + 4)); }
                    else { rh[m][bj] = *(const u32x4*)(hi + c); rl[m][bj] = *(const u32x4*)(lo_in + c); } }
#pragma unroll
            for (int m = 0; m < 2; ++m) { const int r = row0 + ai * HALF + (mh + m) * 16; float s = 0.f;
#pragma unroll
                for (int bj = 0; bj < 2; ++bj) { const size_t c = (size_t)r * 1024 + col0 + bj * 32; const u32x4 h = rh[m][bj], l = rl[m][bj]; f32x4 b0, b1;
                    if (xin) { b0 = __builtin_bit_cast(f32x4, h); b1 = __builtin_bit_cast(f32x4, l); }
                    else { b0 = (f32x4){__uint_as_float(h.x << 16) + __uint_as_float(l.x << 16), __uint_as_float(h.x & 0xffff0000u) + __uint_as_float(l.x & 0xffff0000u),
                                        __uint_as_float(h.y << 16) + __uint_as_float(l.y << 16), __uint_as_float(h.y & 0xffff0000u) + __uint_as_float(l.y & 0xffff0000u)};
                           b1 = (f32x4){__uint_as_float(h.z << 16) + __uint_as_float(l.z << 16), __uint_as_float(h.z & 0xffff0000u) + __uint_as_float(l.z & 0xffff0000u),
                                        __uint_as_float(h.w << 16) + __uint_as_float(l.w << 16), __uint_as_float(h.w & 0xffff0000u) + __uint_as_float(l.w & 0xffff0000u)}; }
                    const f32x4 v0 = b0 + acc[ai][bj][mh + m][0] * scale + bv[bj][0], v1 = b1 + acc[ai][bj][mh + m][1] * scale + bv[bj][1];
                    if (fout) { *(f32x4*)(fout + c) = v0; *(f32x4*)(fout + c + 4) = v1; }
                    else { const unsigned h0 = pk2(v0[0], v0[1]), h1 = pk2(v0[2], v0[3]), h2 = pk2(v1[0], v1[1]), h3 = pk2(v1[2], v1[3]);
                        const unsigned l0 = pk2(v0[0] - __uint_as_float(h0 << 16), v0[1] - __uint_as_float(h0 & 0xffff0000u)), l1 = pk2(v0[2] - __uint_as_float(h1 << 16), v0[3] - __uint_as_float(h1 & 0xffff0000u)),
                                       l2 = pk2(v1[0] - __uint_as_float(h2 << 16), v1[1] - __uint_as_float(h2 & 0xffff0000u)), l3 = pk2(v1[2] - __uint_as_float(h3 << 16), v1[3] - __uint_as_float(h3 & 0xffff0000u));
                        *(u32x4*)(hi + c) = (u32x4){h0, h1, h2, h3}; *(u32x4*)(lo_out + c) = (u32x4){l0, l1, l2, l3}; }
                    s += ((v0[0] * v0[0] + v0[1] * v0[1]) + (v0[2] * v0[2] + v0[3] * v0[3])) + ((v1[0] * v1[0] + v1[1] * v1[1]) + (v1[2] * v1[2] + v1[3] * v1[3])); }
                s += __shfl_xor(s, 16); s += __shfl_xor(s, 32);
                if (fq == 0) ssn[(size_t)r * 16 + u.pn * 4 + wc] = s; }
        }
    }
};
struct EpiBf {
    static constexpr bool PERM = true, AFTER_DRAIN = false, WIDE = true;
    bf16_t* O; int ldc; const float* ss; const float* bias; int mode;
    __device__ __forceinline__ void operator()(const f32x4 (&acc)[2][2][4][2], const Unit& u, int wr, int wc, int fr, int fq) const {
        const int row0 = u.pm * BM + wr * 64 + fr; const int col0 = u.pn * BM + wc * 64 + 8 * fq;
        const int seg = (mode == 1) ? (u.pn >> 1) : 3;
        f32x4 bv[2][2];
#pragma unroll
        for (int bj = 0; bj < 2; ++bj)
#pragma unroll
            for (int n = 0; n < 2; ++n) bv[bj][n] = bias ? *(const f32x4*)(bias + col0 + bj * 32 + 4 * n) : (f32x4){0.f, 0.f, 0.f, 0.f};
        float rsv[2][4];
#pragma unroll
        for (int ai = 0; ai < 2; ++ai)
#pragma unroll
            for (int m = 0; m < 4; ++m) rsv[ai][m] = ss ? row_rs(ss, row0 + ai * HALF + m * 16, fq) : 1.0f;
#pragma unroll
        for (int ai = 0; ai < 2; ++ai)
#pragma unroll
            for (int m = 0; m < 4; ++m) { const int r = row0 + ai * HALF + m * 16; const float rs = rsv[ai][m];
                bf16_t* rowp = O + (size_t)r * ldc + col0;
#pragma unroll
                for (int bj = 0; bj < 2; ++bj) { f32x4 v0 = acc[ai][bj][m][0] * rs + bv[bj][0], v1 = acc[ai][bj][m][1] * rs + bv[bj][1];
                    if (seg < 2) { const float sc = (seg == 0) ? 0.60653065971263342f : 1.0f;
#pragma unroll
                        for (int e = 0; e < 4; ++e) { v0[e] = sc * fast_sigmoid(v0[e]); v1[e] = sc * fast_sigmoid(v1[e]); } }
                    *(u32x4*)(rowp + bj * 32) = (u32x4){pk2(v0[0], v0[1]), pk2(v0[2], v0[3]), pk2(v1[0], v1[1]), pk2(v1[2], v1[3])}; } }
    }
};

template <class Epi, class Sched, bool ALIGN_EPI = false, bool SP2 = false>
__device__ __forceinline__ void gemm_phase(PG8_LAS unsigned char* lds, const Gemm g, const Sched& S, const Epi& E, const int tid_) {
    const int tid = tid_, wid = __builtin_amdgcn_readfirstlane(tid >> 6), lane = tid & 63, wr = wid >> 2, wc = wid & 3, fr = lane & 15, fq = lane >> 4;
    const int K = g.K, nt = K / BK;
    unsigned voffA[2], voffB[2];
#pragma unroll
    for (int i = 0; i < 2; ++i) { int R, C; stage_rc(tid * 16 + i * 8192, R, C); const int Rb = Epi::WIDE ? (64 * (R >> 5) + (Epi::PERM ? perm32(R & 31) : (R & 31))) : (Epi::PERM ? ((R & ~31) + perm32(R & 31)) : R);
        voffA[i] = (unsigned)(R * K + C) * 2u; voffB[i] = (unsigned)(Rb * K + C) * 2u; }
    const size_t kstep = (size_t)(BK * 2);
    const size_t hstep = (size_t)HALF * K * 2;
    const size_t tstep = 2 * hstep;
    const size_t hstepB = Epi::WIDE ? (size_t)32 * K * 2 : hstep;
    const unsigned ldsw = (unsigned)wid * 1024u;
    const int aoff = lds_byte(wr * 64 + fr, fq * 8), boff = lds_byte(wc * 32 + fr, fq * 8);
#define PG8_SA(b, h) (((b) * 2 + (h)) * HTB)
#define PG8_SB(b, h) ((4 + (b) * 2 + (h)) * HTB)
#define PG8_STAGE(bufoff, gbase, voff) do { _Pragma("unroll") for (int _i = 0; _i < 2; ++_i) \
        __builtin_amdgcn_global_load_lds((const unsigned*)((const char*)(gbase) + (voff)[_i]), (PG8_LAS unsigned*)(lds + (bufoff) + ldsw + _i * 8192), 16, 0, 0); } while (0)
#define PG8_LDA(dst, b, h) do { _Pragma("unroll") for (int m = 0; m < 4; ++m) _Pragma("unroll") for (int k = 0; k < 2; ++k) dst[m][k] = *(const PG8_LAS bf16x8*)(lds + PG8_SA(b, h) + aoff + m * 2048 + k * 1024); } while (0)
#define PG8_LDB(dst, b, h) do { _Pragma("unroll") for (int n = 0; n < 2; ++n) _Pragma("unroll") for (int k = 0; k < 2; ++k) dst[n][k] = *(const PG8_LAS bf16x8*)(lds + PG8_SB(b, h) + boff + n * 2048 + k * 1024); } while (0)
#define PG8_MMA(ai, bj, At, Bt) do { __builtin_amdgcn_s_setprio(1); _Pragma("unroll") for (int m = 0; m < 4; ++m) _Pragma("unroll") for (int n = 0; n < 2; ++n) _Pragma("unroll") for (int k = 0; k < 2; ++k) \
        acc[ai][bj][m][n] = __builtin_amdgcn_mfma_f32_16x16x32_bf16(Bt[n][k], At[m][k], acc[ai][bj][m][n], 0, 0, 0); __builtin_amdgcn_s_setprio(0); } while (0)
#define PG8_WAIT_V(n) asm volatile("s_waitcnt vmcnt(" #n ")" ::: "memory")
#define PG8_WAIT_L(n) asm volatile("s_waitcnt lgkmcnt(" #n ")" ::: "memory")
#define PG8_BAR __builtin_amdgcn_s_barrier()
#define PG8_SCHED __builtin_amdgcn_sched_barrier(0)
    Unit cur, nxt; int ui = 0;
    if (!S.next(0, cur)) return;
    f32x4 acc[2][2][4][2];
#pragma unroll
    for (int a = 0; a < 2; ++a)
#pragma unroll
        for (int b = 0; b < 2; ++b)
#pragma unroll
            for (int m = 0; m < 4; ++m)
#pragma unroll
                for (int n = 0; n < 2; ++n) acc[a][b][m][n] = (f32x4){0.f, 0.f, 0.f, 0.f};
    bf16x8 At[4][2], B0[2][2], B1[2][2];
    const char* cA = (const char*)g.A + (size_t)cur.pm * tstep; const char* cB = (const char*)g.Bt + (size_t)cur.pn * tstep;
    S.a_ready(cur);
    if constexpr (SP2) {
        PG8_STAGE(PG8_SB(0, 0), cB, voffB); PG8_STAGE(PG8_SB(0, 1), cB + hstepB, voffB); PG8_STAGE(PG8_SA(0, 0), cA, voffA); PG8_STAGE(PG8_SA(0, 1), cA + hstep, voffA);
        if (wr == 1) PG8_BAR;
        PG8_WAIT_V(2); PG8_BAR;
        PG8_STAGE(PG8_SB(1, 0), cB + kstep, voffB); PG8_STAGE(PG8_SA(1, 0), cA + kstep, voffA); PG8_STAGE(PG8_SB(1, 1), cB + hstepB + kstep, voffB);
        PG8_WAIT_V(6); PG8_BAR;
    } else {
        PG8_STAGE(PG8_SB(0, 0), cB, voffB); PG8_STAGE(PG8_SA(0, 0), cA, voffA); PG8_STAGE(PG8_SB(0, 1), cB + hstepB, voffB); PG8_STAGE(PG8_SA(0, 1), cA + hstep, voffA);
        if (wr == 1) PG8_BAR;
        PG8_WAIT_V(4); PG8_BAR;
        PG8_STAGE(PG8_SB(1, 0), cB + kstep, voffB); PG8_STAGE(PG8_SA(1, 0), cA + kstep, voffA); PG8_STAGE(PG8_SB(1, 1), cB + hstepB + kstep, voffB);
        PG8_WAIT_V(6); PG8_BAR;
    }
    for (;;) {
        const bool has_next = S.next(ui + 1, nxt);
        const char* nA = has_next ? (const char*)g.A + (size_t)nxt.pm * tstep : cA; const char* nB = has_next ? (const char*)g.Bt + (size_t)nxt.pn * tstep : cB;
        for (int t = 0; t < nt; t += 2) {
            const bool last = (t == nt - 2);
            const char* a1 = cA + (size_t)(t + 1) * kstep;
            const char* a2 = last ? nA : cA + (size_t)(t + 2) * kstep; const char* b2 = last ? nB : cB + (size_t)(t + 2) * kstep;
            const char* a3 = a2 + kstep; const char* b3 = b2 + kstep;
            if (last && has_next) S.a_ready(nxt);
            if constexpr (SP2) {
            PG8_LDB(B0, 0, 0); PG8_LDB(B1, 0, 1); PG8_SCHED; PG8_LDA(At, 0, 0); PG8_STAGE(PG8_SA(1, 1), a1 + hstep, voffA);
            PG8_WAIT_V(8); PG8_WAIT_L(0); PG8_BAR; PG8_MMA(0, 0, At, B0); PG8_MMA(0, 1, At, B1); PG8_BAR; PG8_SCHED;
            PG8_LDA(At, 0, 1); PG8_STAGE(PG8_SB(0, 0), b2, voffB); PG8_STAGE(PG8_SB(0, 1), b2 + hstepB, voffB); PG8_STAGE(PG8_SA(0, 0), a2, voffA);
            PG8_WAIT_V(8); PG8_WAIT_L(0); PG8_BAR; PG8_MMA(1, 0, At, B0); PG8_MMA(1, 1, At, B1); PG8_BAR; PG8_SCHED;
            PG8_LDB(B0, 1, 0); PG8_LDB(B1, 1, 1); PG8_SCHED; PG8_LDA(At, 1, 0); PG8_STAGE(PG8_SA(0, 1), a2 + hstep, voffA);
            PG8_WAIT_V(8); PG8_WAIT_L(0); PG8_BAR; PG8_MMA(0, 0, At, B0); PG8_MMA(0, 1, At, B1); PG8_BAR; PG8_SCHED;
            PG8_LDA(At, 1, 1); PG8_STAGE(PG8_SB(1, 0), b3, voffB); PG8_STAGE(PG8_SB(1, 1), b3 + hstepB, voffB); PG8_STAGE(PG8_SA(1, 0), a3, voffA);
            PG8_WAIT_V(8); PG8_WAIT_L(0); PG8_BAR; PG8_MMA(1, 0, At, B0); PG8_MMA(1, 1, At, B1); PG8_BAR; PG8_SCHED;
            } else {
            PG8_LDB(B0, 0, 0); PG8_SCHED; PG8_LDA(At, 0, 0); PG8_STAGE(PG8_SA(1, 1), a1 + hstep, voffA);
            PG8_WAIT_L(8); PG8_BAR; PG8_WAIT_L(0); PG8_MMA(0, 0, At, B0); PG8_BAR; PG8_SCHED;
            PG8_LDB(B1, 0, 1); PG8_STAGE(PG8_SB(0, 0), b2, voffB);
            PG8_BAR; PG8_WAIT_L(0); PG8_MMA(0, 1, At, B1); PG8_BAR;
            PG8_LDA(At, 0, 1); PG8_STAGE(PG8_SA(0, 0), a2, voffA);
            PG8_BAR; PG8_WAIT_L(0); PG8_MMA(1, 0, At, B0); PG8_BAR; PG8_SCHED;
            PG8_STAGE(PG8_SB(0, 1), b2 + hstepB, voffB);
            PG8_WAIT_V(6); PG8_BAR; PG8_MMA(1, 1, At, B1); PG8_BAR;
            PG8_LDB(B0, 1, 0); PG8_SCHED; PG8_LDA(At, 1, 0); PG8_STAGE(PG8_SA(0, 1), a2 + hstep, voffA);
            PG8_WAIT_L(8); PG8_BAR; PG8_WAIT_L(0); PG8_MMA(0, 0, At, B0); PG8_BAR; PG8_SCHED;
            PG8_LDB(B1, 1, 1); PG8_STAGE(PG8_SB(1, 0), b3, voffB);
            PG8_BAR; PG8_WAIT_L(0); PG8_MMA(0, 1, At, B1); PG8_BAR;
            PG8_LDA(At, 1, 1); PG8_STAGE(PG8_SA(1, 0), a3, voffA);
            PG8_BAR; PG8_WAIT_L(0); PG8_MMA(1, 0, At, B0); PG8_BAR; PG8_SCHED;
            PG8_STAGE(PG8_SB(1, 1), b3 + hstepB, voffB);
            PG8_WAIT_V(6); PG8_BAR; PG8_MMA(1, 1, At, B1); PG8_BAR;
            }
        }
        if constexpr (ALIGN_EPI) { if (wr == 0) PG8_BAR; }
        if constexpr (!Epi::AFTER_DRAIN) { E(acc, cur, wr, wc, fr, fq); S.done(cur); }
        if (!has_next) break;
#pragma unroll
        for (int a = 0; a < 2; ++a)
#pragma unroll
            for (int b = 0; b < 2; ++b)
#pragma unroll
                for (int m = 0; m < 4; ++m)
#pragma unroll
                    for (int n = 0; n < 2; ++n) acc[a][b][m][n] = (f32x4){0.f, 0.f, 0.f, 0.f};
        cur = nxt; cA = nA; cB = nB; ++ui;
        if constexpr (ALIGN_EPI) { if (wr == 1) PG8_BAR; }
    }
    PG8_WAIT_V(0);
    if constexpr (!ALIGN_EPI) { if (wr == 0) PG8_BAR; }
    PG8_BAR;
    if constexpr (Epi::AFTER_DRAIN) { E.fused(acc, cur, wr, wc, fr, fq, lds, wid, lane); S.done(cur); }
#undef PG8_SA
#undef PG8_SB
#undef PG8_STAGE
#undef PG8_LDA
#undef PG8_LDB
#undef PG8_MMA
#undef PG8_WAIT_V
#undef PG8_WAIT_L
#undef PG8_BAR
#undef PG8_SCHED
}
}
namespace cg = cooperative_groups;
#define LAS __attribute__((address_space(3)))
using pg8::bf16_t; using pg8::bf16x8; using pg8::f32x4; using pg8::u32x4; using pg8::f32x2; using pg8::u32x2; using pg8::pk2; using pg8::fast_sigmoid;

constexpr int M = 65536, T = 4096, D = 1024, FF = 2816, ZC = 2816, QKVC = 1536, LOC = 1536, LAC = 256;
constexpr size_t MiB = (size_t)1 << 20;
constexpr size_t WS_SS = 1 * MiB;
constexpr size_t WS_LB = 5 * MiB;
constexpr size_t WS_RKB = 6 * MiB;
constexpr size_t WS_ROPE = 8 * MiB;
constexpr size_t WS_W = 24 * MiB;
constexpr size_t FFN_STRIDE = 16 * MiB + MiB / 2, WD_OFF = 11 * MiB;
constexpr size_t WS_WMIX = WS_W + 8 * FFN_STRIDE;
constexpr size_t EVEN_STRIDE = 8 * MiB + MiB / 4, WOUT_OFF = 5 * MiB + MiB / 2, WLORA_OFF = 7 * MiB + MiB / 2;
constexpr size_t WS_WODD = WS_WMIX + 2 * EVEN_STRIDE, ODD_STRIDE = 5 * MiB, WO_OFF = 3 * MiB;
constexpr size_t WS_XB = 184 * MiB;
constexpr size_t OUT_XL = 0, OUT_LA = 128 * MiB, OUT_YRAW = 160 * MiB;
constexpr size_t WS_HZ = 312 * MiB;
constexpr size_t WS_Y = 664 * MiB;
constexpr size_t WS_LO = 792 * MiB;
constexpr size_t WS_END = 984 * MiB;
static_assert(WS_WODD + 2 * ODD_STRIDE <= WS_XB, "ws map");
constexpr int LDS_BYTES = 147456;

struct Args {
    const float* x; const int* pos;
    const float *f1n, *f1g, *f1u, *f1d, *mixn, *f2n, *f2g, *f2u, *f2d;
    const float *win, *mu, *w0, *wdec, *a0, *waaa, *wgate, *kk, *ka, *rk, *gng, *gnb, *lng, *lnb, *wsp, *bsp, *wout;
    const float *wqkv, *bqkv, *qn, *kn, *sinks, *wo, *bo;
    float* out; unsigned char* ws;
    float inv_freq[32];
    int ph_lo, ph_hi;
};

#define KAS __attribute__((address_space(4)))
__device__ __forceinline__ const KAS Args* kargs(int off) { return (const KAS Args*)((const KAS char*)__builtin_amdgcn_kernarg_segment_ptr() + off); }
__device__ __forceinline__ float bf2f(unsigned short h) { return __uint_as_float((unsigned)h << 16); }
__device__ __forceinline__ float bflo(unsigned w) { return __uint_as_float(w << 16); }
__device__ __forceinline__ float bfhi(unsigned w) { return __uint_as_float(w & 0xffff0000u); }
__device__ __forceinline__ void unpack8(const u32x4 w, float (&f)[8]) { f[0] = bflo(w.x); f[1] = bfhi(w.x); f[2] = bflo(w.y); f[3] = bfhi(w.y); f[4] = bflo(w.z); f[5] = bfhi(w.z); f[6] = bflo(w.w); f[7] = bfhi(w.w); }
__device__ __forceinline__ u32x4 pack8(const float (&f)[8]) { return (u32x4){pk2(f[0], f[1]), pk2(f[2], f[3]), pk2(f[4], f[5]), pk2(f[6], f[7])}; }
__device__ __forceinline__ float wave_sum(float v) {
#pragma unroll
    for (int o = 1; o < 64; o <<= 1) v += __shfl_xor(v, o);
    return v;
}
template <int CTRL> __device__ __forceinline__ float dpp_mov(float x) { return __int_as_float(__builtin_amdgcn_update_dpp(0, __float_as_int(x), CTRL, 0xF, 0xF, false)); }
__device__ __forceinline__ float row16_sum(float x) { x += dpp_mov<0xB1>(x); x += dpp_mov<0x4E>(x); x += dpp_mov<0x124>(x); x += dpp_mov<0x128>(x); return x; }
__device__ __forceinline__ float row16_max(float x) { x = fmaxf(x, dpp_mov<0xB1>(x)); x = fmaxf(x, dpp_mov<0x4E>(x)); x = fmaxf(x, dpp_mov<0x124>(x)); x = fmaxf(x, dpp_mov<0x128>(x)); return x; }
__device__ __forceinline__ float wave_sum_dpp(float x) { x = row16_sum(x);
    return __int_as_float(__builtin_amdgcn_readlane(__float_as_int(x), 0)) + __int_as_float(__builtin_amdgcn_readlane(__float_as_int(x), 16)) + (__int_as_float(__builtin_amdgcn_readlane(__float_as_int(x), 32)) + __int_as_float(__builtin_amdgcn_readlane(__float_as_int(x), 48))); }
#define LDS_FENCE() asm volatile("s_waitcnt lgkmcnt(0)" ::: "memory")

__device__ __forceinline__ void tr_item(const float* W, int N, const float* gk, bf16_t* WT, int ldk, int drow, int k0, int n0, LAS float* scr, int lane) {
    f32x4 v[8];
#pragma unroll
    for (int i = 0; i < 8; ++i) { const int kk = 8 * i + (lane >> 3); v[i] = *(const f32x4*)(W + (size_t)(k0 + kk) * N + n0 + 4 * (lane & 7)); }
#pragma unroll
    for (int i = 0; i < 8; ++i) { const int kk = 8 * i + (lane >> 3); const float g = gk ? gk[k0 + kk] : 1.0f; *(LAS f32x4*)(scr + kk * 36 + 4 * (lane & 7)) = v[i] * g; }
    LDS_FENCE();
    const int c = lane & 7;
#pragma unroll
    for (int j = 0; j < 4; ++j) { const int n = (lane >> 3) + 8 * j; const LAS float* s = scr + (8 * c) * 36 + n;
        u32x4 o; o.x = pk2(s[0 * 36], s[1 * 36]); o.y = pk2(s[2 * 36], s[3 * 36]); o.z = pk2(s[4 * 36], s[5 * 36]); o.w = pk2(s[6 * 36], s[7 * 36]);
        *(u32x4*)(WT + (size_t)(drow + n) * ldk + k0 + 8 * c) = o; }
    LDS_FENCE();
}
__device__ __forceinline__ void prologue(const KAS Args& a, LAS unsigned char* lds, const int tid_, const int bid, const int nblk) {
    unsigned char* ws = a.ws;
    const int tid = tid_, lane = tid & 63, wave = tid >> 6;
    LAS float* scr = (LAS float*)(lds + wave * 16384);
    const int gw = bid * 8 + wave, NGW = nblk * 8;
    const int gt = bid * 512 + tid, NGT = nblk * 512;
    constexpr int I_GU = 16 * 88, I_DN = 44 * 32, I_FFN = 2 * I_GU + I_DN, N_FFN = 8 * I_FFN;
    constexpr int I_IN = 16 * 88, I_OUT = 16 * 32, I_QKV = 16 * 48, I_O = 16 * 32, I_MIX = I_IN + I_OUT + I_QKV + I_O;
    for (int it = gw; it < N_FFN + 2 * I_MIX; it += NGW) {
        if (it < N_FFN) {
            const int f = it / I_FFN, r = it % I_FFN, l = f >> 1, second = f & 1;
            bf16_t* wgu = (bf16_t*)(ws + WS_W + (size_t)f * FFN_STRIDE); bf16_t* wd = (bf16_t*)(ws + WS_W + (size_t)f * FFN_STRIDE + WD_OFF);
            if (r < 2 * I_GU) { const int part = r / I_GU, loc = r % I_GU, kb = loc / 88, nb = loc % 88, n0 = 32 * nb;
                const float* src = (part == 0 ? (second ? a.f2g : a.f1g) : (second ? a.f2u : a.f1u)) + (size_t)l * D * FF;
                const float* gk = (second ? a.f2n : a.f1n) + l * D;
                tr_item(src, FF, gk, wgu, D, (n0 >> 7) * 256 + (n0 & 127) + part * 128, 64 * kb, n0, scr, lane);
            } else { const int loc = r - 2 * I_GU, kb = loc / 32, nb = loc % 32;
                const float* src = (second ? a.f2d : a.f1d) + (size_t)l * FF * D;
                tr_item(src, D, nullptr, wd, FF, 32 * nb, 64 * kb, 32 * nb, scr, lane); }
        } else {
            const int r = it - N_FFN, i = r / I_MIX, q = r % I_MIX;
            if (q < I_IN) { const int kb = q / 88, nb = q % 88;
                tr_item(a.win + (size_t)i * D * ZC, ZC, a.mixn + (2 * i) * D, (bf16_t*)(ws + WS_WMIX + i * EVEN_STRIDE), D, 32 * nb, 64 * kb, 32 * nb, scr, lane);
            } else if (q < I_IN + I_OUT) { const int loc = q - I_IN, kb = loc / 32, nb = loc % 32;
                tr_item(a.wout + (size_t)i * D * D, D, nullptr, (bf16_t*)(ws + WS_WMIX + i * EVEN_STRIDE + WOUT_OFF), D, 32 * nb, 64 * kb, 32 * nb, scr, lane);
            } else if (q < I_IN + I_OUT + I_QKV) { const int loc = q - I_IN - I_OUT, kb = loc / 48, nb = loc % 48;
                tr_item(a.wqkv + (size_t)i * D * QKVC, QKVC, a.mixn + (2 * i + 1) * D, (bf16_t*)(ws + WS_WODD + i * ODD_STRIDE), D, 32 * nb, 64 * kb, 32 * nb, scr, lane);
            } else { const int loc = q - I_IN - I_OUT - I_QKV, kb = loc / 32, nb = loc % 32;
                tr_item(a.wo + (size_t)i * D * D, D, nullptr, (bf16_t*)(ws + WS_WODD + i * ODD_STRIDE + WO_OFF), D, 32 * nb, 64 * kb, 32 * nb, scr, lane); }
        }
    }
    for (int idx = gt; idx < 2 * LOC * LAC; idx += NGT) {
        const int i = idx / (LOC * LAC), e = idx % (LOC * LAC), n = e / LAC, k = e % LAC, seg = n >> 9, nn = n & 511;
        float v = 0.f;
        if (seg == 0) { if (k < 64) v = a.wdec[(size_t)i * 64 * 512 + k * 512 + nn]; }
        else if (seg == 1) { if (k >= 64 && k < 128) v = a.waaa[(size_t)i * 64 * 512 + (k - 64) * 512 + nn]; }
        else { if (k >= 128) v = a.wgate[(size_t)i * 128 * 512 + (k - 128) * 512 + nn]; }
        ((bf16_t*)(ws + WS_WMIX + i * EVEN_STRIDE + WLORA_OFF))[e] = (bf16_t)(pk2(v, 0.f) & 0xffffu);
    }
    for (int idx = gt; idx < 2 * LOC; idx += NGT) { const int i = idx / LOC, n = idx % LOC;
        ((float*)(ws + WS_LB))[idx] = (n < 512) ? a.w0[i * 512 + n] : (n < 1024 ? a.a0[i * 512 + n - 512] : 0.f); }
    { bf16_t* xb = (bf16_t*)(ws + WS_XB); bf16_t* xl = (bf16_t*)((unsigned char*)a.out + OUT_XL); float* ss0 = (float*)(ws + WS_SS);
      for (int mb = gw; mb < M; mb += 2 * NGW) { f32x4 v[2][4]; const int m1 = (mb + NGW < M) ? mb + NGW : mb;
#pragma unroll
          for (int j = 0; j < 4; ++j) { v[0][j] = ((const f32x4*)(a.x + (size_t)mb * D) + lane)[64 * j]; v[1][j] = ((const f32x4*)(a.x + (size_t)m1 * D) + lane)[64 * j]; }
#pragma unroll
          for (int k = 0; k < 2; ++k) { const int m = k ? m1 : mb; if (k && m1 == mb) break; float s = 0.f;
#pragma unroll
              for (int j = 0; j < 4; ++j) { const f32x4 w = v[k][j]; s += (w[0] * w[0] + w[1] * w[1]) + (w[2] * w[2] + w[3] * w[3]);
                  const unsigned h01 = pk2(w[0], w[1]), h23 = pk2(w[2], w[3]);
                  const unsigned l01 = pk2(w[0] - bflo(h01), w[1] - bfhi(h01)), l23 = pk2(w[2] - bflo(h23), w[3] - bfhi(h23));
                  *(u32x2*)(xb + (size_t)m * D + 4 * (lane + 64 * j)) = (u32x2){h01, h23}; *(u32x2*)(xl + (size_t)m * D + 4 * (lane + 64 * j)) = (u32x2){l01, l23}; }
              s = wave_sum(s); if (lane < 16) ss0[(size_t)m * 16 + lane] = (lane == 0) ? s : 0.f; } } }
    { float* tab = (float*)(ws + WS_ROPE);
      for (int idx = gt; idx < M * 32; idx += NGT) { const int m = idx >> 5, d = idx & 31; const float ang = (float)a.pos[m] * a.inv_freq[d];
          const double rev = (double)ang * 0.15915494309189535; const float fr = (float)(rev - __builtin_rint(rev));
          tab[(size_t)m * 64 + d] = __builtin_amdgcn_cosf(fr); tab[(size_t)m * 64 + 32 + d] = __builtin_amdgcn_sinf(fr); } }
}

__device__ __forceinline__ void el_phase(const KAS Args& a, int i, const int tid_, const int bid, const int nblk) {
    const bf16_t* Z = (const bf16_t*)(a.ws + WS_HZ); bf16_t* LA = (bf16_t*)((unsigned char*)a.out + OUT_LA);
    const float* mu = a.mu + i * 1792 + 1536;
    const int gt = bid * 512 + tid_, NGT = nblk * 512;
    for (int ib = gt; ib < M * 32; ib += 4 * NGT) { u32x4 rc[4], rp[4];
#pragma unroll
        for (int k = 0; k < 4; ++k) { const int idx = ib + k * NGT; const int ii = idx < M * 32 ? idx : ib; const int m = ii >> 5, c0 = (ii & 31) * 8, t = m & (T - 1);
            rc[k] = *(const u32x4*)(Z + (size_t)m * ZC + 1536 + c0); rp[k] = (t > 0) ? *(const u32x4*)(Z + (size_t)(m - 1) * ZC + 1536 + c0) : (u32x4){0u, 0u, 0u, 0u}; }
#pragma unroll
        for (int k = 0; k < 4; ++k) { const int idx = ib + k * NGT; if (idx >= M * 32) break; const int m = idx >> 5, c0 = (idx & 31) * 8;
            float zc[8], zp[8], o[8]; unpack8(rc[k], zc); unpack8(rp[k], zp);
#pragma unroll
            for (int e = 0; e < 8; ++e) { const float z = zc[e] + (zp[e] - zc[e]) * mu[c0 + e];
                o[e] = (c0 < 64) ? (2.0f * fast_sigmoid(2.0f * z) - 1.0f) : (c0 < 128 ? z : fast_sigmoid(z)); }
            *(u32x4*)(LA + (size_t)m * LAC + c0) = pack8(o); } }
}

constexpr int TC = 32, SST = 352;
__device__ __forceinline__ void scan_load(const bf16_t* Z, const bf16_t* LO, size_t mrow0, int t0, int tid, int colb, u32x2 (&pz)[8]) {
    const int t = t0 + (tid >> 4); const size_t m = mrow0 + t; const bf16_t* zr = Z + m * ZC + colb; const bf16_t* lo = LO + m * LOC + colb;
    pz[0] = *(const u32x2*)(zr); pz[1] = *(const u32x2*)(zr + 512); pz[2] = *(const u32x2*)(zr + 1024);
    if (t > 0) { pz[3] = *(const u32x2*)(zr - ZC); pz[4] = *(const u32x2*)(zr + 512 - ZC); pz[5] = *(const u32x2*)(zr + 1024 - ZC); } else { pz[3] = (u32x2){0u, 0u}; pz[4] = (u32x2){0u, 0u}; pz[5] = (u32x2){0u, 0u}; }
    pz[6] = *(const u32x2*)(lo); pz[7] = *(const u32x2*)(lo + 512);
}
__device__ __forceinline__ void up4(const u32x2 w, float (&f)[4]) { f[0] = bflo(w.x); f[1] = bfhi(w.x); f[2] = bflo(w.y); f[3] = bfhi(w.y); }
__device__ __forceinline__ void scan_stage(const u32x2 (&pz)[8], LAS float* buf, float* RKB, size_t mrow0, int t0, int tid, int h, int half,
                                           const float (&mu_r)[4], const float (&mu_k)[4], const float (&mu_v)[4], const float (&kkc)[4], const float (&kac)[4], const float (&rkc)[4]) {
    const int tl = tid >> 4, cgp = tid & 15;
    float zr[4], zk[4], zv[4], zrp[4], zkp[4], zvp[4], ew[4], ic[4];
    up4(pz[0], zr); up4(pz[1], zk); up4(pz[2], zv); up4(pz[3], zrp); up4(pz[4], zkp); up4(pz[5], zvp); up4(pz[6], ew); up4(pz[7], ic);
    f32x4 r, k2, v, kkv, w; float n2 = 0.f, rkb = 0.f;
#pragma unroll
    for (int e = 0; e < 4; ++e) { r[e] = zr[e] + (zrp[e] - zr[e]) * mu_r[e]; const float k = zk[e] + (zkp[e] - zk[e]) * mu_k[e]; v[e] = zv[e] + (zvp[e] - zv[e]) * mu_v[e];
        kkv[e] = k * kkc[e]; n2 += kkv[e] * kkv[e]; k2[e] = k * (1.0f + (ic[e] - 1.0f) * kac[e]); w[e] = __builtin_amdgcn_exp2f(-1.4426950408889634f * ew[e]); rkb += r[e] * k2[e] * rkc[e]; }
    n2 = row16_sum(n2); rkb = row16_sum(rkb);
    const float inv = __builtin_amdgcn_rsqf(fmaxf(n2, 1e-24f));
    const f32x4 kkn = kkv * inv; f32x4 nb;
#pragma unroll
    for (int e = 0; e < 4; ++e) nb[e] = -kkn[e] * ic[e];
    if (half == 0 && cgp == 0) RKB[(mrow0 + t0 + tl) * 8 + h] = rkb;
    LAS float* sb = buf + tl * SST + 4 * cgp;
    *(LAS f32x4*)(sb) = kkn; *(LAS f32x4*)(sb + 64) = nb; *(LAS f32x4*)(sb + 128) = w; *(LAS f32x4*)(sb + 192) = k2; *(LAS f32x4*)(sb + 256) = r;
    if ((cgp >> 3) == half) *(LAS f32x4*)(buf + tl * SST + 320 + 4 * (cgp & 7)) = v;
}
__device__ __forceinline__ void scan_phase(const KAS Args& a, LAS unsigned char* lds, int i, const int tid_, const int bid, const int nblk) {
    const int tid = tid_, lane = tid & 63, wave = __builtin_amdgcn_readfirstlane(tid >> 6);
    const bf16_t* Z = (const bf16_t*)(a.ws + WS_HZ); const bf16_t* LO = (const bf16_t*)(a.ws + WS_LO);
    bf16_t* YR = (bf16_t*)((unsigned char*)a.out + OUT_YRAW); float* RKB = (float*)(a.ws + WS_RKB);
    LAS float* bufs = (LAS float*)lds; LAS float* ybuf = bufs + 2 * TC * SST;
    for (int unit = bid; unit < 256; unit += nblk) {
        const int bh = unit >> 1, half = unit & 1, b = bh >> 3, h = bh & 7, colb = h * 64 + 4 * (tid & 15);
        float mu_r[4], mu_k[4], mu_v[4], kkc[4], kac[4], rkc[4];
#pragma unroll
        for (int e = 0; e < 4; ++e) { mu_r[e] = a.mu[i * 1792 + colb + e]; mu_k[e] = a.mu[i * 1792 + 512 + colb + e]; mu_v[e] = a.mu[i * 1792 + 1024 + colb + e];
            kkc[e] = a.kk[i * 512 + colb + e]; kac[e] = a.ka[i * 512 + colb + e]; rkc[e] = a.rk[i * 512 + colb + e]; }
        const size_t mrow0 = (size_t)b * T;
        const int rl = wave * 4 + (lane >> 4), cgp = lane & 15;
        f32x4 S = {0.f, 0.f, 0.f, 0.f};
        u32x2 pz[8];
        __syncthreads();
        scan_load(Z, LO, mrow0, 0, tid, colb, pz);
        scan_stage(pz, bufs, RKB, mrow0, 0, tid, h, half, mu_r, mu_k, mu_v, kkc, kac, rkc);
        __syncthreads();
        for (int c = 0; c < T / TC; ++c) {
            const bool more = (c + 1 < T / TC);
            if (more) scan_load(Z, LO, mrow0, (c + 1) * TC, tid, colb, pz);
            const LAS float* buf = bufs + (c & 1) * (TC * SST); LAS float* yb = ybuf + (c & 1) * (TC * 32);
            {
                const LAS float* sb = buf + 4 * cgp; const LAS float* vb = buf + 320 + rl;
                f32x4 kk4 = *(const LAS f32x4*)(sb), nb4 = *(const LAS f32x4*)(sb + 64), w4 = *(const LAS f32x4*)(sb + 128), k4 = *(const LAS f32x4*)(sb + 192), r4 = *(const LAS f32x4*)(sb + 256);
                float v = vb[0], ysel = 0.f;
#pragma unroll
                for (int t = 0; t < TC; ++t) {
                    f32x4 kk4n = kk4, nb4n = nb4, w4n = w4, k4n = k4, r4n = r4; float vn = v;
                    if (t + 1 < TC) { const LAS float* sn = sb + (t + 1) * SST;
                        kk4n = *(const LAS f32x4*)(sn); nb4n = *(const LAS f32x4*)(sn + 64); w4n = *(const LAS f32x4*)(sn + 128); k4n = *(const LAS f32x4*)(sn + 192); r4n = *(const LAS f32x4*)(sn + 256); vn = vb[(t + 1) * SST]; }
                    __builtin_amdgcn_sched_barrier(0x6);
                    float sa = fmaf(S[3], kk4[3], fmaf(S[2], kk4[2], fmaf(S[1], kk4[1], S[0] * kk4[0])));
                    const f32x4 Tm = S * w4 + k4 * v;
                    sa = row16_sum(sa);
                    S = Tm + nb4 * sa;
                    float y = fmaf(S[3], r4[3], fmaf(S[2], r4[2], fmaf(S[1], r4[1], S[0] * r4[0]))); y = row16_sum(y);
                    ysel = (cgp == (t & 15)) ? y : ysel;
                    if ((t & 15) == 15) yb[(t - 15 + cgp) * 32 + rl] = ysel;
                    kk4 = kk4n; nb4 = nb4n; w4 = w4n; k4 = k4n; r4 = r4n; v = vn; }
            }
            if (more) scan_stage(pz, bufs + ((c + 1) & 1) * (TC * SST), RKB, mrow0, (c + 1) * TC, tid, h, half, mu_r, mu_k, mu_v, kkc, kac, rkc);
            __syncthreads();
#pragma unroll
            for (int q = 0; q < 2; ++q) { const int idx = tid + 512 * q, t = idx >> 5, r = idx & 31;
                YR[(mrow0 + c * TC + t) * 512 + h * 64 + half * 32 + r] = (bf16_t)(pk2(yb[t * 32 + r], 0.f) & 0xffffu); }
        }
    }
}

__device__ __forceinline__ void post_phase(const KAS Args& a, LAS unsigned char* lds, int i, const int tid_, const int bid, const int nblk) {
    const int tid = tid_, lane = tid & 63, wave = __builtin_amdgcn_readfirstlane(tid >> 6);
    const bf16_t* Z = (const bf16_t*)(a.ws + WS_HZ); const bf16_t* LO = (const bf16_t*)(a.ws + WS_LO); const bf16_t* YR = (const bf16_t*)((unsigned char*)a.out + OUT_YRAW);
    const float* RKB = (const float*)(a.ws + WS_RKB); bf16_t* Y = (bf16_t*)(a.ws + WS_Y);
    { const int c0 = 8 * lane; float gg[8], gb[8], muv[8];
#pragma unroll
      for (int e = 0; e < 8; ++e) { gg[e] = a.gng[i * 512 + c0 + e]; gb[e] = a.gnb[i * 512 + c0 + e]; muv[e] = a.mu[i * 1792 + 1024 + c0 + e]; }
      const int stride = nblk * 8;
      for (int mb = bid * 8 + wave; mb < M; mb += 2 * stride) {
          u32x4 ry[2], rvc[2], rvp[2], rg[2]; float bon[2]; bool has[2];
#pragma unroll
          for (int k = 0; k < 2; ++k) { const int m = mb + k * stride; has[k] = (m < M); const int mm = has[k] ? m : mb; const int t = mm & (T - 1);
              ry[k] = *(const u32x4*)(YR + (size_t)mm * 512 + c0); rvc[k] = *(const u32x4*)(Z + (size_t)mm * ZC + 1024 + c0);
              rvp[k] = (t > 0) ? *(const u32x4*)(Z + (size_t)(mm - 1) * ZC + 1024 + c0) : (u32x4){0u, 0u, 0u, 0u};
              rg[k] = *(const u32x4*)(LO + (size_t)mm * LOC + 1024 + c0); bon[k] = RKB[(size_t)mm * 8 + (lane >> 3)]; }
#pragma unroll
          for (int k = 0; k < 2; ++k) { const int m = mb + k * stride;
              float y[8], vc[8], vp[8], g[8], o[8];
              unpack8(ry[k], y); unpack8(rvc[k], vc); unpack8(rvp[k], vp); unpack8(rg[k], g);
              float s = 0.f;
#pragma unroll
              for (int e = 0; e < 8; ++e) s += y[e];
              s += __shfl_xor(s, 1); s += __shfl_xor(s, 2); s += __shfl_xor(s, 4);
              const float mean = s * (1.0f / 64.0f); float q = 0.f;
#pragma unroll
              for (int e = 0; e < 8; ++e) { const float d = y[e] - mean; q += d * d; }
              q += __shfl_xor(q, 1); q += __shfl_xor(q, 2); q += __shfl_xor(q, 4);
              const float rstd = 1.0f / sqrtf(q * (1.0f / 64.0f) + 64e-5f);
#pragma unroll
              for (int e = 0; e < 8; ++e) { const float vs = vc[e] + (vp[e] - vc[e]) * muv[e]; o[e] = ((y[e] - mean) * rstd * gg[e] + gb[e] + bon[k] * vs) * g[e]; }
              if (has[k]) *(u32x4*)(Y + (size_t)m * D + c0) = pack8(o); } } }
    LAS float* stat = (LAS float*)lds;
    LAS bf16_t* Wl = (LAS bf16_t*)(lds + 1024);
    LAS bf16_t* St = (LAS bf16_t*)(lds + 1024 + 128 * 136 * 2);
    const int l15 = lane & 15, l4 = lane >> 4;
    for (int ch = bid; ch < M / 128; ch += nblk) { const size_t m0 = (size_t)ch * 128;
        __syncthreads();
#pragma unroll 1
        for (int tb = 0; tb < 16; tb += 4) { u32x4 raw[4];
#pragma unroll
            for (int k = 0; k < 4; ++k) raw[k] = *(const u32x4*)(Z + (m0 + wave * 16 + tb + k) * ZC + 2304 + 8 * lane);
#pragma unroll
            for (int k = 0; k < 4; ++k) { const int tok = wave * 16 + tb + k; float sv[8]; unpack8(raw[k], sv); float s = 0.f;
#pragma unroll
                for (int e = 0; e < 8; e += 2) { const f32x2 gq = pg8::gelu_pk((f32x2){sv[e], sv[e + 1]}); sv[e] = gq.x; sv[e + 1] = gq.y; s += gq.x + gq.y; }
                const float mean = wave_sum(s) * (1.0f / 512.0f); float q = 0.f;
#pragma unroll
                for (int e = 0; e < 8; ++e) { const float d = sv[e] - mean; q += d * d; }
                const float rstd = 1.0f / sqrtf(wave_sum(q) * (1.0f / 512.0f) + 1e-5f);
                if (lane == 0) { stat[2 * tok] = mean; stat[2 * tok + 1] = rstd; } } }
        const int stok = tid >> 2, spart = tid & 3, etok = 16 * wave + l15;
        u32x4 raw[4]; f32x4 wr0[4], wr1[4];
#define GM_LOAD(G) do { const float* wsrc_ = a.wsp + ((size_t)(i * 4 + (G)) * 128 + stok) * 128 + 32 * spart; _Pragma("unroll") for (int q = 0; q < 4; ++q) { \
        raw[q] = *(const u32x4*)(Z + (m0 + stok) * ZC + 2304 + (G) * 128 + 32 * spart + 8 * q); wr0[q] = *(const f32x4*)(wsrc_ + 8 * q); wr1[q] = *(const f32x4*)(wsrc_ + 8 * q + 4); } } while (0)
        GM_LOAD(0);
#pragma unroll 1
        for (int g = 0; g < 4; ++g) {
            __syncthreads();
            { const float mean = stat[2 * stok], rstd = stat[2 * stok + 1];
#pragma unroll
              for (int q = 0; q < 4; ++q) { float sv[8], wv[8]; const int d0 = 32 * spart + 8 * q;
                  unpack8(raw[q], sv);
#pragma unroll
                  for (int e = 0; e < 8; e += 2) { const f32x2 gq = pg8::gelu_pk((f32x2){sv[e], sv[e + 1]}); sv[e] = gq.x; sv[e + 1] = gq.y; }
#pragma unroll
                  for (int e = 0; e < 8; ++e) { const int dd = g * 128 + d0 + e; const float sn = (sv[e] - mean) * rstd * a.lng[i * 512 + dd] + a.lnb[i * 512 + dd];
                      St[(d0 + e) * 136 + stok] = (bf16_t)(pk2(sn, 0.f) & 0xffffu); }
#pragma unroll
                  for (int e = 0; e < 4; ++e) { wv[e] = (d0 + e <= stok) ? wr0[q][e] : 0.f; wv[4 + e] = (d0 + 4 + e <= stok) ? wr1[q][e] : 0.f; }
                  *(LAS u32x4*)(Wl + stok * 136 + d0) = pack8(wv); } }
            if (g < 3) GM_LOAD(g + 1);
            u32x2 uz[8];
#pragma unroll
            for (int dt = 0; dt < 8; ++dt) uz[dt] = *(const u32x2*)(Z + (m0 + etok) * ZC + 1792 + g * 128 + 16 * dt + 4 * l4);
            const float bs = a.bsp[(i * 4 + g) * 128 + etok];
            __syncthreads();
            f32x4 acc[8];
#pragma unroll
            for (int dt = 0; dt < 8; ++dt) acc[dt] = (f32x4){0.f, 0.f, 0.f, 0.f};
#pragma unroll
            for (int ks = 0; ks < 4; ++ks) { const bf16x8 wf = *(const LAS bf16x8*)(Wl + (16 * wave + l15) * 136 + 32 * ks + 8 * l4);
#pragma unroll
                for (int dt = 0; dt < 8; ++dt) { const bf16x8 sf = *(const LAS bf16x8*)(St + (16 * dt + l15) * 136 + 32 * ks + 8 * l4);
                    acc[dt] = __builtin_amdgcn_mfma_f32_16x16x32_bf16(sf, wf, acc[dt], 0, 0, 0); } }
#pragma unroll
            for (int dt = 0; dt < 8; ++dt) { const f32x2 u0 = pg8::gelu_pk((f32x2){bflo(uz[dt].x), bfhi(uz[dt].x)}), u1 = pg8::gelu_pk((f32x2){bflo(uz[dt].y), bfhi(uz[dt].y)});
                *(u32x2*)(Y + (m0 + etok) * D + 512 + g * 128 + 16 * dt + 4 * l4) = (u32x2){pk2(u0.x * (acc[dt][0] + bs), u0.y * (acc[dt][1] + bs)), pk2(u1.x * (acc[dt][2] + bs), u1.y * (acc[dt][3] + bs))}; }
        }
#undef GM_LOAD
    }
}

__device__ __forceinline__ void attn_phase(const KAS Args& a, LAS unsigned char* lds, int i, const int tid_, const int bid, const int nblk) {
    const int tid = tid_, lane = tid & 63, wave = __builtin_amdgcn_readfirstlane(tid >> 6);
    const int l15 = lane & 15, l4 = lane >> 4;
    const bf16_t* QKV = (const bf16_t*)(a.ws + WS_HZ); bf16_t* Y = (bf16_t*)(a.ws + WS_Y); const float* tab = (const float*)(a.ws + WS_ROPE);
    LAS bf16_t* Ks = (LAS bf16_t*)lds;
    LAS bf16_t* Vt = (LAS bf16_t*)(lds + 36864);
    LAS bf16_t* Pb = (LAS bf16_t*)(lds + 36864 + 33792) + wave * (16 * 168);
    const float* qn = a.qn + i * 64; const float* kn = a.kn + i * 64;
    for (int unit = bid; unit < 16 * 4 * 32; unit += nblk) {
        const int b = unit >> 7, kvh = (unit >> 5) & 3, n = unit & 31;
        const size_t m0 = (size_t)b * T + n * 128;
        __syncthreads();
        { const int key = tid >> 1, hh = tid & 1; const bool valid = (n > 0) || (key >= 128); const size_t mk = m0 + key - 128;
          float x1[16], x2[16];
          if (valid) { const bf16_t* kp = QKV + mk * QKVC + 1024 + kvh * 64 + 16 * hh; float t8[8];
              unpack8(*(const u32x4*)(kp), t8);
#pragma unroll
              for (int e = 0; e < 8; ++e) x1[e] = t8[e];
              unpack8(*(const u32x4*)(kp + 8), t8);
#pragma unroll
              for (int e = 0; e < 8; ++e) x1[8 + e] = t8[e];
              unpack8(*(const u32x4*)(kp + 32), t8);
#pragma unroll
              for (int e = 0; e < 8; ++e) x2[e] = t8[e];
              unpack8(*(const u32x4*)(kp + 40), t8);
#pragma unroll
              for (int e = 0; e < 8; ++e) x2[8 + e] = t8[e];
          } else {
#pragma unroll
              for (int e = 0; e < 16; ++e) { x1[e] = 0.f; x2[e] = 0.f; } }
          float s = 0.f;
#pragma unroll
          for (int e = 0; e < 16; ++e) s += x1[e] * x1[e] + x2[e] * x2[e];
          s += __shfl_xor(s, 1);
          const float rms = 1.0f / sqrtf(s * (1.0f / 64.0f) + 1e-6f);
          float o1[16], o2[16];
#pragma unroll
          for (int e = 0; e < 16; ++e) { const int d = 16 * hh + e; float c = 1.f, sn = 0.f; if (valid) { c = tab[mk * 64 + d]; sn = tab[mk * 64 + 32 + d]; }
              const float a1 = x1[e] * rms * kn[d], a2 = x2[e] * rms * kn[32 + d]; o1[e] = a1 * c - a2 * sn; o2[e] = a2 * c + a1 * sn; }
          LAS bf16_t* kd = Ks + key * 72 + 16 * hh;
          *(LAS u32x4*)(kd) = (u32x4){pk2(o1[0], o1[1]), pk2(o1[2], o1[3]), pk2(o1[4], o1[5]), pk2(o1[6], o1[7])};
          *(LAS u32x4*)(kd + 8) = (u32x4){pk2(o1[8], o1[9]), pk2(o1[10], o1[11]), pk2(o1[12], o1[13]), pk2(o1[14], o1[15])};
          *(LAS u32x4*)(kd + 32) = (u32x4){pk2(o2[0], o2[1]), pk2(o2[2], o2[3]), pk2(o2[4], o2[5]), pk2(o2[6], o2[7])};
          *(LAS u32x4*)(kd + 40) = (u32x4){pk2(o2[8], o2[9]), pk2(o2[10], o2[11]), pk2(o2[12], o2[13]), pk2(o2[14], o2[15])};
        }
        { const int kp = (wave & 1) * 64 + lane, dq = wave >> 1; const bool valid = (n > 0) || (kp >= 64); const size_t mk = m0 + 2 * kp - 128;
          u32x4 va0 = {0u, 0u, 0u, 0u}, va1 = va0, vb0 = va0, vb1 = va0;
          if (valid) { const bf16_t* vp = QKV + mk * QKVC + 1280 + kvh * 64 + 16 * dq; va0 = *(const u32x4*)(vp); va1 = *(const u32x4*)(vp + 8); vb0 = *(const u32x4*)(vp + QKVC); vb1 = *(const u32x4*)(vp + QKVC + 8); }
          LAS unsigned* vt32 = (LAS unsigned*)Vt;
#define VT_ST(dd, A, B) vt32[((16 * dq + (dd)) * 264 + 2 * kp) >> 1] = ((A) & 0xffffu) | ((B) << 16); vt32[((16 * dq + (dd) + 1) * 264 + 2 * kp) >> 1] = ((A) >> 16) | ((B) & 0xffff0000u)
          VT_ST(0, va0.x, vb0.x); VT_ST(2, va0.y, vb0.y); VT_ST(4, va0.z, vb0.z); VT_ST(6, va0.w, vb0.w);
          VT_ST(8, va1.x, vb1.x); VT_ST(10, va1.y, vb1.y); VT_ST(12, va1.z, vb1.z); VT_ST(14, va1.w, vb1.w);
#undef VT_ST
        }
        __syncthreads();
        const int g = wave >> 1, qh = kvh * 4 + g; const float sink = a.sinks[i * 16 + qh];
#pragma unroll 1
        for (int pass = 0; pass < 2; ++pass) { const int i0 = (wave & 1) * 64 + pass * 32;
            bf16x8 qf[2][2];
#pragma unroll
            for (int rt = 0; rt < 2; ++rt) { const size_t mq = m0 + i0 + 16 * rt + l15; const bf16_t* qp = QKV + mq * QKVC + qh * 64 + 8 * l4; float x1[8], x2[8];
                unpack8(*(const u32x4*)(qp), x1); unpack8(*(const u32x4*)(qp + 32), x2);
                float s = 0.f;
#pragma unroll
                for (int e = 0; e < 8; ++e) s += x1[e] * x1[e] + x2[e] * x2[e];
                s += __shfl_xor(s, 16); s += __shfl_xor(s, 32);
                const float rms = 0.125f * __builtin_amdgcn_rsqf(s * (1.0f / 64.0f) + 1e-6f);
                float o1[8], o2[8];
#pragma unroll
                for (int e = 0; e < 8; ++e) { const int d = 8 * l4 + e; const float c = tab[mq * 64 + d], sn = tab[mq * 64 + 32 + d];
                    const float a1 = x1[e] * rms * qn[d], a2 = x2[e] * rms * qn[32 + d]; o1[e] = a1 * c - a2 * sn; o2[e] = a2 * c + a1 * sn; }
                qf[rt][0] = __builtin_bit_cast(bf16x8, pack8(o1)); qf[rt][1] = __builtin_bit_cast(bf16x8, pack8(o2)); }
            f32x4 sc[2][10];
#pragma unroll
            for (int rt = 0; rt < 2; ++rt)
#pragma unroll
                for (int kt = 0; kt < 10; ++kt) sc[rt][kt] = (f32x4){0.f, 0.f, 0.f, 0.f};
#pragma unroll
            for (int kt = 0; kt < 10; ++kt)
#pragma unroll
                for (int ks = 0; ks < 2; ++ks) { const bf16x8 kf = *(const LAS bf16x8*)(Ks + (i0 + 16 * kt + l15) * 72 + 32 * ks + 8 * l4);
#pragma unroll
                    for (int rt = 0; rt < 2; ++rt) if (kt - rt >= 0 && kt - rt <= 8) sc[rt][kt] = __builtin_amdgcn_mfma_f32_16x16x32_bf16(kf, qf[rt][ks], sc[rt][kt], 0, 0, 0); }
#pragma unroll
            for (int rt = 0; rt < 2; ++rt) {
                float mx = -INFINITY;
#pragma unroll
                for (int kt = 0; kt < 10; ++kt) { const int dk = kt - rt;
                    if (dk < 0 || dk > 8) continue;
#pragma unroll
                    for (int reg = 0; reg < 4; ++reg) { float sv = sc[rt][kt][reg];
                        if (dk == 0) sv = (4 * l4 + reg > l15) ? sv : -INFINITY;
                        if (dk == 8) sv = (4 * l4 + reg <= l15) ? sv : -INFINITY;
                        if (n == 0) sv = (i0 + 16 * kt + 4 * l4 + reg >= 128) ? sv : -INFINITY;
                        sc[rt][kt][reg] = sv; mx = fmaxf(mx, sv); } }
                mx = fmaxf(mx, __shfl_xor(mx, 16)); mx = fmaxf(mx, __shfl_xor(mx, 32)); mx = fmaxf(mx, sink);
                const float mneg = -mx * 1.4426950408889634f; float sum = 0.f;
#pragma unroll
                for (int kt = 0; kt < 10; ++kt) { const int dk = kt - rt;
                    if (dk < 0 || dk > 8) { sc[rt][kt] = (f32x4){0.f, 0.f, 0.f, 0.f}; continue; }
#pragma unroll
                    for (int reg = 0; reg < 4; ++reg) { const float p = __builtin_amdgcn_exp2f(fmaf(sc[rt][kt][reg], 1.4426950408889634f, mneg)); sc[rt][kt][reg] = p; sum += p; } }
                sum += __shfl_xor(sum, 16); sum += __shfl_xor(sum, 32);
                sum += __builtin_amdgcn_exp2f(fmaf(sink, 1.4426950408889634f, mneg));
                const float rden = __builtin_amdgcn_rcpf(sum);
                f32x4 o[4];
#pragma unroll
                for (int dt = 0; dt < 4; ++dt) o[dt] = (f32x4){0.f, 0.f, 0.f, 0.f};
#pragma unroll
                for (int ks = 0; ks < 5; ++ks) { const f32x4 pa = sc[rt][2 * ks], pb = sc[rt][2 * ks + 1];
                    const bf16x8 pf = __builtin_bit_cast(bf16x8, (u32x4){pk2(pa[0], pa[1]), pk2(pa[2], pa[3]), pk2(pb[0], pb[1]), pk2(pb[2], pb[3])});
#pragma unroll
                    for (int dt = 0; dt < 4; ++dt) { const LAS bf16_t* vp = Vt + (16 * dt + l15) * 264 + i0 + 32 * ks + 4 * l4;
                        const u32x2 v0 = *(const LAS u32x2*)(vp), v1 = *(const LAS u32x2*)(vp + 16);
                        const bf16x8 vf = __builtin_bit_cast(bf16x8, (u32x4){v0.x, v0.y, v1.x, v1.y});
                        o[dt] = __builtin_amdgcn_mfma_f32_16x16x32_bf16(vf, pf, o[dt], 0, 0, 0); } }
                { const size_t mq = m0 + i0 + 16 * rt + l15;
#pragma unroll
                  for (int dt = 0; dt < 4; ++dt) *(u32x2*)(Y + mq * D + qh * 64 + 16 * dt + 4 * l4) = (u32x2){pk2(o[dt][0] * rden, o[dt][1] * rden), pk2(o[dt][2] * rden, o[dt][3] * rden)}; }
            }
        }
    }
}

#define XB_TMO      128
#define XB_XCNT(j)  (256  + 64 * (j))
#define XB_XSUB(j)  (1280 + 64 * (j))
#define XB_XGEN(j)  (2304 + 64 * (j))
#define XB_TOP      3328
#define XB_TOPGEN   3392
#define XCD_BAR_WORDS 3456
#define XB_SPIN_CAP (1u << 18)

__device__ __forceinline__ unsigned xb_ld(unsigned* p)              { return __hip_atomic_load(p, __ATOMIC_RELAXED, __HIP_MEMORY_SCOPE_AGENT); }
__device__ __forceinline__ unsigned xb_add(unsigned* p, unsigned v) { return __hip_atomic_fetch_add(p, v, __ATOMIC_RELAXED, __HIP_MEMORY_SCOPE_AGENT); }
__device__ __forceinline__ unsigned xb_xcc_id() { return (unsigned)__builtin_amdgcn_s_getreg((3 << 11) | 20) & 0xFu; }
#define XB_SPIN(cond, bar) do { unsigned _sp = 0; while (cond) { __builtin_amdgcn_s_sleep(1); \
    if ((++_sp & 255u) == 0u) { if (xb_ld(&(bar)[XB_TMO])) break; if (_sp > XB_SPIN_CAP) { atomicAdd(&(bar)[XB_TMO], 1u); break; } } } } while (0)

struct XcdBarrier {
    unsigned* bar; unsigned x;
    volatile LAS unsigned* st;
};

__device__ __forceinline__ XcdBarrier xcd_barrier_post(unsigned* bar, volatile LAS unsigned* st) {
    XcdBarrier b; b.bar = bar; b.x = xb_xcc_id(); b.st = st;
    if (threadIdx.x == 0) (void)xb_add(&bar[XB_XCNT(b.x)], 1u);
    return b;
}
__device__ __forceinline__ void xcd_barrier_complete(unsigned* bar, unsigned x, unsigned& nloc, unsigned& nx) {
    const unsigned G = gridDim.x * gridDim.y * gridDim.z;
    unsigned sum, cnt, mine, sp = 0u;
    for (;;) {
        sum = 0u; cnt = 0u; mine = 0u;
#pragma unroll
        for (unsigned j = 0; j < 16; ++j) { const unsigned c = xb_ld(&bar[XB_XCNT(j)]); sum += c; cnt += (c > 0u) ? 1u : 0u; mine = (j == x) ? c : mine; }
        if (sum == G) break;
        __builtin_amdgcn_s_sleep(1);
        if ((++sp & 255u) == 0u) { if (xb_ld(&bar[XB_TMO])) break; if (sp > XB_SPIN_CAP) { atomicAdd(&bar[XB_TMO], 1u); break; } }
    }
    nloc = mine > 0u ? mine : 1u; nx = cnt > 0u ? cnt : 1u;
}

__device__ __forceinline__ void xcd_barrier(const XcdBarrier& b) {
    asm volatile("s_waitcnt vmcnt(0)" ::: "memory");
    __syncthreads();
    if (threadIdx.x == 0) {
        unsigned* bar = b.bar;
        __builtin_amdgcn_s_waitcnt(0);
        unsigned nloc = b.st[0], nx = b.st[1];
        if (nloc == 0u) { xcd_barrier_complete(bar, b.x, nloc, nx); b.st[0] = nloc; b.st[1] = nx; }
        const unsigned old = xb_add(&bar[XB_XSUB(b.x)], 1u);
        const unsigned gen = old / nloc;
        if (old + 1u == (gen + 1u) * nloc) {
            __builtin_amdgcn_fence(__ATOMIC_RELEASE, "agent");
            asm volatile("s_waitcnt vmcnt(0)" ::: "memory");
            const unsigned og = xb_add(&bar[XB_TOP], 1u);
            const unsigned tg = og / nx;
            if (og + 1u == (tg + 1u) * nx) xb_add(&bar[XB_TOPGEN], 1u);
            else XB_SPIN(xb_ld(&bar[XB_TOPGEN]) == tg, bar);
            __builtin_amdgcn_fence(__ATOMIC_ACQUIRE, "agent");
            xb_add(&bar[XB_XGEN(b.x)], 1u);
            asm volatile("s_waitcnt vmcnt(0)" ::: "memory");
        } else {
            XB_SPIN(xb_ld(&bar[XB_XGEN(b.x)]) == gen, bar);
            __builtin_amdgcn_fence(__ATOMIC_ACQUIRE, "agent");
            asm volatile("s_waitcnt vmcnt(0)" ::: "memory");
        }
    }
    __syncthreads();
}
#ifndef PROBE_KIND
#define PROBE_KIND -1
#endif
#if PROBE_KIND == 6
constexpr int NE = 11, NO = 7; __device__ const signed char EVEN_K[NE] = {1, 2, 3, 4, 5, 6, 6, 7, 8, 1, 2}, EVEN_S[NE] = {0, 0, 0, 0, 0, 0, 0, 0, 0, 1, 1}, ODD_K[NO] = {1, 2, 3, 9, 8, 1, 2}, ODD_S[NO] = {0, 0, 0, 0, 0, 1, 1};
#elif PROBE_KIND == 7
constexpr int NE = 11, NO = 7; __device__ const signed char EVEN_K[NE] = {1, 2, 3, 4, 5, 6, 7, 7, 8, 1, 2}, EVEN_S[NE] = {0, 0, 0, 0, 0, 0, 0, 0, 0, 1, 1}, ODD_K[NO] = {1, 2, 3, 9, 8, 1, 2}, ODD_S[NO] = {0, 0, 0, 0, 0, 1, 1};
#elif PROBE_KIND == 9
constexpr int NE = 10, NO = 8; __device__ const signed char EVEN_K[NE] = {1, 2, 3, 4, 5, 6, 7, 8, 1, 2}, EVEN_S[NE] = {0, 0, 0, 0, 0, 0, 0, 0, 1, 1}, ODD_K[NO] = {1, 2, 3, 9, 9, 8, 1, 2}, ODD_S[NO] = {0, 0, 0, 0, 0, 0, 1, 1};
#elif PROBE_KIND == 1
constexpr int NE = 12, NO = 9; __device__ const signed char EVEN_K[NE] = {1, 1, 2, 3, 4, 5, 6, 7, 8, 1, 1, 2}, EVEN_S[NE] = {0, 0, 0, 0, 0, 0, 0, 0, 0, 1, 1, 1}, ODD_K[NO] = {1, 1, 2, 3, 9, 8, 1, 1, 2}, ODD_S[NO] = {0, 0, 0, 0, 0, 0, 1, 1, 1};
#elif PROBE_KIND == 3
constexpr int NE = 12, NO = 8; __device__ const signed char EVEN_K[NE] = {1, 2, 3, 3, 4, 5, 5, 6, 7, 8, 1, 2}, EVEN_S[NE] = {0, 0, 0, 0, 0, 0, 0, 0, 0, 0, 1, 1}, ODD_K[NO] = {1, 2, 3, 3, 9, 8, 1, 2}, ODD_S[NO] = {0, 0, 0, 0, 0, 0, 1, 1};
#else
constexpr int NE = 10, NO = 7; __device__ const signed char EVEN_K[NE] = {1, 2, 3, 4, 5, 6, 7, 8, 1, 2}, EVEN_S[NE] = {0, 0, 0, 0, 0, 0, 0, 0, 1, 1}, ODD_K[NO] = {1, 2, 3, 9, 8, 1, 2}, ODD_S[NO] = {0, 0, 0, 0, 0, 1, 1};
#endif
constexpr int N_PHASES = 1 + 2 * (NE + NO);
__global__ void __launch_bounds__(512) mega_fwd(Args a_) {
    extern __shared__ __attribute__((aligned(16))) unsigned char lds_raw[];
    cg::grid_group grid = cg::this_grid();
    const int ph_lo = a_.ph_lo, ph_hi = a_.ph_hi;
    volatile LAS unsigned* MISC = (volatile LAS unsigned*)((LAS unsigned char*)lds_raw + 131072 + 320);
    if (threadIdx.x < 32) MISC[threadIdx.x] = 0u;
    __syncthreads();
    XcdBarrier xbar; xbar.bar = (unsigned*)a_.ws; xbar.x = 0; xbar.st = nullptr;
    for (int ph = ph_lo; ph < ph_hi; ++ph) {
        int koff = 0, bid = blockIdx.x, nblk = gridDim.x, tid_ = threadIdx.x; asm volatile("" : "+s"(koff), "+s"(bid), "+s"(nblk), "+v"(tid_));
        LAS unsigned char* lds = (LAS unsigned char*)lds_raw + koff;
        const KAS Args& a = *kargs(koff);
        unsigned char* ws = a.ws;
        float* ssb = (float*)(ws + WS_SS);
        bf16_t* XB = (bf16_t*)(ws + WS_XB); bf16_t* HZ = (bf16_t*)(ws + WS_HZ); bf16_t* YB = (bf16_t*)(ws + WS_Y);
        int kind = 0, l = 0, second = 0;
        if (ph > 0) { const int p = ph - 1, pair = p / (NE + NO), q = p % (NE + NO);
            if (q < NE) { l = 2 * pair; kind = EVEN_K[q]; second = EVEN_S[q]; }
            else { l = 2 * pair + 1; kind = ODD_K[q - NE]; second = ODD_S[q - NE]; } }
        const int i = l >> 1, odd = l & 1, f = 2 * l + second;
#ifndef PHM
#define PHM 0x3ff
#endif
        if (kind == 0) { if (bid == 0) { for (int k_ = tid_; k_ < 4096; k_ += 512) ((unsigned*)ws)[k_] = 0u; }
                         if (PHM & 1) prologue(a, lds, tid_, bid, nblk); }
        else if (kind == 1 && (PHM & 2)) {
            pg8::Gemm g{XB, (const bf16_t*)(ws + WS_W + (size_t)f * FFN_STRIDE), M, 2 * FF, D}; pg8::StaticOrder S; S.init(M, 2 * FF, nblk, bid);
            pg8::EpiSwiglu E{HZ, FF, ssb};
            pg8::gemm_phase<pg8::EpiSwiglu, pg8::StaticOrder, true, true>(lds, g, S, E, tid_);
        } else if ((kind == 2 || kind == 8) && (PHM & 4)) {
            pg8::Gemm g; const float* bias = nullptr; float scale = 1.0f; float* ssn;
            if (kind == 2) { g = pg8::Gemm{HZ, (const bf16_t*)(ws + WS_W + (size_t)f * FFN_STRIDE + WD_OFF), M, D, FF}; scale = 0.5f; ssn = ssb; }
            else { g = pg8::Gemm{YB, (const bf16_t*)(odd ? ws + WS_WODD + i * ODD_STRIDE + WO_OFF : ws + WS_WMIX + i * EVEN_STRIDE + WOUT_OFF), M, D, D}; if (odd) bias = a.bo + i * D; ssn = ssb; }
            const bool first = (kind == 2 && l == 0 && !second), last = (kind == 2 && l == 3 && second), prelast = (kind == 8 && l == 3);
            bf16_t* xl = (bf16_t*)((unsigned char*)a.out + OUT_XL); bf16_t* xl2 = (bf16_t*)(ws + WS_LO);
            pg8::StaticOrder S; S.init(M, D, nblk, bid);
            pg8::EpiResid E{first ? a.x : nullptr, XB, last ? xl2 : xl, prelast ? xl2 : xl, last ? a.out : nullptr, ssn, bias, scale};
            pg8::gemm_phase<pg8::EpiResid, pg8::StaticOrder, false, true>(lds, g, S, E, tid_);
        } else if ((kind == 3 || kind == 5) && (PHM & 8)) {
            pg8::Gemm g; pg8::EpiBf E;
            if (kind == 3 && !odd) { g = pg8::Gemm{XB, (const bf16_t*)(ws + WS_WMIX + i * EVEN_STRIDE), M, ZC, D}; E = pg8::EpiBf{HZ, ZC, ssb, nullptr, 0}; }
            else if (kind == 3) { g = pg8::Gemm{XB, (const bf16_t*)(ws + WS_WODD + i * ODD_STRIDE), M, QKVC, D}; E = pg8::EpiBf{HZ, QKVC, ssb, a.bqkv + i * QKVC, 0}; }
            else { g = pg8::Gemm{(const bf16_t*)((unsigned char*)a.out + OUT_LA), (const bf16_t*)(ws + WS_WMIX + i * EVEN_STRIDE + WLORA_OFF), M, LOC, LAC}; E = pg8::EpiBf{(bf16_t*)(ws + WS_LO), LOC, nullptr, (const float*)(ws + WS_LB) + i * LOC, 1}; }
            pg8::StaticOrder S; S.init(M, g.N, nblk, bid);
            pg8::gemm_phase<pg8::EpiBf, pg8::StaticOrder, true, true>(lds, g, S, E, tid_);
        } else if (kind == 4 && (PHM & 16)) el_phase(a, i, tid_, bid, nblk);
        else if (kind == 6 && (PHM & 32)) scan_phase(a, lds, i, tid_, bid, nblk);
        else if (kind == 7 && (PHM & 64)) post_phase(a, lds, i, tid_, bid, nblk);
        else if (kind == 9 && (PHM & 128)) attn_phase(a, lds, i, tid_, bid, nblk);
#ifndef PROBE_SYNC
#define PROBE_SYNC 1
#endif
#ifndef PROBE_PRO2
#define PROBE_PRO2 0
#endif
        if (PROBE_PRO2 && ph == 0) { grid.sync(); prologue(a, lds, tid_, bid, nblk); }
        if (ph + 1 < ph_hi) { if (ph == ph_lo) { grid.sync(); xbar = xcd_barrier_post((unsigned*)ws, MISC + 8); } else xcd_barrier(xbar); }
    }
}

#ifndef MK_MULTI
#define MK_MULTI 0
#endif
extern "C" void kernel_launch(void* const* d_in, const int* in_sizes, int n_in, void* d_out, int out_size, void* d_ws, size_t ws_size, hipStream_t stream) {
    static int grid = 0;
    if (grid == 0) {
        if (n_in != 35 || in_sizes[0] != M * D || out_size != M * D || ws_size < WS_END) { fprintf(stderr, "kernel_launch: unexpected shapes (n_in %d, in0 %d, out %d, ws %zu); nothing launched\n", n_in, n_in > 0 ? in_sizes[0] : -1, out_size, ws_size); grid = -1; return; }
        int dev = 0, cus = 0, per_cu = 0;
        hipGetDevice(&dev); hipDeviceGetAttribute(&cus, hipDeviceAttributeMultiprocessorCount, dev);
        if (hipFuncSetAttribute((const void*)mega_fwd, hipFuncAttributeMaxDynamicSharedMemorySize, LDS_BYTES) != hipSuccess) { fprintf(stderr, "kernel_launch: hipFuncSetAttribute failed\n"); grid = -1; return; }
        if (hipOccupancyMaxActiveBlocksPerMultiprocessor(&per_cu, (const void*)mega_fwd, 512, LDS_BYTES) != hipSuccess || per_cu < 1) { fprintf(stderr, "kernel_launch: occupancy query says %d\n", per_cu); per_cu = 1; }
        (void)hipGetLastError();
        grid = cus * per_cu;
        if (grid > 256) grid = 256;
    }
    if (grid < 0) return;
    Args a{};
    const float** fp = (const float**)&a.f1n;
    a.x = (const float*)d_in[0]; a.pos = (const int*)d_in[1];
    for (int k = 2; k < 35; ++k) fp[k - 2] = (const float*)d_in[k];
    a.out = (float*)d_out; a.ws = (unsigned char*)d_ws;
    for (int d = 0; d < 32; ++d) a.inv_freq[d] = (float)pow(10000.0, -(double)(2 * d) / 64.0);
#if MK_MULTI
    for (int ph = 0; ph < N_PHASES; ++ph) { a.ph_lo = ph; a.ph_hi = ph + 1; hipLaunchKernelGGL(mega_fwd, dim3(grid), dim3(512), LDS_BYTES, stream, a); }
#else
    a.ph_lo = 0; a.ph_hi = N_PHASES;
    void* args[] = {&a};
    hipError_t e = hipLaunchCooperativeKernel((const void*)mega_fwd, dim3(grid), dim3(512), args, LDS_BYTES, stream);
    if (e != hipSuccess) fprintf(stderr, "cooperative launch failed: %s (grid %d)\n", hipGetErrorString(e), grid);
#endif
}
```

```cpp
#include <hip/hip_runtime.h>
#include <hip/hip_cooperative_groups.h>
#include <cstdio>
#include <cstdint>
#include <cmath>
namespace pg8 {
#define PG8_LAS __attribute__((address_space(3)))
typedef unsigned short bf16_t;
typedef short bf16x8 __attribute__((ext_vector_type(8)));
typedef float f32x4 __attribute__((ext_vector_type(4)));
typedef unsigned u32x4 __attribute__((ext_vector_type(4)));
constexpr int BM = 256, BK = 64, HALF = 128, HTB = HALF * BK * 2  , STAGE_BYTES = 8 * HTB, NXCD = 8, WGM = 8;

__host__ __device__ __forceinline__ int lds_byte(int r, int c) { const int st = (r >> 4) * 2 + (c >> 5), rr = r & 15, cc = c & 31, ob = rr * 64 + cc * 2; return st * 1024 + (ob ^ (((ob >> 9) & 1) << 5)); }
__host__ __device__ __forceinline__ void stage_rc(int b, int& R, int& C) { const int st = b / 1024, sb = b % 1024, swz = sb ^ (((sb >> 9) & 1) << 5); R = (st >> 1) * 16 + swz / 64; C = (st & 1) * 32 + (swz % 64) / 2; }
__host__ __device__ __forceinline__ int perm32(int rho) { const int n = rho >> 4, i = rho & 15; return 8 * (i >> 2) + 4 * n + (i & 3); }

struct Unit { int pm, pn; };
struct Gemm { const bf16_t* A; const bf16_t* Bt; int M, N, K; };

struct StaticOrder {
    int nM, nN, nwg, G, c;
    __host__ __device__ void init(int M, int N, int G_, int c_) { nM = M / BM; nN = N / BM; nwg = nM * nN; G = G_; c = c_; }
    __host__ __device__ bool next(int i, Unit& u) const {
        const long L = (long)i * G + c; if (L >= nwg) return false;
        int wgid = (int)L; { const int q = nwg / NXCD, r = nwg % NXCD, xcd = wgid % NXCD, off = wgid / NXCD; wgid = (xcd < r ? xcd * (q + 1) : r * (q + 1) + (xcd - r) * q) + off; }
        const int nig = WGM * nN, gid = wgid / nig, fm = gid * WGM, gsz = (nM - fm) < WGM ? (nM - fm) : WGM;
        u.pm = fm + ((wgid % nig) % gsz); u.pn = (wgid % nig) / gsz; return true;
    }
    __device__ __forceinline__ void a_ready(const Unit&) const {}
    __device__ __forceinline__ void done(const Unit&) const {}
};
__device__ __forceinline__ unsigned cvt_pk_bf16(float lo, float hi) { unsigned r; asm volatile("v_cvt_pk_bf16_f32 %0, %1, %2" : "=v"(r) : "v"(lo), "v"(hi)); return r; }
typedef float f32x2 __attribute__((ext_vector_type(2)));
__device__ __forceinline__ f32x2 gelu_pk(f32x2 v) {
    const f32x2 av = __builtin_elementwise_abs(v), d = av * 0.2316418882f + 1.0f;
    f32x2 t; t.x = __builtin_amdgcn_rcpf(d.x); t.y = __builtin_amdgcn_rcpf(d.y);
    f32x2 q = t * 0.5307027145f + (-0.7265760135f); q = q * t + 0.7107068705f; q = q * t + (-0.142248368f); q = q * t + 0.127414796f; q = q * t;
    const f32x2 s = (v * v) * (-0.72134752044f);
    f32x2 e; e.x = __builtin_amdgcn_exp2f(s.x); e.y = __builtin_amdgcn_exp2f(s.y);
    const f32x2 m = v * (q * e), r = v - m;
    f32x2 o; o.x = v.x < 0.f ? m.x : r.x; o.y = v.y < 0.f ? m.y : r.y; return o;
}
typedef unsigned u32x2 __attribute__((ext_vector_type(2)));
typedef __bf16 bf16x2_t __attribute__((ext_vector_type(2)));
__device__ __forceinline__ unsigned pk2(float lo, float hi) { f32x2 v = {lo, hi}; bf16x2_t b = __builtin_convertvector(v, bf16x2_t); return __builtin_bit_cast(unsigned, b); }
__device__ __forceinline__ float fast_sigmoid(float x) { return __builtin_amdgcn_rcpf(1.0f + __builtin_amdgcn_exp2f(-1.4426950408889634f * x)); }

__device__ __forceinline__ float row_rs(const float* ss, int r, int fq) { const f32x4 a = *(const f32x4*)(ss + (size_t)r * 16 + 4 * fq);
    float t = (a[0] + a[1]) + (a[2] + a[3]); t += __shfl_xor(t, 16); t += __shfl_xor(t, 32); return __builtin_amdgcn_rsqf(t * (1.0f / 1024.0f) + 1e-6f); }
struct EpiSwiglu {
    static constexpr bool PERM = true, AFTER_DRAIN = false, WIDE = false;
    bf16_t* H; int ldh; const float* ss;
    __device__ __forceinline__ void operator()(const f32x4 (&acc)[2][2][4][2], const Unit& u, int wr, int wc, int fr, int fq) const {
        const int row0 = u.pm * BM + wr * 64 + fr; const int col0 = u.pn * HALF + wc * 32 + 8 * fq;
        float rsv[2][4];
#pragma unroll
        for (int ai = 0; ai < 2; ++ai)
#pragma unroll
            for (int m = 0; m < 4; ++m) rsv[ai][m] = row_rs(ss, row0 + ai * HALF + m * 16, fq);
#pragma unroll
        for (int ai = 0; ai < 2; ++ai)
#pragma unroll
            for (int m = 0; m < 4; ++m) { const int r = row0 + ai * HALF + m * 16; const float rs = rsv[ai][m], rs2 = rs * rs, nl = -1.4426950408889634f * rs;
                unsigned w[4];
#pragma unroll
                for (int n = 0; n < 2; ++n) { const f32x4 g = acc[ai][0][m][n], gu = g * acc[ai][1][m][n] * rs2, ge = g * nl; float hv[4];
#pragma unroll
                    for (int e = 0; e < 4; ++e) hv[e] = gu[e] * __builtin_amdgcn_rcpf(1.0f + __builtin_amdgcn_exp2f(ge[e]));
                    w[2 * n] = pk2(hv[0], hv[1]); w[2 * n + 1] = pk2(hv[2], hv[3]); }
                *(u32x4*)(H + (size_t)r * ldh + col0) = (u32x4){w[0], w[1], w[2], w[3]}; }
    }
};
struct EpiResid {
    static constexpr bool PERM = true, AFTER_DRAIN = false, WIDE = true;
    const float* xin;
    bf16_t* hi; const bf16_t* lo_in; bf16_t* lo_out;
    float* fout;
    float* ssn; const float* bias; float scale;
    __device__ __forceinline__ void operator()(const f32x4 (&acc)[2][2][4][2], const Unit& u, int wr, int wc, int fr, int fq) const {
        const int row0 = u.pm * BM + wr * 64 + fr; const int col0 = u.pn * BM + wc * 64 + 8 * fq;
        f32x4 bv[2][2];
#pragma unroll
        for (int bj = 0; bj < 2; ++bj)
#pragma unroll
            for (int n = 0; n < 2; ++n) bv[bj][n] = bias ? *(const f32x4*)(bias + col0 + bj * 32 + 4 * n) : (f32x4){0.f, 0.f, 0.f, 0.f};
#pragma unroll
        for (int q = 0; q < 4; ++q) { const int ai = q >> 1, mh = (q & 1) * 2;
            u32x4 rh[2][2], rl[2][2];
#pragma unroll
            for (int m = 0; m < 2; ++m)
#pragma unroll
                for (int bj = 0; bj < 2; ++bj) { const size_t c = (size_t)(row0 + ai * HALF + (mh + m) * 16) * 1024 + col0 + bj * 32;
                    if (xin) { rh[m][bj] = __builtin_bit_cast(u32x4, *(const f32x4*)(xin + c)); rl[m][bj] = __builtin_bit_cast(u32x4, *(const f32x4*)(xin + c + 4)); }
                    else { rh[m][bj] = *(const u32x4*)(hi + c); rl[m][bj] = *(const u32x4*)(lo_in + c); } }
#pragma unroll
            for (int m = 0; m < 2; ++m) { const int r = row0 + ai * HALF + (mh + m) * 16; float s = 0.f;
#pragma unroll
                for (int bj = 0; bj < 2; ++bj) { const size_t c = (size_t)r * 1024 + col0 + bj * 32; const u32x4 h = rh[m][bj], l = rl[m][bj]; f32x4 b0, b1;
                    if (xin) { b0 = __builtin_bit_cast(f32x4, h); b1 = __builtin_bit_cast(f32x4, l); }
                    else { b0 = (f32x4){__uint_as_float(h.x << 16) + __uint_as_float(l.x << 16), __uint_as_float(h.x & 0xffff0000u) + __uint_as_float(l.x & 0xffff0000u),
                                        __uint_as_float(h.y << 16) + __uint_as_float(l.y << 16), __uint_as_float(h.y & 0xffff0000u) + __uint_as_float(l.y & 0xffff0000u)};
                           b1 = (f32x4){__uint_as_float(h.z << 16) + __uint_as_float(l.z << 16), __uint_as_float(h.z & 0xffff0000u) + __uint_as_float(l.z & 0xffff0000u),
                                        __uint_as_float(h.w << 16) + __uint_as_float(l.w << 16), __uint_as_float(h.w & 0xffff0000u) + __uint_as_float(l.w & 0xffff0000u)}; }
                    const f32x4 v0 = b0 + acc[ai][bj][mh + m][0] * scale + bv[bj][0], v1 = b1 + acc[ai][bj][mh + m][1] * scale + bv[bj][1];
                    if (fout) { *(f32x4*)(fout + c) = v0; *(f32x4*)(fout + c + 4) = v1; }
                    else { const unsigned h0 = pk2(v0[0], v0[1]), h1 = pk2(v0[2], v0[3]), h2 = pk2(v1[0], v1[1]), h3 = pk2(v1[2], v1[3]);
                        const unsigned l0 = pk2(v0[0] - __uint_as_float(h0 << 16), v0[1] - __uint_as_float(h0 & 0xffff0000u)), l1 = pk2(v0[2] - __uint_as_float(h1 << 16), v0[3] - __uint_as_float(h1 & 0xffff0000u)),
                                       l2 = pk2(v1[0] - __uint_as_float(h2 << 16), v1[1] - __uint_as_float(h2 & 0xffff0000u)), l3 = pk2(v1[2] - __uint_as_float(h3 << 16), v1[3] - __uint_as_float(h3 & 0xffff0000u));
                        *(u32x4*)(hi + c) = (u32x4){h0, h1, h2, h3}; *(u32x4*)(lo_out + c) = (u32x4){l0, l1, l2, l3}; }
                    s += ((v0[0] * v0[0] + v0[1] * v0[1]) + (v0[2] * v0[2] + v0[3] * v0[3])) + ((v1[0] * v1[0] + v1[1] * v1[1]) + (v1[2] * v1[2] + v1[3] * v1[3])); }
                s += __shfl_xor(s, 16); s += __shfl_xor(s, 32);
                if (fq == 0) ssn[(size_t)r * 16 + u.pn * 4 + wc] = s; }
        }
    }
};
struct EpiBf {
    static constexpr bool PERM = true, AFTER_DRAIN = false, WIDE = true;
    bf16_t* O; int ldc; const float* ss; const float* bias; int mode;
    const float* tab; const float* qn; const float* kn;
    __device__ __forceinline__ void operator()(const f32x4 (&acc)[2][2][4][2], const Unit& u, int wr, int wc, int fr, int fq) const {
        const int row0 = u.pm * BM + wr * 64 + fr; const int col0 = u.pn * BM + wc * 64 + 8 * fq;
        const int seg = (mode == 1) ? (u.pn >> 1) : 3;
        const bool qk = (mode == 2) && (u.pn < 5); const float* gn = (u.pn < 4) ? qn : kn; const float qsc = (u.pn < 4) ? 0.125f : 1.0f;
        f32x4 bv[2][2];
#pragma unroll
        for (int bj = 0; bj < 2; ++bj)
#pragma unroll
            for (int n = 0; n < 2; ++n) bv[bj][n] = bias ? *(const f32x4*)(bias + col0 + bj * 32 + 4 * n) : (f32x4){0.f, 0.f, 0.f, 0.f};
        float rsv[2][4];
#pragma unroll
        for (int ai = 0; ai < 2; ++ai)
#pragma unroll
            for (int m = 0; m < 4; ++m) rsv[ai][m] = ss ? row_rs(ss, row0 + ai * HALF + m * 16, fq) : 1.0f;
#pragma unroll
        for (int ai = 0; ai < 2; ++ai)
#pragma unroll
            for (int m = 0; m < 4; ++m) { const int r = row0 + ai * HALF + m * 16; const float rs = rsv[ai][m];
                bf16_t* rowp = O + (size_t)r * ldc + col0;
                if (qk) {
                    f32x4 x1a = acc[ai][0][m][0] * rs + bv[0][0], x1b = acc[ai][0][m][1] * rs + bv[0][1], x2a = acc[ai][1][m][0] * rs + bv[1][0], x2b = acc[ai][1][m][1] * rs + bv[1][1];
                    float sq = 0.f;
#pragma unroll
                    for (int e = 0; e < 4; ++e) sq += (x1a[e] * x1a[e] + x1b[e] * x1b[e]) + (x2a[e] * x2a[e] + x2b[e] * x2b[e]);
                    sq += __shfl_xor(sq, 16); sq += __shfl_xor(sq, 32);
                    const float rms = qsc * __builtin_amdgcn_rsqf(sq * (1.0f / 64.0f) + 1e-6f);
                    const float* tr = tab + (size_t)r * 64 + 8 * fq;
                    const f32x4 ca = *(const f32x4*)(tr), cb = *(const f32x4*)(tr + 4), sa = *(const f32x4*)(tr + 32), sb = *(const f32x4*)(tr + 36);
                    const f32x4 g1a = *(const f32x4*)(gn + 8 * fq), g1b = *(const f32x4*)(gn + 8 * fq + 4), g2a = *(const f32x4*)(gn + 32 + 8 * fq), g2b = *(const f32x4*)(gn + 36 + 8 * fq);
                    x1a = x1a * rms * g1a; x1b = x1b * rms * g1b; x2a = x2a * rms * g2a; x2b = x2b * rms * g2b;
                    const f32x4 o1a = x1a * ca - x2a * sa, o1b = x1b * cb - x2b * sb, o2a = x2a * ca + x1a * sa, o2b = x2b * cb + x1b * sb;
                    *(u32x4*)(rowp) = (u32x4){pk2(o1a[0], o1a[1]), pk2(o1a[2], o1a[3]), pk2(o1b[0], o1b[1]), pk2(o1b[2], o1b[3])};
                    *(u32x4*)(rowp + 32) = (u32x4){pk2(o2a[0], o2a[1]), pk2(o2a[2], o2a[3]), pk2(o2b[0], o2b[1]), pk2(o2b[2], o2b[3])};
                } else {
#pragma unroll
                for (int bj = 0; bj < 2; ++bj) { f32x4 v0 = acc[ai][bj][m][0] * rs + bv[bj][0], v1 = acc[ai][bj][m][1] * rs + bv[bj][1];
                    if (seg < 2) { const float sc = (seg == 0) ? 0.60653065971263342f : 1.0f;
#pragma unroll
                        for (int e = 0; e < 4; ++e) { v0[e] = sc * fast_sigmoid(v0[e]); v1[e] = sc * fast_sigmoid(v1[e]); } }
                    *(u32x4*)(rowp + bj * 32) = (u32x4){pk2(v0[0], v0[1]), pk2(v0[2], v0[3]), pk2(v1[0], v1[1]), pk2(v1[2], v1[3])}; } } }
    }
};

template <class Epi, class Sched, bool ALIGN_EPI = false, bool SP2 = false>
__device__ __forceinline__ void gemm_phase(PG8_LAS unsigned char* lds, const Gemm g, const Sched& S, const Epi& E, const int tid_) {
    const int tid = tid_, wid = __builtin_amdgcn_readfirstlane(tid >> 6), lane = tid & 63, wr = wid >> 2, wc = wid & 3, fr = lane & 15, fq = lane >> 4;
    const int K = g.K, nt = K / BK;
    unsigned voffA[2], voffB[2];
#pragma unroll
    for (int i = 0; i < 2; ++i) { int R, C; stage_rc(tid * 16 + i * 8192, R, C); const int Rb = Epi::WIDE ? (64 * (R >> 5) + (Epi::PERM ? perm32(R & 31) : (R & 31))) : (Epi::PERM ? ((R & ~31) + perm32(R & 31)) : R);
        voffA[i] = (unsigned)(R * K + C) * 2u; voffB[i] = (unsigned)(Rb * K + C) * 2u; }
    const size_t kstep = (size_t)(BK * 2);
    const size_t hstep = (size_t)HALF * K * 2;
    const size_t tstep = 2 * hstep;
    const size_t hstepB = Epi::WIDE ? (size_t)32 * K * 2 : hstep;
    const unsigned ldsw = (unsigned)wid * 1024u;
    const int aoff = lds_byte(wr * 64 + fr, fq * 8), boff = lds_byte(wc * 32 + fr, fq * 8);
#define PG8_SA(b, h) (((b) * 2 + (h)) * HTB)
#define PG8_SB(b, h) ((4 + (b) * 2 + (h)) * HTB)
#define PG8_STAGE(bufoff, gbase, voff) do { _Pragma("unroll") for (int _i = 0; _i < 2; ++_i) \
        __builtin_amdgcn_global_load_lds((const unsigned*)((const char*)(gbase) + (voff)[_i]), (PG8_LAS unsigned*)(lds + (bufoff) + ldsw + _i * 8192), 16, 0, 0); } while (0)
#define PG8_LDA(dst, b, h) do { _Pragma("unroll") for (int m = 0; m < 4; ++m) _Pragma("unroll") for (int k = 0; k < 2; ++k) dst[m][k] = *(const PG8_LAS bf16x8*)(lds + PG8_SA(b, h) + aoff + m * 2048 + k * 1024); } while (0)
#define PG8_LDB(dst, b, h) do { _Pragma("unroll") for (int n = 0; n < 2; ++n) _Pragma("unroll") for (int k = 0; k < 2; ++k) dst[n][k] = *(const PG8_LAS bf16x8*)(lds + PG8_SB(b, h) + boff + n * 2048 + k * 1024); } while (0)
#define PG8_MMA(ai, bj, At, Bt) do { __builtin_amdgcn_s_setprio(1); _Pragma("unroll") for (int m = 0; m < 4; ++m) _Pragma("unroll") for (int n = 0; n < 2; ++n) _Pragma("unroll") for (int k = 0; k < 2; ++k) \
        acc[ai][bj][m][n] = __builtin_amdgcn_mfma_f32_16x16x32_bf16(Bt[n][k], At[m][k], acc[ai][bj][m][n], 0, 0, 0); __builtin_amdgcn_s_setprio(0); } while (0)
#define PG8_WAIT_V(n) asm volatile("s_waitcnt vmcnt(" #n ")" ::: "memory")
#define PG8_WAIT_L(n) asm volatile("s_waitcnt lgkmcnt(" #n ")" ::: "memory")
#define PG8_BAR __builtin_amdgcn_s_barrier()
#define PG8_SCHED __builtin_amdgcn_sched_barrier(0)
    Unit cur, nxt; int ui = 0;
    if (!S.next(0, cur)) return;
    f32x4 acc[2][2][4][2];
#pragma unroll
    for (int a = 0; a < 2; ++a)
#pragma unroll
        for (int b = 0; b < 2; ++b)
#pragma unroll
            for (int m = 0; m < 4; ++m)
#pragma unroll
                for (int n = 0; n < 2; ++n) acc[a][b][m][n] = (f32x4){0.f, 0.f, 0.f, 0.f};
    bf16x8 At[4][2], B0[2][2], B1[2][2];
    const char* cA = (const char*)g.A + (size_t)cur.pm * tstep; const char* cB = (const char*)g.Bt + (size_t)cur.pn * tstep;
    S.a_ready(cur);
    if constexpr (SP2) {
        PG8_STAGE(PG8_SB(0, 0), cB, voffB); PG8_STAGE(PG8_SB(0, 1), cB + hstepB, voffB); PG8_STAGE(PG8_SA(0, 0), cA, voffA); PG8_STAGE(PG8_SA(0, 1), cA + hstep, voffA);
        if (wr == 1) PG8_BAR;
        PG8_WAIT_V(2); PG8_BAR;
        PG8_STAGE(PG8_SB(1, 0), cB + kstep, voffB); PG8_STAGE(PG8_SA(1, 0), cA + kstep, voffA); PG8_STAGE(PG8_SB(1, 1), cB + hstepB + kstep, voffB);
        PG8_WAIT_V(6); PG8_BAR;
    } else {
        PG8_STAGE(PG8_SB(0, 0), cB, voffB); PG8_STAGE(PG8_SA(0, 0), cA, voffA); PG8_STAGE(PG8_SB(0, 1), cB + hstepB, voffB); PG8_STAGE(PG8_SA(0, 1), cA + hstep, voffA);
        if (wr == 1) PG8_BAR;
        PG8_WAIT_V(4); PG8_BAR;
        PG8_STAGE(PG8_SB(1, 0), cB + kstep, voffB); PG8_STAGE(PG8_SA(1, 0), cA + kstep, voffA); PG8_STAGE(PG8_SB(1, 1), cB + hstepB + kstep, voffB);
        PG8_WAIT_V(6); PG8_BAR;
    }
    for (;;) {
        const bool has_next = S.next(ui + 1, nxt);
        const char* nA = has_next ? (const char*)g.A + (size_t)nxt.pm * tstep : cA; const char* nB = has_next ? (const char*)g.Bt + (size_t)nxt.pn * tstep : cB;
        for (int t = 0; t < nt; t += 2) {
            const bool last = (t == nt - 2);
            const char* a1 = cA + (size_t)(t + 1) * kstep;
            const char* a2 = last ? nA : cA + (size_t)(t + 2) * kstep; const char* b2 = last ? nB : cB + (size_t)(t + 2) * kstep;
            const char* a3 = a2 + kstep; const char* b3 = b2 + kstep;
            if (last && has_next) S.a_ready(nxt);
            if constexpr (SP2) {
            PG8_LDB(B0, 0, 0); PG8_LDB(B1, 0, 1); PG8_SCHED; PG8_LDA(At, 0, 0); PG8_STAGE(PG8_SA(1, 1), a1 + hstep, voffA);
            PG8_WAIT_V(8); PG8_WAIT_L(0); PG8_BAR; PG8_MMA(0, 0, At, B0); PG8_MMA(0, 1, At, B1); PG8_BAR; PG8_SCHED;
            PG8_LDA(At, 0, 1); PG8_STAGE(PG8_SB(0, 0), b2, voffB); PG8_STAGE(PG8_SB(0, 1), b2 + hstepB, voffB); PG8_STAGE(PG8_SA(0, 0), a2, voffA);
            PG8_WAIT_V(8); PG8_WAIT_L(0); PG8_BAR; PG8_MMA(1, 0, At, B0); PG8_MMA(1, 1, At, B1); PG8_BAR; PG8_SCHED;
            PG8_LDB(B0, 1, 0); PG8_LDB(B1, 1, 1); PG8_SCHED; PG8_LDA(At, 1, 0); PG8_STAGE(PG8_SA(0, 1), a2 + hstep, voffA);
            PG8_WAIT_V(8); PG8_WAIT_L(0); PG8_BAR; PG8_MMA(0, 0, At, B0); PG8_MMA(0, 1, At, B1); PG8_BAR; PG8_SCHED;
            PG8_LDA(At, 1, 1); PG8_STAGE(PG8_SB(1, 0), b3, voffB); PG8_STAGE(PG8_SB(1, 1), b3 + hstepB, voffB); PG8_STAGE(PG8_SA(1, 0), a3, voffA);
            PG8_WAIT_V(8); PG8_WAIT_L(0); PG8_BAR; PG8_MMA(1, 0, At, B0); PG8_MMA(1, 1, At, B1); PG8_BAR; PG8_SCHED;
            } else {
            PG8_LDB(B0, 0, 0); PG8_SCHED; PG8_LDA(At, 0, 0); PG8_STAGE(PG8_SA(1, 1), a1 + hstep, voffA);
            PG8_WAIT_L(8); PG8_BAR; PG8_WAIT_L(0); PG8_MMA(0, 0, At, B0); PG8_BAR; PG8_SCHED;
            PG8_LDB(B1, 0, 1); PG8_STAGE(PG8_SB(0, 0), b2, voffB);
            PG8_BAR; PG8_WAIT_L(0); PG8_MMA(0, 1, At, B1); PG8_BAR;
            PG8_LDA(At, 0, 1); PG8_STAGE(PG8_SA(0, 0), a2, voffA);
            PG8_BAR; PG8_WAIT_L(0); PG8_MMA(1, 0, At, B0); PG8_BAR; PG8_SCHED;
            PG8_STAGE(PG8_SB(0, 1), b2 + hstepB, voffB);
            PG8_WAIT_V(6); PG8_BAR; PG8_MMA(1, 1, At, B1); PG8_BAR;
            PG8_LDB(B0, 1, 0); PG8_SCHED; PG8_LDA(At, 1, 0); PG8_STAGE(PG8_SA(0, 1), a2 + hstep, voffA);
            PG8_WAIT_L(8); PG8_BAR; PG8_WAIT_L(0); PG8_MMA(0, 0, At, B0); PG8_BAR; PG8_SCHED;
            PG8_LDB(B1, 1, 1); PG8_STAGE(PG8_SB(1, 0), b3, voffB);
            PG8_BAR; PG8_WAIT_L(0); PG8_MMA(0, 1, At, B1); PG8_BAR;
            PG8_LDA(At, 1, 1); PG8_STAGE(PG8_SA(1, 0), a3, voffA);
            PG8_BAR; PG8_WAIT_L(0); PG8_MMA(1, 0, At, B0); PG8_BAR; PG8_SCHED;
            PG8_STAGE(PG8_SB(1, 1), b3 + hstepB, voffB);
            PG8_WAIT_V(6); PG8_BAR; PG8_MMA(1, 1, At, B1); PG8_BAR;
            }
        }
        if constexpr (ALIGN_EPI) { if (wr == 0) PG8_BAR; }
        if constexpr (!Epi::AFTER_DRAIN) { E(acc, cur, wr, wc, fr, fq); S.done(cur); }
        if (!has_next) break;
#pragma unroll
        for (int a = 0; a < 2; ++a)
#pragma unroll
            for (int b = 0; b < 2; ++b)
#pragma unroll
                for (int m = 0; m < 4; ++m)
#pragma unroll
                    for (int n = 0; n < 2; ++n) acc[a][b][m][n] = (f32x4){0.f, 0.f, 0.f, 0.f};
        cur = nxt; cA = nA; cB = nB; ++ui;
        if constexpr (ALIGN_EPI) { if (wr == 1) PG8_BAR; }
    }
    PG8_WAIT_V(0);
    if constexpr (!ALIGN_EPI) { if (wr == 0) PG8_BAR; }
    PG8_BAR;
    if constexpr (Epi::AFTER_DRAIN) { E.fused(acc, cur, wr, wc, fr, fq, lds, wid, lane); S.done(cur); }
#undef PG8_SA
#undef PG8_SB
#undef PG8_STAGE
#undef PG8_LDA
#undef PG8_LDB
#undef PG8_MMA
#undef PG8_WAIT_V
#undef PG8_WAIT_L
#undef PG8_BAR
#undef PG8_SCHED
}
}
namespace cg = cooperative_groups;
#define LAS __attribute__((address_space(3)))
using pg8::bf16_t; using pg8::bf16x8; using pg8::f32x4; using pg8::u32x4; using pg8::f32x2; using pg8::u32x2; using pg8::pk2; using pg8::fast_sigmoid;

constexpr int M = 65536, T = 4096, D = 1024, FF = 2816, ZC = 2816, QKVC = 1536, LOC = 1536, LAC = 256;
constexpr size_t MiB = (size_t)1 << 20;
constexpr size_t WS_SS = 1 * MiB;
constexpr size_t WS_LB = 5 * MiB;
constexpr size_t WS_RKB = 6 * MiB;
constexpr size_t WS_ROPE = 8 * MiB;
constexpr size_t WS_W = 24 * MiB;
constexpr size_t FFN_STRIDE = 16 * MiB + MiB / 2, WD_OFF = 11 * MiB;
constexpr size_t WS_WMIX = WS_W + 8 * FFN_STRIDE;
constexpr size_t EVEN_STRIDE = 8 * MiB + MiB / 4, WOUT_OFF = 5 * MiB + MiB / 2, WLORA_OFF = 7 * MiB + MiB / 2;
constexpr size_t WS_WODD = WS_WMIX + 2 * EVEN_STRIDE, ODD_STRIDE = 5 * MiB, WO_OFF = 3 * MiB;
constexpr size_t WS_XB = 184 * MiB;
constexpr size_t OUT_XL = 0, OUT_LA = 128 * MiB, OUT_YRAW = 160 * MiB;
constexpr size_t WS_HZ = 312 * MiB;
constexpr size_t WS_Y = 664 * MiB;
constexpr size_t WS_LO = 792 * MiB;
constexpr size_t WS_END = 984 * MiB;
static_assert(WS_WODD + 2 * ODD_STRIDE <= WS_XB, "ws map");
constexpr int LDS_BYTES = 147456;

struct Args {
    const float* x; const int* pos;
    const float *f1n, *f1g, *f1u, *f1d, *mixn, *f2n, *f2g, *f2u, *f2d;
    const float *win, *mu, *w0, *wdec, *a0, *waaa, *wgate, *kk, *ka, *rk, *gng, *gnb, *lng, *lnb, *wsp, *bsp, *wout;
    const float *wqkv, *bqkv, *qn, *kn, *sinks, *wo, *bo;
    float* out; unsigned char* ws;
    float inv_freq[32];
    int ph_lo, ph_hi;
};

#define KAS __attribute__((address_space(4)))
__device__ __forceinline__ const KAS Args* kargs(int off) { return (const KAS Args*)((const KAS char*)__builtin_amdgcn_kernarg_segment_ptr() + off); }
__device__ __forceinline__ float bf2f(unsigned short h) { return __uint_as_float((unsigned)h << 16); }
__device__ __forceinline__ float bflo(unsigned w) { return __uint_as_float(w << 16); }
__device__ __forceinline__ float bfhi(unsigned w) { return __uint_as_float(w & 0xffff0000u); }
__device__ __forceinline__ void unpack8(const u32x4 w, float (&f)[8]) { f[0] = bflo(w.x); f[1] = bfhi(w.x); f[2] = bflo(w.y); f[3] = bfhi(w.y); f[4] = bflo(w.z); f[5] = bfhi(w.z); f[6] = bflo(w.w); f[7] = bfhi(w.w); }
__device__ __forceinline__ u32x4 pack8(const float (&f)[8]) { return (u32x4){pk2(f[0], f[1]), pk2(f[2], f[3]), pk2(f[4], f[5]), pk2(f[6], f[7])}; }
__device__ __forceinline__ float wave_sum(float v) {
#pragma unroll
    for (int o = 1; o < 64; o <<= 1) v += __shfl_xor(v, o);
    return v;
}
template <int CTRL> __device__ __forceinline__ float dpp_mov(float x) { return __int_as_float(__builtin_amdgcn_update_dpp(0, __float_as_int(x), CTRL, 0xF, 0xF, false)); }
__device__ __forceinline__ float row16_sum(float x) { x += dpp_mov<0xB1>(x); x += dpp_mov<0x4E>(x); x += dpp_mov<0x124>(x); x += dpp_mov<0x128>(x); return x; }
__device__ __forceinline__ float row16_max(float x) { x = fmaxf(x, dpp_mov<0xB1>(x)); x = fmaxf(x, dpp_mov<0x4E>(x)); x = fmaxf(x, dpp_mov<0x124>(x)); x = fmaxf(x, dpp_mov<0x128>(x)); return x; }
__device__ __forceinline__ float wave_sum_dpp(float x) { x = row16_sum(x);
    return __int_as_float(__builtin_amdgcn_readlane(__float_as_int(x), 0)) + __int_as_float(__builtin_amdgcn_readlane(__float_as_int(x), 16)) + (__int_as_float(__builtin_amdgcn_readlane(__float_as_int(x), 32)) + __int_as_float(__builtin_amdgcn_readlane(__float_as_int(x), 48))); }
#define LDS_FENCE() asm volatile("s_waitcnt lgkmcnt(0)" ::: "memory")

__device__ __forceinline__ void tr_item(const float* W, int N, const float* gk, bf16_t* WT, int ldk, int drow, int k0, int n0, LAS float* scr, int lane) {
    f32x4 v[8];
#pragma unroll
    for (int i = 0; i < 8; ++i) { const int kk = 8 * i + (lane >> 3); v[i] = *(const f32x4*)(W + (size_t)(k0 + kk) * N + n0 + 4 * (lane & 7)); }
#pragma unroll
    for (int i = 0; i < 8; ++i) { const int kk = 8 * i + (lane >> 3); const float g = gk ? gk[k0 + kk] : 1.0f; *(LAS f32x4*)(scr + kk * 36 + 4 * (lane & 7)) = v[i] * g; }
    LDS_FENCE();
    const int c = lane & 7;
#pragma unroll
    for (int j = 0; j < 4; ++j) { const int n = (lane >> 3) + 8 * j; const LAS float* s = scr + (8 * c) * 36 + n;
        u32x4 o; o.x = pk2(s[0 * 36], s[1 * 36]); o.y = pk2(s[2 * 36], s[3 * 36]); o.z = pk2(s[4 * 36], s[5 * 36]); o.w = pk2(s[6 * 36], s[7 * 36]);
        *(u32x4*)(WT + (size_t)(drow + n) * ldk + k0 + 8 * c) = o; }
    LDS_FENCE();
}
__device__ __forceinline__ void prologue(const KAS Args& a, LAS unsigned char* lds, const int tid_, const int bid, const int nblk) {
    unsigned char* ws = a.ws;
    const int tid = tid_, lane = tid & 63, wave = tid >> 6;
    LAS float* scr = (LAS float*)(lds + wave * 16384);
    const int gw = bid * 8 + wave, NGW = nblk * 8;
    const int gt = bid * 512 + tid, NGT = nblk * 512;
    constexpr int I_GU = 16 * 88, I_DN = 44 * 32, I_FFN = 2 * I_GU + I_DN, N_FFN = 8 * I_FFN;
    constexpr int I_IN = 16 * 88, I_OUT = 16 * 32, I_QKV = 16 * 48, I_O = 16 * 32, I_MIX = I_IN + I_OUT + I_QKV + I_O;
    for (int it = gw; it < N_FFN + 2 * I_MIX; it += NGW) {
        if (it < N_FFN) {
            const int f = it / I_FFN, r = it % I_FFN, l = f >> 1, second = f & 1;
            bf16_t* wgu = (bf16_t*)(ws + WS_W + (size_t)f * FFN_STRIDE); bf16_t* wd = (bf16_t*)(ws + WS_W + (size_t)f * FFN_STRIDE + WD_OFF);
            if (r < 2 * I_GU) { const int part = r / I_GU, loc = r % I_GU, kb = loc / 88, nb = loc % 88, n0 = 32 * nb;
                const float* src = (part == 0 ? (second ? a.f2g : a.f1g) : (second ? a.f2u : a.f1u)) + (size_t)l * D * FF;
                const float* gk = (second ? a.f2n : a.f1n) + l * D;
                tr_item(src, FF, gk, wgu, D, (n0 >> 7) * 256 + (n0 & 127) + part * 128, 64 * kb, n0, scr, lane);
            } else { const int loc = r - 2 * I_GU, kb = loc / 32, nb = loc % 32;
                const float* src = (second ? a.f2d : a.f1d) + (size_t)l * FF * D;
                tr_item(src, D, nullptr, wd, FF, 32 * nb, 64 * kb, 32 * nb, scr, lane); }
        } else {
            const int r = it - N_FFN, i = r / I_MIX, q = r % I_MIX;
            if (q < I_IN) { const int kb = q / 88, nb = q % 88;
                tr_item(a.win + (size_t)i * D * ZC, ZC, a.mixn + (2 * i) * D, (bf16_t*)(ws + WS_WMIX + i * EVEN_STRIDE), D, 32 * nb, 64 * kb, 32 * nb, scr, lane);
            } else if (q < I_IN + I_OUT) { const int loc = q - I_IN, kb = loc / 32, nb = loc % 32;
                tr_item(a.wout + (size_t)i * D * D, D, nullptr, (bf16_t*)(ws + WS_WMIX + i * EVEN_STRIDE + WOUT_OFF), D, 32 * nb, 64 * kb, 32 * nb, scr, lane);
            } else if (q < I_IN + I_OUT + I_QKV) { const int loc = q - I_IN - I_OUT, kb = loc / 48, nb = loc % 48;
                tr_item(a.wqkv + (size_t)i * D * QKVC, QKVC, a.mixn + (2 * i + 1) * D, (bf16_t*)(ws + WS_WODD + i * ODD_STRIDE), D, 32 * nb, 64 * kb, 32 * nb, scr, lane);
            } else { const int loc = q - I_IN - I_OUT - I_QKV, kb = loc / 32, nb = loc % 32;
                tr_item(a.wo + (size_t)i * D * D, D, nullptr, (bf16_t*)(ws + WS_WODD + i * ODD_STRIDE + WO_OFF), D, 32 * nb, 64 * kb, 32 * nb, scr, lane); }
        }
    }
    for (int idx = gt; idx < 2 * LOC * LAC; idx += NGT) {
        const int i = idx / (LOC * LAC), e = idx % (LOC * LAC), n = e / LAC, k = e % LAC, seg = n >> 9, nn = n & 511;
        float v = 0.f;
        if (seg == 0) { if (k < 64) v = a.wdec[(size_t)i * 64 * 512 + k * 512 + nn]; }
        else if (seg == 1) { if (k >= 64 && k < 128) v = a.waaa[(size_t)i * 64 * 512 + (k - 64) * 512 + nn]; }
        else { if (k >= 128) v = a.wgate[(size_t)i * 128 * 512 + (k - 128) * 512 + nn]; }
        ((bf16_t*)(ws + WS_WMIX + i * EVEN_STRIDE + WLORA_OFF))[e] = (bf16_t)(pk2(v, 0.f) & 0xffffu);
    }
    for (int idx = gt; idx < 2 * LOC; idx += NGT) { const int i = idx / LOC, n = idx % LOC;
        ((float*)(ws + WS_LB))[idx] = (n < 512) ? a.w0[i * 512 + n] : (n < 1024 ? a.a0[i * 512 + n - 512] : 0.f); }
    { bf16_t* xb = (bf16_t*)(ws + WS_XB); bf16_t* xl = (bf16_t*)((unsigned char*)a.out + OUT_XL); float* ss0 = (float*)(ws + WS_SS);
      for (int mb = gw; mb < M; mb += 2 * NGW) { f32x4 v[2][4]; const int m1 = (mb + NGW < M) ? mb + NGW : mb;
#pragma unroll
          for (int j = 0; j < 4; ++j) { v[0][j] = ((const f32x4*)(a.x + (size_t)mb * D) + lane)[64 * j]; v[1][j] = ((const f32x4*)(a.x + (size_t)m1 * D) + lane)[64 * j]; }
#pragma unroll
          for (int k = 0; k < 2; ++k) { const int m = k ? m1 : mb; if (k && m1 == mb) break; float s = 0.f;
#pragma unroll
              for (int j = 0; j < 4; ++j) { const f32x4 w = v[k][j]; s += (w[0] * w[0] + w[1] * w[1]) + (w[2] * w[2] + w[3] * w[3]);
                  const unsigned h01 = pk2(w[0], w[1]), h23 = pk2(w[2], w[3]);
                  const unsigned l01 = pk2(w[0] - bflo(h01), w[1] - bfhi(h01)), l23 = pk2(w[2] - bflo(h23), w[3] - bfhi(h23));
                  *(u32x2*)(xb + (size_t)m * D + 4 * (lane + 64 * j)) = (u32x2){h01, h23}; *(u32x2*)(xl + (size_t)m * D + 4 * (lane + 64 * j)) = (u32x2){l01, l23}; }
              s = wave_sum(s); if (lane < 16) ss0[(size_t)m * 16 + lane] = (lane == 0) ? s : 0.f; } } }
    { float* tab = (float*)(ws + WS_ROPE);
      for (int idx = gt; idx < M * 32; idx += NGT) { const int m = idx >> 5, d = idx & 31; const float ang = (float)a.pos[m] * a.inv_freq[d];
          const double rev = (double)ang * 0.15915494309189535; const float fr = (float)(rev - __builtin_rint(rev));
          tab[(size_t)m * 64 + d] = __builtin_amdgcn_cosf(fr); tab[(size_t)m * 64 + 32 + d] = __builtin_amdgcn_sinf(fr); } }
}

__device__ __forceinline__ void el_phase(const KAS Args& a, int i, const int tid_, const int bid, const int nblk) {
    const bf16_t* Z = (const bf16_t*)(a.ws + WS_HZ); bf16_t* LA = (bf16_t*)((unsigned char*)a.out + OUT_LA);
    const float* mu = a.mu + i * 1792 + 1536;
    const int gt = bid * 512 + tid_, NGT = nblk * 512;
    for (int ib = gt; ib < M * 32; ib += 4 * NGT) { u32x4 rc[4], rp[4];
#pragma unroll
        for (int k = 0; k < 4; ++k) { const int idx = ib + k * NGT; const int ii = idx < M * 32 ? idx : ib; const int m = ii >> 5, c0 = (ii & 31) * 8, t = m & (T - 1);
            rc[k] = *(const u32x4*)(Z + (size_t)m * ZC + 1536 + c0); rp[k] = (t > 0) ? *(const u32x4*)(Z + (size_t)(m - 1) * ZC + 1536 + c0) : (u32x4){0u, 0u, 0u, 0u}; }
#pragma unroll
        for (int k = 0; k < 4; ++k) { const int idx = ib + k * NGT; if (idx >= M * 32) break; const int m = idx >> 5, c0 = (idx & 31) * 8;
            float zc[8], zp[8], o[8]; unpack8(rc[k], zc); unpack8(rp[k], zp);
#pragma unroll
            for (int e = 0; e < 8; ++e) { const float z = zc[e] + (zp[e] - zc[e]) * mu[c0 + e];
                o[e] = (c0 < 64) ? (2.0f * fast_sigmoid(2.0f * z) - 1.0f) : (c0 < 128 ? z : fast_sigmoid(z)); }
            *(u32x4*)(LA + (size_t)m * LAC + c0) = pack8(o); } }
}

constexpr int TC = 32, SST = 352;
__device__ __forceinline__ void scan_load(const bf16_t* Z, const bf16_t* LO, size_t mrow0, int t0, int tid, int colb, u32x2 (&pz)[8]) {
    const int t = t0 + (tid >> 4); const size_t m = mrow0 + t; const bf16_t* zr = Z + m * ZC + colb; const bf16_t* lo = LO + m * LOC + colb;
    pz[0] = *(const u32x2*)(zr); pz[1] = *(const u32x2*)(zr + 512); pz[2] = *(const u32x2*)(zr + 1024);
    if (t > 0) { pz[3] = *(const u32x2*)(zr - ZC); pz[4] = *(const u32x2*)(zr + 512 - ZC); pz[5] = *(const u32x2*)(zr + 1024 - ZC); } else { pz[3] = (u32x2){0u, 0u}; pz[4] = (u32x2){0u, 0u}; pz[5] = (u32x2){0u, 0u}; }
    pz[6] = *(const u32x2*)(lo); pz[7] = *(const u32x2*)(lo + 512);
}
__device__ __forceinline__ void up4(const u32x2 w, float (&f)[4]) { f[0] = bflo(w.x); f[1] = bfhi(w.x); f[2] = bflo(w.y); f[3] = bfhi(w.y); }
__device__ __forceinline__ void scan_stage(const u32x2 (&pz)[8], LAS float* buf, float* RKB, size_t mrow0, int t0, int tid, int h, int half,
                                           const float (&mu_r)[4], const float (&mu_k)[4], const float (&mu_v)[4], const float (&kkc)[4], const float (&kac)[4], const float (&rkc)[4]) {
    const int tl = tid >> 4, cgp = tid & 15;
    float zr[4], zk[4], zv[4], zrp[4], zkp[4], zvp[4], ew[4], ic[4];
    up4(pz[0], zr); up4(pz[1], zk); up4(pz[2], zv); up4(pz[3], zrp); up4(pz[4], zkp); up4(pz[5], zvp); up4(pz[6], ew); up4(pz[7], ic);
    f32x4 r, k2, v, kkv, w; float n2 = 0.f, rkb = 0.f;
#pragma unroll
    for (int e = 0; e < 4; ++e) { r[e] = zr[e] + (zrp[e] - zr[e]) * mu_r[e]; const float k = zk[e] + (zkp[e] - zk[e]) * mu_k[e]; v[e] = zv[e] + (zvp[e] - zv[e]) * mu_v[e];
        kkv[e] = k * kkc[e]; n2 += kkv[e] * kkv[e]; k2[e] = k * (1.0f + (ic[e] - 1.0f) * kac[e]); w[e] = __builtin_amdgcn_exp2f(-1.4426950408889634f * ew[e]); rkb += r[e] * k2[e] * rkc[e]; }
    n2 = row16_sum(n2); rkb = row16_sum(rkb);
    const float inv = __builtin_amdgcn_rsqf(fmaxf(n2, 1e-24f));
    const f32x4 kkn = kkv * inv; f32x4 nb;
#pragma unroll
    for (int e = 0; e < 4; ++e) nb[e] = -kkn[e] * ic[e];
    if (half == 0 && cgp == 0) RKB[(mrow0 + t0 + tl) * 8 + h] = rkb;
    LAS float* sb = buf + tl * SST + 4 * cgp;
    *(LAS f32x4*)(sb) = kkn; *(LAS f32x4*)(sb + 64) = nb; *(LAS f32x4*)(sb + 128) = w; *(LAS f32x4*)(sb + 192) = k2; *(LAS f32x4*)(sb + 256) = r;
    if ((cgp >> 3) == half) *(LAS f32x4*)(buf + tl * SST + 320 + 4 * (cgp & 7)) = v;
}
__device__ __forceinline__ void scan_phase(const KAS Args& a, LAS unsigned char* lds, int i, const int tid_, const int bid, const int nblk) {
    const int tid = tid_, lane = tid & 63, wave = __builtin_amdgcn_readfirstlane(tid >> 6);
    const bf16_t* Z = (const bf16_t*)(a.ws + WS_HZ); const bf16_t* LO = (const bf16_t*)(a.ws + WS_LO);
    bf16_t* YR = (bf16_t*)((unsigned char*)a.out + OUT_YRAW); float* RKB = (float*)(a.ws + WS_RKB);
    LAS float* bufs = (LAS float*)lds; LAS float* ybuf = bufs + 2 * TC * SST;
    for (int unit = bid; unit < 256; unit += nblk) {
        const int bh = unit >> 1, half = unit & 1, b = bh >> 3, h = bh & 7, colb = h * 64 + 4 * (tid & 15);
        float mu_r[4], mu_k[4], mu_v[4], kkc[4], kac[4], rkc[4];
#pragma unroll
        for (int e = 0; e < 4; ++e) { mu_r[e] = a.mu[i * 1792 + colb + e]; mu_k[e] = a.mu[i * 1792 + 512 + colb + e]; mu_v[e] = a.mu[i * 1792 + 1024 + colb + e];
            kkc[e] = a.kk[i * 512 + colb + e]; kac[e] = a.ka[i * 512 + colb + e]; rkc[e] = a.rk[i * 512 + colb + e]; }
        const size_t mrow0 = (size_t)b * T;
        const int rl = wave * 4 + (lane >> 4), cgp = lane & 15;
        f32x4 S = {0.f, 0.f, 0.f, 0.f};
        u32x2 pz[8];
        __syncthreads();
        scan_load(Z, LO, mrow0, 0, tid, colb, pz);
        scan_stage(pz, bufs, RKB, mrow0, 0, tid, h, half, mu_r, mu_k, mu_v, kkc, kac, rkc);
        __syncthreads();
        for (int c = 0; c < T / TC; ++c) {
            const bool more = (c + 1 < T / TC);
            if (more) scan_load(Z, LO, mrow0, (c + 1) * TC, tid, colb, pz);
            const LAS float* buf = bufs + (c & 1) * (TC * SST); LAS float* yb = ybuf + (c & 1) * (TC * 32);
            {
                const LAS float* sb = buf + 4 * cgp; const LAS float* vb = buf + 320 + rl;
                f32x4 kk4 = *(const LAS f32x4*)(sb), nb4 = *(const LAS f32x4*)(sb + 64), w4 = *(const LAS f32x4*)(sb + 128), k4 = *(const LAS f32x4*)(sb + 192), r4 = *(const LAS f32x4*)(sb + 256);
                float v = vb[0], ysel = 0.f;
#pragma unroll
                for (int t = 0; t < TC; ++t) {
                    f32x4 kk4n = kk4, nb4n = nb4, w4n = w4, k4n = k4, r4n = r4; float vn = v;
                    if (t + 1 < TC) { const LAS float* sn = sb + (t + 1) * SST;
                        kk4n = *(const LAS f32x4*)(sn); nb4n = *(const LAS f32x4*)(sn + 64); w4n = *(const LAS f32x4*)(sn + 128); k4n = *(const LAS f32x4*)(sn + 192); r4n = *(const LAS f32x4*)(sn + 256); vn = vb[(t + 1) * SST]; }
                    __builtin_amdgcn_sched_barrier(0x6);
                    float sa = fmaf(S[3], kk4[3], fmaf(S[2], kk4[2], fmaf(S[1], kk4[1], S[0] * kk4[0])));
                    const f32x4 Tm = S * w4 + k4 * v;
                    sa = row16_sum(sa);
                    S = Tm + nb4 * sa;
                    float y = fmaf(S[3], r4[3], fmaf(S[2], r4[2], fmaf(S[1], r4[1], S[0] * r4[0]))); y = row16_sum(y);
                    ysel = (cgp == (t & 15)) ? y : ysel;
                    if ((t & 15) == 15) yb[(t - 15 + cgp) * 32 + rl] = ysel;
                    kk4 = kk4n; nb4 = nb4n; w4 = w4n; k4 = k4n; r4 = r4n; v = vn; }
            }
            if (more) scan_stage(pz, bufs + ((c + 1) & 1) * (TC * SST), RKB, mrow0, (c + 1) * TC, tid, h, half, mu_r, mu_k, mu_v, kkc, kac, rkc);
            __syncthreads();
#pragma unroll
            for (int q = 0; q < 2; ++q) { const int idx = tid + 512 * q, t = idx >> 5, r = idx & 31;
                YR[(mrow0 + c * TC + t) * 512 + h * 64 + half * 32 + r] = (bf16_t)(pk2(yb[t * 32 + r], 0.f) & 0xffffu); }
        }
    }
}

__device__ __forceinline__ void post_phase(const KAS Args& a, LAS unsigned char* lds, int i, const int tid_, const int bid, const int nblk) {
    const int tid = tid_, lane = tid & 63, wave = __builtin_amdgcn_readfirstlane(tid >> 6);
    const bf16_t* Z = (const bf16_t*)(a.ws + WS_HZ); const bf16_t* LO = (const bf16_t*)(a.ws + WS_LO); const bf16_t* YR = (const bf16_t*)((unsigned char*)a.out + OUT_YRAW);
    const float* RKB = (const float*)(a.ws + WS_RKB); bf16_t* Y = (bf16_t*)(a.ws + WS_Y);
    { const int c0 = 8 * lane; float gg[8], gb[8], muv[8];
#pragma unroll
      for (int e = 0; e < 8; ++e) { gg[e] = a.gng[i * 512 + c0 + e]; gb[e] = a.gnb[i * 512 + c0 + e]; muv[e] = a.mu[i * 1792 + 1024 + c0 + e]; }
      const int stride = nblk * 8;
      for (int mb = bid * 8 + wave; mb < M; mb += 2 * stride) {
          u32x4 ry[2], rvc[2], rvp[2], rg[2]; float bon[2]; bool has[2];
#pragma unroll
          for (int k = 0; k < 2; ++k) { const int m = mb + k * stride; has[k] = (m < M); const int mm = has[k] ? m : mb; const int t = mm & (T - 1);
              ry[k] = *(const u32x4*)(YR + (size_t)mm * 512 + c0); rvc[k] = *(const u32x4*)(Z + (size_t)mm * ZC + 1024 + c0);
              rvp[k] = (t > 0) ? *(const u32x4*)(Z + (size_t)(mm - 1) * ZC + 1024 + c0) : (u32x4){0u, 0u, 0u, 0u};
              rg[k] = *(const u32x4*)(LO + (size_t)mm * LOC + 1024 + c0); bon[k] = RKB[(size_t)mm * 8 + (lane >> 3)]; }
#pragma unroll
          for (int k = 0; k < 2; ++k) { const int m = mb + k * stride;
              float y[8], vc[8], vp[8], g[8], o[8];
              unpack8(ry[k], y); unpack8(rvc[k], vc); unpack8(rvp[k], vp); unpack8(rg[k], g);
              float s = 0.f;
#pragma unroll
              for (int e = 0; e < 8; ++e) s += y[e];
              s += __shfl_xor(s, 1); s += __shfl_xor(s, 2); s += __shfl_xor(s, 4);
              const float mean = s * (1.0f / 64.0f); float q = 0.f;
#pragma unroll
              for (int e = 0; e < 8; ++e) { const float d = y[e] - mean; q += d * d; }
              q += __shfl_xor(q, 1); q += __shfl_xor(q, 2); q += __shfl_xor(q, 4);
              const float rstd = 1.0f / sqrtf(q * (1.0f / 64.0f) + 64e-5f);
#pragma unroll
              for (int e = 0; e < 8; ++e) { const float vs = vc[e] + (vp[e] - vc[e]) * muv[e]; o[e] = ((y[e] - mean) * rstd * gg[e] + gb[e] + bon[k] * vs) * g[e]; }
              if (has[k]) *(u32x4*)(Y + (size_t)m * D + c0) = pack8(o); } } }
    LAS float* stat = (LAS float*)lds;
    LAS bf16_t* Wl = (LAS bf16_t*)(lds + 1024);
    LAS bf16_t* St = (LAS bf16_t*)(lds + 1024 + 128 * 136 * 2);
    const int l15 = lane & 15, l4 = lane >> 4;
    for (int ch = bid; ch < M / 128; ch += nblk) { const size_t m0 = (size_t)ch * 128;
        __syncthreads();
#pragma unroll 1
        for (int tb = 0; tb < 16; tb += 4) { u32x4 raw[4];
#pragma unroll
            for (int k = 0; k < 4; ++k) raw[k] = *(const u32x4*)(Z + (m0 + wave * 16 + tb + k) * ZC + 2304 + 8 * lane);
#pragma unroll
            for (int k = 0; k < 4; ++k) { const int tok = wave * 16 + tb + k; float sv[8]; unpack8(raw[k], sv); float s = 0.f;
#pragma unroll
                for (int e = 0; e < 8; e += 2) { const f32x2 gq = pg8::gelu_pk((f32x2){sv[e], sv[e + 1]}); sv[e] = gq.x; sv[e + 1] = gq.y; s += gq.x + gq.y; }
                const float mean = wave_sum(s) * (1.0f / 512.0f); float q = 0.f;
#pragma unroll
                for (int e = 0; e < 8; ++e) { const float d = sv[e] - mean; q += d * d; }
                const float rstd = 1.0f / sqrtf(wave_sum(q) * (1.0f / 512.0f) + 1e-5f);
                if (lane == 0) { stat[2 * tok] = mean; stat[2 * tok + 1] = rstd; } } }
        const int stok = tid >> 2, spart = tid & 3, etok = 16 * wave + l15;
        u32x4 raw[4]; f32x4 wr0[4], wr1[4];
#define GM_LOAD(G) do { const float* wsrc_ = a.wsp + ((size_t)(i * 4 + (G)) * 128 + stok) * 128 + 32 * spart; _Pragma("unroll") for (int q = 0; q < 4; ++q) { \
        raw[q] = *(const u32x4*)(Z + (m0 + stok) * ZC + 2304 + (G) * 128 + 32 * spart + 8 * q); wr0[q] = *(const f32x4*)(wsrc_ + 8 * q); wr1[q] = *(const f32x4*)(wsrc_ + 8 * q + 4); } } while (0)
        GM_LOAD(0);
#pragma unroll 1
        for (int g = 0; g < 4; ++g) {
            __syncthreads();
            { const float mean = stat[2 * stok], rstd = stat[2 * stok + 1];
#pragma unroll
              for (int q = 0; q < 4; ++q) { float sv[8], wv[8]; const int d0 = 32 * spart + 8 * q;
                  unpack8(raw[q], sv);
#pragma unroll
                  for (int e = 0; e < 8; e += 2) { const f32x2 gq = pg8::gelu_pk((f32x2){sv[e], sv[e + 1]}); sv[e] = gq.x; sv[e + 1] = gq.y; }
#pragma unroll
                  for (int e = 0; e < 8; ++e) { const int dd = g * 128 + d0 + e; const float sn = (sv[e] - mean) * rstd * a.lng[i * 512 + dd] + a.lnb[i * 512 + dd];
                      St[(d0 + e) * 136 + stok] = (bf16_t)(pk2(sn, 0.f) & 0xffffu); }
#pragma unroll
                  for (int e = 0; e < 4; ++e) { wv[e] = (d0 + e <= stok) ? wr0[q][e] : 0.f; wv[4 + e] = (d0 + 4 + e <= stok) ? wr1[q][e] : 0.f; }
                  *(LAS u32x4*)(Wl + stok * 136 + d0) = pack8(wv); } }
            if (g < 3) GM_LOAD(g + 1);
            u32x2 uz[8];
#pragma unroll
            for (int dt = 0; dt < 8; ++dt) uz[dt] = *(const u32x2*)(Z + (m0 + etok) * ZC + 1792 + g * 128 + 16 * dt + 4 * l4);
            const float bs = a.bsp[(i * 4 + g) * 128 + etok];
            __syncthreads();
            f32x4 acc[8];
#pragma unroll
            for (int dt = 0; dt < 8; ++dt) acc[dt] = (f32x4){0.f, 0.f, 0.f, 0.f};
#pragma unroll
            for (int ks = 0; ks < 4; ++ks) { const bf16x8 wf = *(const LAS bf16x8*)(Wl + (16 * wave + l15) * 136 + 32 * ks + 8 * l4);
#pragma unroll
                for (int dt = 0; dt < 8; ++dt) { const bf16x8 sf = *(const LAS bf16x8*)(St + (16 * dt + l15) * 136 + 32 * ks + 8 * l4);
                    acc[dt] = __builtin_amdgcn_mfma_f32_16x16x32_bf16(sf, wf, acc[dt], 0, 0, 0); } }
#pragma unroll
            for (int dt = 0; dt < 8; ++dt) { const f32x2 u0 = pg8::gelu_pk((f32x2){bflo(uz[dt].x), bfhi(uz[dt].x)}), u1 = pg8::gelu_pk((f32x2){bflo(uz[dt].y), bfhi(uz[dt].y)});
                *(u32x2*)(Y + (m0 + etok) * D + 512 + g * 128 + 16 * dt + 4 * l4) = (u32x2){pk2(u0.x * (acc[dt][0] + bs), u0.y * (acc[dt][1] + bs)), pk2(u1.x * (acc[dt][2] + bs), u1.y * (acc[dt][3] + bs))}; }
        }
#undef GM_LOAD
    }
}

__device__ __forceinline__ void attn_phase(const KAS Args& a, LAS unsigned char* lds, int i, const int tid_, const int bid, const int nblk) {
    const int tid = tid_, lane = tid & 63, wave = __builtin_amdgcn_readfirstlane(tid >> 6);
    const int l15 = lane & 15, l4 = lane >> 4;
    const bf16_t* QKV = (const bf16_t*)(a.ws + WS_HZ); bf16_t* Y = (bf16_t*)(a.ws + WS_Y); const float* tab = (const float*)(a.ws + WS_ROPE);
    LAS bf16_t* Ks = (LAS bf16_t*)lds;
    LAS bf16_t* Vt = (LAS bf16_t*)(lds + 36864);
    LAS bf16_t* Pb = (LAS bf16_t*)(lds + 36864 + 33792) + wave * (16 * 168);
    const float* qn = a.qn + i * 64; const float* kn = a.kn + i * 64;
    for (int unit = bid; unit < 16 * 4 * 32; unit += nblk) {
        const int b = unit >> 7, kvh = (unit >> 5) & 3, n = unit & 31;
        const size_t m0 = (size_t)b * T + n * 128;
        __syncthreads();
        { const int key = tid >> 1, hh = tid & 1; const bool valid = (n > 0) || (key >= 128); const size_t mk = m0 + key - 128;
          u32x4 k0v = {0u, 0u, 0u, 0u}, k1v = k0v, k2v = k0v, k3v = k0v;
          if (valid) { const bf16_t* kp = QKV + mk * QKVC + 1024 + kvh * 64 + 16 * hh; k0v = *(const u32x4*)(kp); k1v = *(const u32x4*)(kp + 8); k2v = *(const u32x4*)(kp + 32); k3v = *(const u32x4*)(kp + 40); }
          LAS bf16_t* kd = Ks + key * 72 + 16 * hh;
          *(LAS u32x4*)(kd) = k0v; *(LAS u32x4*)(kd + 8) = k1v; *(LAS u32x4*)(kd + 32) = k2v; *(LAS u32x4*)(kd + 40) = k3v;
        }
        { const int kp = (wave & 1) * 64 + lane, dq = wave >> 1; const bool valid = (n > 0) || (kp >= 64); const size_t mk = m0 + 2 * kp - 128;
          u32x4 va0 = {0u, 0u, 0u, 0u}, va1 = va0, vb0 = va0, vb1 = va0;
          if (valid) { const bf16_t* vp = QKV + mk * QKVC + 1280 + kvh * 64 + 16 * dq; va0 = *(const u32x4*)(vp); va1 = *(const u32x4*)(vp + 8); vb0 = *(const u32x4*)(vp + QKVC); vb1 = *(const u32x4*)(vp + QKVC + 8); }
          LAS unsigned* vt32 = (LAS unsigned*)Vt;
#define VT_ST(dd, A, B) vt32[((16 * dq + (dd)) * 264 + 2 * kp) >> 1] = ((A) & 0xffffu) | ((B) << 16); vt32[((16 * dq + (dd) + 1) * 264 + 2 * kp) >> 1] = ((A) >> 16) | ((B) & 0xffff0000u)
          VT_ST(0, va0.x, vb0.x); VT_ST(2, va0.y, vb0.y); VT_ST(4, va0.z, vb0.z); VT_ST(6, va0.w, vb0.w);
          VT_ST(8, va1.x, vb1.x); VT_ST(10, va1.y, vb1.y); VT_ST(12, va1.z, vb1.z); VT_ST(14, va1.w, vb1.w);
#undef VT_ST
        }
        __syncthreads();
        const int g = wave >> 1, qh = kvh * 4 + g; const float sink = a.sinks[i * 16 + qh];
#pragma unroll 1
        for (int pass = 0; pass < 2; ++pass) { const int i0 = (wave & 1) * 64 + pass * 32;
            bf16x8 qf[2][2];
#pragma unroll
            for (int rt = 0; rt < 2; ++rt) { const size_t mq = m0 + i0 + 16 * rt + l15; const bf16_t* qp = QKV + mq * QKVC + qh * 64 + 8 * l4;
                qf[rt][0] = *(const bf16x8*)(qp); qf[rt][1] = *(const bf16x8*)(qp + 32); }
            f32x4 sc[2][10];
#pragma unroll
            for (int rt = 0; rt < 2; ++rt)
#pragma unroll
                for (int kt = 0; kt < 10; ++kt) sc[rt][kt] = (f32x4){0.f, 0.f, 0.f, 0.f};
#pragma unroll
            for (int kt = 0; kt < 10; ++kt)
#pragma unroll
                for (int ks = 0; ks < 2; ++ks) { const bf16x8 kf = *(const LAS bf16x8*)(Ks + (i0 + 16 * kt + l15) * 72 + 32 * ks + 8 * l4);
#pragma unroll
                    for (int rt = 0; rt < 2; ++rt) if (kt - rt >= 0 && kt - rt <= 8) sc[rt][kt] = __builtin_amdgcn_mfma_f32_16x16x32_bf16(kf, qf[rt][ks], sc[rt][kt], 0, 0, 0); }
#pragma unroll
            for (int rt = 0; rt < 2; ++rt) {
                float mx = -INFINITY;
#pragma unroll
                for (int kt = 0; kt < 10; ++kt) { const int dk = kt - rt;
                    if (dk < 0 || dk > 8) continue;
#pragma unroll
                    for (int reg = 0; reg < 4; ++reg) { float sv = sc[rt][kt][reg];
                        if (dk == 0) sv = (4 * l4 + reg > l15) ? sv : -INFINITY;
                        if (dk == 8) sv = (4 * l4 + reg <= l15) ? sv : -INFINITY;
                        if (n == 0) sv = (i0 + 16 * kt + 4 * l4 + reg >= 128) ? sv : -INFINITY;
                        sc[rt][kt][reg] = sv; mx = fmaxf(mx, sv); } }
                mx = fmaxf(mx, __shfl_xor(mx, 16)); mx = fmaxf(mx, __shfl_xor(mx, 32)); mx = fmaxf(mx, sink);
                const float mneg = -mx * 1.4426950408889634f; float sum = 0.f;
#pragma unroll
                for (int kt = 0; kt < 10; ++kt) { const int dk = kt - rt;
                    if (dk < 0 || dk > 8) { sc[rt][kt] = (f32x4){0.f, 0.f, 0.f, 0.f}; continue; }
#pragma unroll
                    for (int reg = 0; reg < 4; ++reg) { const float p = __builtin_amdgcn_exp2f(fmaf(sc[rt][kt][reg], 1.4426950408889634f, mneg)); sc[rt][kt][reg] = p; sum += p; } }
                sum += __shfl_xor(sum, 16); sum += __shfl_xor(sum, 32);
                sum += __builtin_amdgcn_exp2f(fmaf(sink, 1.4426950408889634f, mneg));
                const float rden = __builtin_amdgcn_rcpf(sum);
                f32x4 o[4];
#pragma unroll
                for (int dt = 0; dt < 4; ++dt) o[dt] = (f32x4){0.f, 0.f, 0.f, 0.f};
#pragma unroll
                for (int ks = 0; ks < 5; ++ks) { const f32x4 pa = sc[rt][2 * ks], pb = sc[rt][2 * ks + 1];
                    const bf16x8 pf = __builtin_bit_cast(bf16x8, (u32x4){pk2(pa[0], pa[1]), pk2(pa[2], pa[3]), pk2(pb[0], pb[1]), pk2(pb[2], pb[3])});
#pragma unroll
                    for (int dt = 0; dt < 4; ++dt) { const LAS bf16_t* vp = Vt + (16 * dt + l15) * 264 + i0 + 32 * ks + 4 * l4;
                        const u32x2 v0 = *(const LAS u32x2*)(vp), v1 = *(const LAS u32x2*)(vp + 16);
                        const bf16x8 vf = __builtin_bit_cast(bf16x8, (u32x4){v0.x, v0.y, v1.x, v1.y});
                        o[dt] = __builtin_amdgcn_mfma_f32_16x16x32_bf16(vf, pf, o[dt], 0, 0, 0); } }
                { const size_t mq = m0 + i0 + 16 * rt + l15;
#pragma unroll
                  for (int dt = 0; dt < 4; ++dt) *(u32x2*)(Y + mq * D + qh * 64 + 16 * dt + 4 * l4) = (u32x2){pk2(o[dt][0] * rden, o[dt][1] * rden), pk2(o[dt][2] * rden, o[dt][3] * rden)}; }
            }
        }
    }
}

#define XB_TMO      128
#define XB_XCNT(j)  (256  + 64 * (j))
#define XB_XSUB(j)  (1280 + 64 * (j))
#define XB_XGEN(j)  (2304 + 64 * (j))
#define XB_TOP      3328
#define XB_TOPGEN   3392
#define XCD_BAR_WORDS 3456
#define XB_SPIN_CAP (1u << 18)

__device__ __forceinline__ unsigned xb_ld(unsigned* p)              { return __hip_atomic_load(p, __ATOMIC_RELAXED, __HIP_MEMORY_SCOPE_AGENT); }
__device__ __forceinline__ unsigned xb_add(unsigned* p, unsigned v) { return __hip_atomic_fetch_add(p, v, __ATOMIC_RELAXED, __HIP_MEMORY_SCOPE_AGENT); }
__device__ __forceinline__ unsigned xb_xcc_id() { return (unsigned)__builtin_amdgcn_s_getreg((3 << 11) | 20) & 0xFu; }
#define XB_SPIN(cond, bar) do { unsigned _sp = 0; while (cond) { __builtin_amdgcn_s_sleep(1); \
    if ((++_sp & 255u) == 0u) { if (xb_ld(&(bar)[XB_TMO])) break; if (_sp > XB_SPIN_CAP) { atomicAdd(&(bar)[XB_TMO], 1u); break; } } } } while (0)

struct XcdBarrier {
    unsigned* bar; unsigned x;
    volatile LAS unsigned* st;
};

__device__ __forceinline__ XcdBarrier xcd_barrier_post(unsigned* bar, volatile LAS unsigned* st) {
    XcdBarrier b; b.bar = bar; b.x = xb_xcc_id(); b.st = st;
    if (threadIdx.x == 0) (void)xb_add(&bar[XB_XCNT(b.x)], 1u);
    return b;
}
__device__ __forceinline__ void xcd_barrier_complete(unsigned* bar, unsigned x, unsigned& nloc, unsigned& nx) {
    const unsigned G = gridDim.x * gridDim.y * gridDim.z;
    unsigned sum, cnt, mine, sp = 0u;
    for (;;) {
        sum = 0u; cnt = 0u; mine = 0u;
#pragma unroll
        for (unsigned j = 0; j < 16; ++j) { const unsigned c = xb_ld(&bar[XB_XCNT(j)]); sum += c; cnt += (c > 0u) ? 1u : 0u; mine = (j == x) ? c : mine; }
        if (sum == G) break;
        __builtin_amdgcn_s_sleep(1);
        if ((++sp & 255u) == 0u) { if (xb_ld(&bar[XB_TMO])) break; if (sp > XB_SPIN_CAP) { atomicAdd(&bar[XB_TMO], 1u); break; } }
    }
    nloc = mine > 0u ? mine : 1u; nx = cnt > 0u ? cnt : 1u;
}

__device__ __forceinline__ void xcd_barrier(const XcdBarrier& b) {
    asm volatile("s_waitcnt vmcnt(0)" ::: "memory");
    __syncthreads();
    if (threadIdx.x == 0) {
        unsigned* bar = b.bar;
        __builtin_amdgcn_s_waitcnt(0);
        unsigned nloc = b.st[0], nx = b.st[1];
        if (nloc == 0u) { xcd_barrier_complete(bar, b.x, nloc, nx); b.st[0] = nloc; b.st[1] = nx; }
        const unsigned old = xb_add(&bar[XB_XSUB(b.x)], 1u);
        const unsigned gen = old / nloc;
        if (old + 1u == (gen + 1u) * nloc) {
            __builtin_amdgcn_fence(__ATOMIC_RELEASE, "agent");
            asm volatile("s_waitcnt vmcnt(0)" ::: "memory");
            const unsigned og = xb_add(&bar[XB_TOP], 1u);
            const unsigned tg = og / nx;
            if (og + 1u == (tg + 1u) * nx) xb_add(&bar[XB_TOPGEN], 1u);
            else XB_SPIN(xb_ld(&bar[XB_TOPGEN]) == tg, bar);
            __builtin_amdgcn_fence(__ATOMIC_ACQUIRE, "agent");
            xb_add(&bar[XB_XGEN(b.x)], 1u);
            asm volatile("s_waitcnt vmcnt(0)" ::: "memory");
        } else {
            XB_SPIN(xb_ld(&bar[XB_XGEN(b.x)]) == gen, bar);
            __builtin_amdgcn_fence(__ATOMIC_ACQUIRE, "agent");
            asm volatile("s_waitcnt vmcnt(0)" ::: "memory");
        }
    }
    __syncthreads();
}
#ifndef PROBE_KIND
#define PROBE_KIND -1
#endif
#if PROBE_KIND == 6
constexpr int NE = 11, NO = 7; __device__ const signed char EVEN_K[NE] = {1, 2, 3, 4, 5, 6, 6, 7, 8, 1, 2}, EVEN_S[NE] = {0, 0, 0, 0, 0, 0, 0, 0, 0, 1, 1}, ODD_K[NO] = {1, 2, 3, 9, 8, 1, 2}, ODD_S[NO] = {0, 0, 0, 0, 0, 1, 1};
#elif PROBE_KIND == 7
constexpr int NE = 11, NO = 7; __device__ const signed char EVEN_K[NE] = {1, 2, 3, 4, 5, 6, 7, 7, 8, 1, 2}, EVEN_S[NE] = {0, 0, 0, 0, 0, 0, 0, 0, 0, 1, 1}, ODD_K[NO] = {1, 2, 3, 9, 8, 1, 2}, ODD_S[NO] = {0, 0, 0, 0, 0, 1, 1};
#elif PROBE_KIND == 9
constexpr int NE = 10, NO = 8; __device__ const signed char EVEN_K[NE] = {1, 2, 3, 4, 5, 6, 7, 8, 1, 2}, EVEN_S[NE] = {0, 0, 0, 0, 0, 0, 0, 0, 1, 1}, ODD_K[NO] = {1, 2, 3, 9, 9, 8, 1, 2}, ODD_S[NO] = {0, 0, 0, 0, 0, 0, 1, 1};
#elif PROBE_KIND == 1
constexpr int NE = 12, NO = 9; __device__ const signed char EVEN_K[NE] = {1, 1, 2, 3, 4, 5, 6, 7, 8, 1, 1, 2}, EVEN_S[NE] = {0, 0, 0, 0, 0, 0, 0, 0, 0, 1, 1, 1}, ODD_K[NO] = {1, 1, 2, 3, 9, 8, 1, 1, 2}, ODD_S[NO] = {0, 0, 0, 0, 0, 0, 1, 1, 1};
#elif PROBE_KIND == 3
constexpr int NE = 12, NO = 8; __device__ const signed char EVEN_K[NE] = {1, 2, 3, 3, 4, 5, 5, 6, 7, 8, 1, 2}, EVEN_S[NE] = {0, 0, 0, 0, 0, 0, 0, 0, 0, 0, 1, 1}, ODD_K[NO] = {1, 2, 3, 3, 9, 8, 1, 2}, ODD_S[NO] = {0, 0, 0, 0, 0, 0, 1, 1};
#else
constexpr int NE = 10, NO = 7; __device__ const signed char EVEN_K[NE] = {1, 2, 3, 4, 5, 6, 7, 8, 1, 2}, EVEN_S[NE] = {0, 0, 0, 0, 0, 0, 0, 0, 1, 1}, ODD_K[NO] = {1, 2, 3, 9, 8, 1, 2}, ODD_S[NO] = {0, 0, 0, 0, 0, 1, 1};
#endif
constexpr int N_PHASES = 1 + 2 * (NE + NO);
__global__ void __launch_bounds__(512) mega_fwd(Args a_) {
    extern __shared__ __attribute__((aligned(16))) unsigned char lds_raw[];
    cg::grid_group grid = cg::this_grid();
    const int ph_lo = a_.ph_lo, ph_hi = a_.ph_hi;
    volatile LAS unsigned* MISC = (volatile LAS unsigned*)((LAS unsigned char*)lds_raw + 131072 + 320);
    if (threadIdx.x < 32) MISC[threadIdx.x] = 0u;
    __syncthreads();
    XcdBarrier xbar; xbar.bar = (unsigned*)a_.ws; xbar.x = 0; xbar.st = nullptr;
    for (int ph = ph_lo; ph < ph_hi; ++ph) {
        int koff = 0, bid = blockIdx.x, nblk = gridDim.x, tid_ = threadIdx.x; asm volatile("" : "+s"(koff), "+s"(bid), "+s"(nblk), "+v"(tid_));
        LAS unsigned char* lds = (LAS unsigned char*)lds_raw + koff;
        const KAS Args& a = *kargs(koff);
        unsigned char* ws = a.ws;
        float* ssb = (float*)(ws + WS_SS);
        bf16_t* XB = (bf16_t*)(ws + WS_XB); bf16_t* HZ = (bf16_t*)(ws + WS_HZ); bf16_t* YB = (bf16_t*)(ws + WS_Y);
        int kind = 0, l = 0, second = 0;
        if (ph > 0) { const int p = ph - 1, pair = p / (NE + NO), q = p % (NE + NO);
            if (q < NE) { l = 2 * pair; kind = EVEN_K[q]; second = EVEN_S[q]; }
            else { l = 2 * pair + 1; kind = ODD_K[q - NE]; second = ODD_S[q - NE]; } }
        const int i = l >> 1, odd = l & 1, f = 2 * l + second;
#ifndef PHM
#define PHM 0x3ff
#endif
        if (kind == 0) { if (bid == 0) { for (int k_ = tid_; k_ < 4096; k_ += 512) ((unsigned*)ws)[k_] = 0u; }
                         if (PHM & 1) prologue(a, lds, tid_, bid, nblk); }
        else if (kind == 1 && (PHM & 2)) {
            pg8::Gemm g{XB, (const bf16_t*)(ws + WS_W + (size_t)f * FFN_STRIDE), M, 2 * FF, D}; pg8::StaticOrder S; S.init(M, 2 * FF, nblk, bid);
            pg8::EpiSwiglu E{HZ, FF, ssb};
            pg8::gemm_phase<pg8::EpiSwiglu, pg8::StaticOrder, true, true>(lds, g, S, E, tid_);
        } else if ((kind == 2 || kind == 8) && (PHM & 4)) {
            pg8::Gemm g; const float* bias = nullptr; float scale = 1.0f; float* ssn;
            if (kind == 2) { g = pg8::Gemm{HZ, (const bf16_t*)(ws + WS_W + (size_t)f * FFN_STRIDE + WD_OFF), M, D, FF}; scale = 0.5f; ssn = ssb; }
            else { g = pg8::Gemm{YB, (const bf16_t*)(odd ? ws + WS_WODD + i * ODD_STRIDE + WO_OFF : ws + WS_WMIX + i * EVEN_STRIDE + WOUT_OFF), M, D, D}; if (odd) bias = a.bo + i * D; ssn = ssb; }
            const bool first = (kind == 2 && l == 0 && !second), last = (kind == 2 && l == 3 && second), prelast = (kind == 8 && l == 3);
            bf16_t* xl = (bf16_t*)((unsigned char*)a.out + OUT_XL); bf16_t* xl2 = (bf16_t*)(ws + WS_LO);
            pg8::StaticOrder S; S.init(M, D, nblk, bid);
            pg8::EpiResid E{first ? a.x : nullptr, XB, last ? xl2 : xl, prelast ? xl2 : xl, last ? a.out : nullptr, ssn, bias, scale};
            pg8::gemm_phase<pg8::EpiResid, pg8::StaticOrder, false, true>(lds, g, S, E, tid_);
        } else if ((kind == 3 || kind == 5) && (PHM & 8)) {
            pg8::Gemm g; pg8::EpiBf E;
            if (kind == 3 && !odd) { g = pg8::Gemm{XB, (const bf16_t*)(ws + WS_WMIX + i * EVEN_STRIDE), M, ZC, D}; E = pg8::EpiBf{HZ, ZC, ssb, nullptr, 0, nullptr, nullptr, nullptr}; }
            else if (kind == 3) { g = pg8::Gemm{XB, (const bf16_t*)(ws + WS_WODD + i * ODD_STRIDE), M, QKVC, D}; E = pg8::EpiBf{HZ, QKVC, ssb, a.bqkv + i * QKVC, 2, (const float*)(ws + WS_ROPE), a.qn + i * 64, a.kn + i * 64}; }
            else { g = pg8::Gemm{(const bf16_t*)((unsigned char*)a.out + OUT_LA), (const bf16_t*)(ws + WS_WMIX + i * EVEN_STRIDE + WLORA_OFF), M, LOC, LAC}; E = pg8::EpiBf{(bf16_t*)(ws + WS_LO), LOC, nullptr, (const float*)(ws + WS_LB) + i * LOC, 1, nullptr, nullptr, nullptr}; }
            pg8::StaticOrder S; S.init(M, g.N, nblk, bid);
            pg8::gemm_phase<pg8::EpiBf, pg8::StaticOrder, true, true>(lds, g, S, E, tid_);
        } else if (kind == 4 && (PHM & 16)) el_phase(a, i, tid_, bid, nblk);
        else if (kind == 6 && (PHM & 32)) scan_phase(a, lds, i, tid_, bid, nblk);
        else if (kind == 7 && (PHM & 64)) post_phase(a, lds, i, tid_, bid, nblk);
        else if (kind == 9 && (PHM & 128)) attn_phase(a, lds, i, tid_, bid, nblk);
#ifndef PROBE_SYNC
#define PROBE_SYNC 1
#endif
#ifndef PROBE_PRO2
#define PROBE_PRO2 0
#endif
        if (PROBE_PRO2 && ph == 0) { grid.sync(); prologue(a, lds, tid_, bid, nblk); }
        if (ph + 1 < ph_hi) { if (ph == ph_lo) { grid.sync(); xbar = xcd_barrier_post((unsigned*)ws, MISC + 8); } else xcd_barrier(xbar); }
    }
}

#ifndef MK_MULTI
#define MK_MULTI 0
#endif
extern "C" void kernel_launch(void* const* d_in, const int* in_sizes, int n_in, void* d_out, int out_size, void* d_ws, size_t ws_size, hipStream_t stream) {
    static int grid = 0;
    if (grid == 0) {
        if (n_in != 35 || in_sizes[0] != M * D || out_size != M * D || ws_size < WS_END) { fprintf(stderr, "kernel_launch: unexpected shapes (n_in %d, in0 %d, out %d, ws %zu); nothing launched\n", n_in, n_in > 0 ? in_sizes[0] : -1, out_size, ws_size); grid = -1; return; }
        int dev = 0, cus = 0, per_cu = 0;
        hipGetDevice(&dev); hipDeviceGetAttribute(&cus, hipDeviceAttributeMultiprocessorCount, dev);
        if (hipFuncSetAttribute((const void*)mega_fwd, hipFuncAttributeMaxDynamicSharedMemorySize, LDS_BYTES) != hipSuccess) { fprintf(stderr, "kernel_launch: hipFuncSetAttribute failed\n"); grid = -1; return; }
        if (hipOccupancyMaxActiveBlocksPerMultiprocessor(&per_cu, (const void*)mega_fwd, 512, LDS_BYTES) != hipSuccess || per_cu < 1) { fprintf(stderr, "kernel_launch: occupancy query says %d\n", per_cu); per_cu = 1; }
        (void)hipGetLastError();
        grid = cus * per_cu;
        if (grid > 256) grid = 256;
    }
    if (grid < 0) return;
    Args a{};
    const float** fp = (const float**)&a.f1n;
    a.x = (const float*)d_in[0]; a.pos = (const int*)d_in[1];
    for (int k = 2; k < 35; ++k) fp[k - 2] = (const float*)d_in[k];
    a.out = (float*)d_out; a.ws = (unsigned char*)d_ws;
    for (int d = 0; d < 32; ++d) a.inv_freq[d] = (float)pow(10000.0, -(double)(2 * d) / 64.0);
#if MK_MULTI
    for (int ph = 0; ph < N_PHASES; ++ph) { a.ph_lo = ph; a.ph_hi = ph + 1; hipLaunchKernelGGL(mega_fwd, dim3(grid), dim3(512), LDS_BYTES, stream, a); }
#else
    a.ph_lo = 0; a.ph_hi = N_PHASES;
    void* args[] = {&a};
    hipError_t e = hipLaunchCooperativeKernel((const void*)mega_fwd, dim3(grid), dim3(512), args, LDS_BYTES, stream);
    if (e != hipSuccess) fprintf(stderr, "cooperative launch failed: %s (grid %d)\n", hipGetErrorString(e), grid);
#endif
}
```

```cpp
#include <hip/hip_runtime.h>
#include <hip/hip_cooperative_groups.h>
#include <cstdio>
#include <cstdint>
#include <cmath>
namespace pg8 {
#define PG8_LAS __attribute__((address_space(3)))
typedef unsigned short bf16_t;
typedef short bf16x8 __attribute__((ext_vector_type(8)));
typedef float f32x4 __attribute__((ext_vector_type(4)));
typedef unsigned u32x4 __attribute__((ext_vector_type(4)));
constexpr int BM = 256, BK = 64, HALF = 128, HTB = HALF * BK * 2  , STAGE_BYTES = 8 * HTB, NXCD = 8, WGM = 8;

__host__ __device__ __forceinline__ int lds_byte(int r, int c) { const int st = (r >> 4) * 2 + (c >> 5), rr = r & 15, cc = c & 31, ob = rr * 64 + cc * 2; return st * 1024 + (ob ^ (((ob >> 9) & 1) << 5)); }
__host__ __device__ __forceinline__ void stage_rc(int b, int& R, int& C) { const int st = b / 1024, sb = b % 1024, swz = sb ^ (((sb >> 9) & 1) << 5); R = (st >> 1) * 16 + swz / 64; C = (st & 1) * 32 + (swz % 64) / 2; }
__host__ __device__ __forceinline__ int perm32(int rho) { const int n = rho >> 4, i = rho & 15; return 8 * (i >> 2) + 4 * n + (i & 3); }

struct Unit { int pm, pn; };
struct Gemm { const bf16_t* A; const bf16_t* Bt; int M, N, K; };

struct StaticOrder {
    int nM, nN, nwg, G, c;
    __host__ __device__ void init(int M, int N, int G_, int c_) { nM = M / BM; nN = N / BM; nwg = nM * nN; G = G_; c = c_; }
    __host__ __device__ bool next(int i, Unit& u) const {
        const long L = (long)i * G + c; if (L >= nwg) return false;
        int wgid = (int)L; { const int q = nwg / NXCD, r = nwg % NXCD, xcd = wgid % NXCD, off = wgid / NXCD; wgid = (xcd < r ? xcd * (q + 1) : r * (q + 1) + (xcd - r) * q) + off; }
        const int nig = WGM * nN, gid = wgid / nig, fm = gid * WGM, gsz = (nM - fm) < WGM ? (nM - fm) : WGM;
        u.pm = fm + ((wgid % nig) % gsz); u.pn = (wgid % nig) / gsz; return true;
    }
    __device__ __forceinline__ void a_ready(const Unit&) const {}
    __device__ __forceinline__ void done(const Unit&) const {}
};
__device__ __forceinline__ unsigned cvt_pk_bf16(float lo, float hi) { unsigned r; asm volatile("v_cvt_pk_bf16_f32 %0, %1, %2" : "=v"(r) : "v"(lo), "v"(hi)); return r; }
typedef float f32x2 __attribute__((ext_vector_type(2)));
__device__ __forceinline__ f32x2 gelu_pk(f32x2 v) {
    const f32x2 av = __builtin_elementwise_abs(v), d = av * 0.2316418882f + 1.0f;
    f32x2 t; t.x = __builtin_amdgcn_rcpf(d.x); t.y = __builtin_amdgcn_rcpf(d.y);
    f32x2 q = t * 0.5307027145f + (-0.7265760135f); q = q * t + 0.7107068705f; q = q * t + (-0.142248368f); q = q * t + 0.127414796f; q = q * t;
    const f32x2 s = (v * v) * (-0.72134752044f);
    f32x2 e; e.x = __builtin_amdgcn_exp2f(s.x); e.y = __builtin_amdgcn_exp2f(s.y);
    const f32x2 m = v * (q * e), r = v - m;
    f32x2 o; o.x = v.x < 0.f ? m.x : r.x; o.y = v.y < 0.f ? m.y : r.y; return o;
}
typedef unsigned u32x2 __attribute__((ext_vector_type(2)));
typedef __bf16 bf16x2_t __attribute__((ext_vector_type(2)));
__device__ __forceinline__ unsigned pk2(float lo, float hi) { f32x2 v = {lo, hi}; bf16x2_t b = __builtin_convertvector(v, bf16x2_t); return __builtin_bit_cast(unsigned, b); }
__device__ __forceinline__ float fast_sigmoid(float x) { return __builtin_amdgcn_rcpf(1.0f + __builtin_amdgcn_exp2f(-1.4426950408889634f * x)); }

__device__ __forceinline__ float row_rs(const float* ss, int r, int fq) { const f32x4 a = *(const f32x4*)(ss + (size_t)r * 16 + 4 * fq);
    float t = (a[0] + a[1]) + (a[2] + a[3]); t += __shfl_xor(t, 16); t += __shfl_xor(t, 32); return __builtin_amdgcn_rsqf(t * (1.0f / 1024.0f) + 1e-6f); }
struct EpiSwiglu {
    static constexpr bool PERM = true, AFTER_DRAIN = false, WIDE = false;
    bf16_t* H; int ldh; const float* ss;
    __device__ __forceinline__ void operator()(const f32x4 (&acc)[2][2][4][2], const Unit& u, int wr, int wc, int fr, int fq) const {
        const int row0 = u.pm * BM + wr * 64 + fr; const int col0 = u.pn * HALF + wc * 32 + 8 * fq;
        float rsv[2][4];
#pragma unroll
        for (int ai = 0; ai < 2; ++ai)
#pragma unroll
            for (int m = 0; m < 4; ++m) rsv[ai][m] = row_rs(ss, row0 + ai * HALF + m * 16, fq);
#pragma unroll
        for (int ai = 0; ai < 2; ++ai)
#pragma unroll
            for (int m = 0; m < 4; ++m) { const int r = row0 + ai * HALF + m * 16; const float rs = rsv[ai][m], rs2 = rs * rs, nl = -1.4426950408889634f * rs;
                unsigned w[4];
#pragma unroll
                for (int n = 0; n < 2; ++n) { const f32x4 g = acc[ai][0][m][n], gu = g * acc[ai][1][m][n] * rs2, ge = g * nl; float hv[4];
#pragma unroll
                    for (int e = 0; e < 4; ++e) hv[e] = gu[e] * __builtin_amdgcn_rcpf(1.0f + __builtin_amdgcn_exp2f(ge[e]));
                    w[2 * n] = pk2(hv[0], hv[1]); w[2 * n + 1] = pk2(hv[2], hv[3]); }
                *(u32x4*)(H + (size_t)r * ldh + col0) = (u32x4){w[0], w[1], w[2], w[3]}; }
    }
};
struct EpiResid {
    static constexpr bool PERM = true, AFTER_DRAIN = false, WIDE = true;
    const float* xin;
    bf16_t* hi; const bf16_t* lo_in; bf16_t* lo_out;
    float* fout;
    float* ssn; const float* bias; float scale;
    __device__ __forceinline__ void operator()(const f32x4 (&acc)[2][2][4][2], const Unit& u, int wr, int wc, int fr, int fq) const {
        const int row0 = u.pm * BM + wr * 64 + fr; const int col0 = u.pn * BM + wc * 64 + 8 * fq;
        f32x4 bv[2][2];
#pragma unroll
        for (int bj = 0; bj < 2; ++bj)
#pragma unroll
            for (int n = 0; n < 2; ++n) bv[bj][n] = bias ? *(const f32x4*)(bias + col0 + bj * 32 + 4 * n) : (f32x4){0.f, 0.f, 0.f, 0.f};
#pragma unroll
        for (int q = 0; q < 4; ++q) { const int ai = q >> 1, mh = (q & 1) * 2;
            u32x4 rh[2][2], rl[2][2];
#pragma unroll
            for (int m = 0; m < 2; ++m)
#pragma unroll
                for (int bj = 0; bj < 2; ++bj) { const size_t c = (size_t)(row0 + ai * HALF + (mh + m) * 16) * 1024 + col0 + bj * 32;
                    if (xin) { rh[m][bj] = __builtin_bit_cast(u32x4, *(const f32x4*)(xin + c)); rl[m][bj] = __builtin_bit_cast(u32x4, *(const f32x4*)(xin + c + 4)); }
                    else { rh[m][bj] = *(const u32x4*)(hi + c); rl[m][bj] = *(const u32x4*)(lo_in + c); } }
#pragma unroll
            for (int m = 0; m < 2; ++m) { const int r = row0 + ai * HALF + (mh + m) * 16; float s = 0.f;
#pragma unroll
                for (int bj = 0; bj < 2; ++bj) { const size_t c = (size_t)r * 1024 + col0 + bj * 32; const u32x4 h = rh[m][bj], l = rl[m][bj]; f32x4 b0, b1;
                    if (xin) { b0 = __builtin_bit_cast(f32x4, h); b1 = __builtin_bit_cast(f32x4, l); }
                    else { b0 = (f32x4){__uint_as_float(h.x << 16) + __uint_as_float(l.x << 16), __uint_as_float(h.x & 0xffff0000u) + __uint_as_float(l.x & 0xffff0000u),
                                        __uint_as_float(h.y << 16) + __uint_as_float(l.y << 16), __uint_as_float(h.y & 0xffff0000u) + __uint_as_float(l.y & 0xffff0000u)};
                           b1 = (f32x4){__uint_as_float(h.z << 16) + __uint_as_float(l.z << 16), __uint_as_float(h.z & 0xffff0000u) + __uint_as_float(l.z & 0xffff0000u),
                                        __uint_as_float(h.w << 16) + __uint_as_float(l.w << 16), __uint_as_float(h.w & 0xffff0000u) + __uint_as_float(l.w & 0xffff0000u)}; }
                    const f32x4 v0 = b0 + acc[ai][bj][mh + m][0] * scale + bv[bj][0], v1 = b1 + acc[ai][bj][mh + m][1] * scale + bv[bj][1];
                    if (fout) { *(f32x4*)(fout + c) = v0; *(f32x4*)(fout + c + 4) = v1; }
                    else { const unsigned h0 = pk2(v0[0], v0[1]), h1 = pk2(v0[2], v0[3]), h2 = pk2(v1[0], v1[1]), h3 = pk2(v1[2], v1[3]);
                        const unsigned l0 = pk2(v0[0] - __uint_as_float(h0 << 16), v0[1] - __uint_as_float(h0 & 0xffff0000u)), l1 = pk2(v0[2] - __uint_as_float(h1 << 16), v0[3] - __uint_as_float(h1 & 0xffff0000u)),
                                       l2 = pk2(v1[0] - __uint_as_float(h2 << 16), v1[1] - __uint_as_float(h2 & 0xffff0000u)), l3 = pk2(v1[2] - __uint_as_float(h3 << 16), v1[3] - __uint_as_float(h3 & 0xffff0000u));
                        *(u32x4*)(hi + c) = (u32x4){h0, h1, h2, h3}; *(u32x4*)(lo_out + c) = (u32x4){l0, l1, l2, l3}; }
                    s += ((v0[0] * v0[0] + v0[1] * v0[1]) + (v0[2] * v0[2] + v0[3] * v0[3])) + ((v1[0] * v1[0] + v1[1] * v1[1]) + (v1[2] * v1[2] + v1[3] * v1[3])); }
                s += __shfl_xor(s, 16); s += __shfl_xor(s, 32);
                if (fq == 0) ssn[(size_t)r * 16 + u.pn * 4 + wc] = s; }
        }
    }
};
struct EpiBf {
    static constexpr bool PERM = true, AFTER_DRAIN = false, WIDE = true;
    bf16_t* O; int ldc; const float* ss; const float* bias; int mode;
    const float* tab; const float* qn; const float* kn;
    __device__ __forceinline__ void operator()(const f32x4 (&acc)[2][2][4][2], const Unit& u, int wr, int wc, int fr, int fq) const {
        const int row0 = u.pm * BM + wr * 64 + fr; const int col0 = u.pn * BM + wc * 64 + 8 * fq;
        const int seg = (mode == 1) ? (u.pn >> 1) : 3;
        const bool qk = (mode == 2) && (u.pn < 5); const float* gn = (u.pn < 4) ? qn : kn; const float qsc = (u.pn < 4) ? 0.125f : 1.0f;
        f32x4 bv[2][2];
#pragma unroll
        for (int bj = 0; bj < 2; ++bj)
#pragma unroll
            for (int n = 0; n < 2; ++n) bv[bj][n] = bias ? *(const f32x4*)(bias + col0 + bj * 32 + 4 * n) : (f32x4){0.f, 0.f, 0.f, 0.f};
        float rsv[2][4];
#pragma unroll
        for (int ai = 0; ai < 2; ++ai)
#pragma unroll
            for (int m = 0; m < 4; ++m) rsv[ai][m] = ss ? row_rs(ss, row0 + ai * HALF + m * 16, fq) : 1.0f;
#pragma unroll
        for (int ai = 0; ai < 2; ++ai)
#pragma unroll
            for (int m = 0; m < 4; ++m) { const int r = row0 + ai * HALF + m * 16; const float rs = rsv[ai][m];
                bf16_t* rowp = O + (size_t)r * ldc + col0;
                if (qk) {
                    f32x4 x1a = acc[ai][0][m][0] * rs + bv[0][0], x1b = acc[ai][0][m][1] * rs + bv[0][1], x2a = acc[ai][1][m][0] * rs + bv[1][0], x2b = acc[ai][1][m][1] * rs + bv[1][1];
                    float sq = 0.f;
#pragma unroll
                    for (int e = 0; e < 4; ++e) sq += (x1a[e] * x1a[e] + x1b[e] * x1b[e]) + (x2a[e] * x2a[e] + x2b[e] * x2b[e]);
                    sq += __shfl_xor(sq, 16); sq += __shfl_xor(sq, 32);
                    const float rms = qsc * __builtin_amdgcn_rsqf(sq * (1.0f / 64.0f) + 1e-6f);
                    const float* tr = tab + (size_t)r * 64 + 8 * fq;
                    const f32x4 ca = *(const f32x4*)(tr), cb = *(const f32x4*)(tr + 4), sa = *(const f32x4*)(tr + 32), sb = *(const f32x4*)(tr + 36);
                    const f32x4 g1a = *(const f32x4*)(gn + 8 * fq), g1b = *(const f32x4*)(gn + 8 * fq + 4), g2a = *(const f32x4*)(gn + 32 + 8 * fq), g2b = *(const f32x4*)(gn + 36 + 8 * fq);
                    x1a = x1a * rms * g1a; x1b = x1b * rms * g1b; x2a = x2a * rms * g2a; x2b = x2b * rms * g2b;
                    const f32x4 o1a = x1a * ca - x2a * sa, o1b = x1b * cb - x2b * sb, o2a = x2a * ca + x1a * sa, o2b = x2b * cb + x1b * sb;
                    *(u32x4*)(rowp) = (u32x4){pk2(o1a[0], o1a[1]), pk2(o1a[2], o1a[3]), pk2(o1b[0], o1b[1]), pk2(o1b[2], o1b[3])};
                    *(u32x4*)(rowp + 32) = (u32x4){pk2(o2a[0], o2a[1]), pk2(o2a[2], o2a[3]), pk2(o2b[0], o2b[1]), pk2(o2b[2], o2b[3])};
                } else {
#pragma unroll
                for (int bj = 0; bj < 2; ++bj) { f32x4 v0 = acc[ai][bj][m][0] * rs + bv[bj][0], v1 = acc[ai][bj][m][1] * rs + bv[bj][1];
                    if (mode == 3 && u.pn >= 7) { const f32x2 g0 = gelu_pk((f32x2){v0[0], v0[1]}), g1 = gelu_pk((f32x2){v0[2], v0[3]}), g2 = gelu_pk((f32x2){v1[0], v1[1]}), g3 = gelu_pk((f32x2){v1[2], v1[3]});
                        v0 = (f32x4){g0.x, g0.y, g1.x, g1.y}; v1 = (f32x4){g2.x, g2.y, g3.x, g3.y}; }
                    if (seg < 2) { const float sc = (seg == 0) ? 0.60653065971263342f : 1.0f;
#pragma unroll
                        for (int e = 0; e < 4; ++e) { v0[e] = sc * fast_sigmoid(v0[e]); v1[e] = sc * fast_sigmoid(v1[e]); } }
                    *(u32x4*)(rowp + bj * 32) = (u32x4){pk2(v0[0], v0[1]), pk2(v0[2], v0[3]), pk2(v1[0], v1[1]), pk2(v1[2], v1[3])}; } } }
    }
};

template <class Epi, class Sched, bool ALIGN_EPI = false, bool SP2 = false>
__device__ __forceinline__ void gemm_phase(PG8_LAS unsigned char* lds, const Gemm g, const Sched& S, const Epi& E, const int tid_) {
    const int tid = tid_, wid = __builtin_amdgcn_readfirstlane(tid >> 6), lane = tid & 63, wr = wid >> 2, wc = wid & 3, fr = lane & 15, fq = lane >> 4;
    const int K = g.K, nt = K / BK;
    unsigned voffA[2], voffB[2];
#pragma unroll
    for (int i = 0; i < 2; ++i) { int R, C; stage_rc(tid * 16 + i * 8192, R, C); const int Rb = Epi::WIDE ? (64 * (R >> 5) + (Epi::PERM ? perm32(R & 31) : (R & 31))) : (Epi::PERM ? ((R & ~31) + perm32(R & 31)) : R);
        voffA[i] = (unsigned)(R * K + C) * 2u; voffB[i] = (unsigned)(Rb * K + C) * 2u; }
    const size_t kstep = (size_t)(BK * 2);
    const size_t hstep = (size_t)HALF * K * 2;
    const size_t tstep = 2 * hstep;
    const size_t hstepB = Epi::WIDE ? (size_t)32 * K * 2 : hstep;
    const unsigned ldsw = (unsigned)wid * 1024u;
    const int aoff = lds_byte(wr * 64 + fr, fq * 8), boff = lds_byte(wc * 32 + fr, fq * 8);
#define PG8_SA(b, h) (((b) * 2 + (h)) * HTB)
#define PG8_SB(b, h) ((4 + (b) * 2 + (h)) * HTB)
#define PG8_STAGE(bufoff, gbase, voff) do { _Pragma("unroll") for (int _i = 0; _i < 2; ++_i) \
        __builtin_amdgcn_global_load_lds((const unsigned*)((const char*)(gbase) + (voff)[_i]), (PG8_LAS unsigned*)(lds + (bufoff) + ldsw + _i * 8192), 16, 0, 0); } while (0)
#define PG8_LDA(dst, b, h) do { _Pragma("unroll") for (int m = 0; m < 4; ++m) _Pragma("unroll") for (int k = 0; k < 2; ++k) dst[m][k] = *(const PG8_LAS bf16x8*)(lds + PG8_SA(b, h) + aoff + m * 2048 + k * 1024); } while (0)
#define PG8_LDB(dst, b, h) do { _Pragma("unroll") for (int n = 0; n < 2; ++n) _Pragma("unroll") for (int k = 0; k < 2; ++k) dst[n][k] = *(const PG8_LAS bf16x8*)(lds + PG8_SB(b, h) + boff + n * 2048 + k * 1024); } while (0)
#define PG8_MMA(ai, bj, At, Bt) do { __builtin_amdgcn_s_setprio(1); _Pragma("unroll") for (int m = 0; m < 4; ++m) _Pragma("unroll") for (int n = 0; n < 2; ++n) _Pragma("unroll") for (int k = 0; k < 2; ++k) \
        acc[ai][bj][m][n] = __builtin_amdgcn_mfma_f32_16x16x32_bf16(Bt[n][k], At[m][k], acc[ai][bj][m][n], 0, 0, 0); __builtin_amdgcn_s_setprio(0); } while (0)
#define PG8_WAIT_V(n) asm volatile("s_waitcnt vmcnt(" #n ")" ::: "memory")
#define PG8_WAIT_L(n) asm volatile("s_waitcnt lgkmcnt(" #n ")" ::: "memory")
#define PG8_BAR __builtin_amdgcn_s_barrier()
#define PG8_SCHED __builtin_amdgcn_sched_barrier(0)
    Unit cur, nxt; int ui = 0;
    if (!S.next(0, cur)) return;
    f32x4 acc[2][2][4][2];
#pragma unroll
    for (int a = 0; a < 2; ++a)
#pragma unroll
        for (int b = 0; b < 2; ++b)
#pragma unroll
            for (int m = 0; m < 4; ++m)
#pragma unroll
                for (int n = 0; n < 2; ++n) acc[a][b][m][n] = (f32x4){0.f, 0.f, 0.f, 0.f};
    bf16x8 At[4][2], B0[2][2], B1[2][2];
    const char* cA = (const char*)g.A + (size_t)cur.pm * tstep; const char* cB = (const char*)g.Bt + (size_t)cur.pn * tstep;
    S.a_ready(cur);
    if constexpr (SP2) {
        PG8_STAGE(PG8_SB(0, 0), cB, voffB); PG8_STAGE(PG8_SB(0, 1), cB + hstepB, voffB); PG8_STAGE(PG8_SA(0, 0), cA, voffA); PG8_STAGE(PG8_SA(0, 1), cA + hstep, voffA);
        if (wr == 1) PG8_BAR;
        PG8_WAIT_V(2); PG8_BAR;
        PG8_STAGE(PG8_SB(1, 0), cB + kstep, voffB); PG8_STAGE(PG8_SA(1, 0), cA + kstep, voffA); PG8_STAGE(PG8_SB(1, 1), cB + hstepB + kstep, voffB);
        PG8_WAIT_V(6); PG8_BAR;
    } else {
        PG8_STAGE(PG8_SB(0, 0), cB, voffB); PG8_STAGE(PG8_SA(0, 0), cA, voffA); PG8_STAGE(PG8_SB(0, 1), cB + hstepB, voffB); PG8_STAGE(PG8_SA(0, 1), cA + hstep, voffA);
        if (wr == 1) PG8_BAR;
        PG8_WAIT_V(4); PG8_BAR;
        PG8_STAGE(PG8_SB(1, 0), cB + kstep, voffB); PG8_STAGE(PG8_SA(1, 0), cA + kstep, voffA); PG8_STAGE(PG8_SB(1, 1), cB + hstepB + kstep, voffB);
        PG8_WAIT_V(6); PG8_BAR;
    }
    for (;;) {
        const bool has_next = S.next(ui + 1, nxt);
        const char* nA = has_next ? (const char*)g.A + (size_t)nxt.pm * tstep : cA; const char* nB = has_next ? (const char*)g.Bt + (size_t)nxt.pn * tstep : cB;
        for (int t = 0; t < nt; t += 2) {
            const bool last = (t == nt - 2);
            const char* a1 = cA + (size_t)(t + 1) * kstep;
            const char* a2 = last ? nA : cA + (size_t)(t + 2) * kstep; const char* b2 = last ? nB : cB + (size_t)(t + 2) * kstep;
            const char* a3 = a2 + kstep; const char* b3 = b2 + kstep;
            if (last && has_next) S.a_ready(nxt);
            if constexpr (SP2) {
            PG8_LDB(B0, 0, 0); PG8_LDB(B1, 0, 1); PG8_SCHED; PG8_LDA(At, 0, 0); PG8_STAGE(PG8_SA(1, 1), a1 + hstep, voffA);
            PG8_WAIT_V(8); PG8_WAIT_L(0); PG8_BAR; PG8_MMA(0, 0, At, B0); PG8_MMA(0, 1, At, B1); PG8_BAR; PG8_SCHED;
            PG8_LDA(At, 0, 1); PG8_STAGE(PG8_SB(0, 0), b2, voffB); PG8_STAGE(PG8_SB(0, 1), b2 + hstepB, voffB); PG8_STAGE(PG8_SA(0, 0), a2, voffA);
            PG8_WAIT_V(8); PG8_WAIT_L(0); PG8_BAR; PG8_MMA(1, 0, At, B0); PG8_MMA(1, 1, At, B1); PG8_BAR; PG8_SCHED;
            PG8_LDB(B0, 1, 0); PG8_LDB(B1, 1, 1); PG8_SCHED; PG8_LDA(At, 1, 0); PG8_STAGE(PG8_SA(0, 1), a2 + hstep, voffA);
            PG8_WAIT_V(8); PG8_WAIT_L(0); PG8_BAR; PG8_MMA(0, 0, At, B0); PG8_MMA(0, 1, At, B1); PG8_BAR; PG8_SCHED;
            PG8_LDA(At, 1, 1); PG8_STAGE(PG8_SB(1, 0), b3, voffB); PG8_STAGE(PG8_SB(1, 1), b3 + hstepB, voffB); PG8_STAGE(PG8_SA(1, 0), a3, voffA);
            PG8_WAIT_V(8); PG8_WAIT_L(0); PG8_BAR; PG8_MMA(1, 0, At, B0); PG8_MMA(1, 1, At, B1); PG8_BAR; PG8_SCHED;
            } else {
            PG8_LDB(B0, 0, 0); PG8_SCHED; PG8_LDA(At, 0, 0); PG8_STAGE(PG8_SA(1, 1), a1 + hstep, voffA);
            PG8_WAIT_L(8); PG8_BAR; PG8_WAIT_L(0); PG8_MMA(0, 0, At, B0); PG8_BAR; PG8_SCHED;
            PG8_LDB(B1, 0, 1); PG8_STAGE(PG8_SB(0, 0), b2, voffB);
            PG8_BAR; PG8_WAIT_L(0); PG8_MMA(0, 1, At, B1); PG8_BAR;
            PG8_LDA(At, 0, 1); PG8_STAGE(PG8_SA(0, 0), a2, voffA);
            PG8_BAR; PG8_WAIT_L(0); PG8_MMA(1, 0, At, B0); PG8_BAR; PG8_SCHED;
            PG8_STAGE(PG8_SB(0, 1), b2 + hstepB, voffB);
            PG8_WAIT_V(6); PG8_BAR; PG8_MMA(1, 1, At, B1); PG8_BAR;
            PG8_LDB(B0, 1, 0); PG8_SCHED; PG8_LDA(At, 1, 0); PG8_STAGE(PG8_SA(0, 1), a2 + hstep, voffA);
            PG8_WAIT_L(8); PG8_BAR; PG8_WAIT_L(0); PG8_MMA(0, 0, At, B0); PG8_BAR; PG8_SCHED;
            PG8_LDB(B1, 1, 1); PG8_STAGE(PG8_SB(1, 0), b3, voffB);
            PG8_BAR; PG8_WAIT_L(0); PG8_MMA(0, 1, At, B1); PG8_BAR;
            PG8_LDA(At, 1, 1); PG8_STAGE(PG8_SA(1, 0), a3, voffA);
            PG8_BAR; PG8_WAIT_L(0); PG8_MMA(1, 0, At, B0); PG8_BAR; PG8_SCHED;
            PG8_STAGE(PG8_SB(1, 1), b3 + hstepB, voffB);
            PG8_WAIT_V(6); PG8_BAR; PG8_MMA(1, 1, At, B1); PG8_BAR;
            }
        }
        if constexpr (ALIGN_EPI) { if (wr == 0) PG8_BAR; }
        if constexpr (!Epi::AFTER_DRAIN) { E(acc, cur, wr, wc, fr, fq); S.done(cur); }
        if (!has_next) break;
#pragma unroll
        for (int a = 0; a < 2; ++a)
#pragma unroll
            for (int b = 0; b < 2; ++b)
#pragma unroll
                for (int m = 0; m < 4; ++m)
#pragma unroll
                    for (int n = 0; n < 2; ++n) acc[a][b][m][n] = (f32x4){0.f, 0.f, 0.f, 0.f};
        cur = nxt; cA = nA; cB = nB; ++ui;
        if constexpr (ALIGN_EPI) { if (wr == 1) PG8_BAR; }
    }
    PG8_WAIT_V(0);
    if constexpr (!ALIGN_EPI) { if (wr == 0) PG8_BAR; }
    PG8_BAR;
    if constexpr (Epi::AFTER_DRAIN) { E.fused(acc, cur, wr, wc, fr, fq, lds, wid, lane); S.done(cur); }
#undef PG8_SA
#undef PG8_SB
#undef PG8_STAGE
#undef PG8_LDA
#undef PG8_LDB
#undef PG8_MMA
#undef PG8_WAIT_V
#undef PG8_WAIT_L
#undef PG8_BAR
#undef PG8_SCHED
}
}
namespace cg = cooperative_groups;
#define LAS __attribute__((address_space(3)))
using pg8::bf16_t; using pg8::bf16x8; using pg8::f32x4; using pg8::u32x4; using pg8::f32x2; using pg8::u32x2; using pg8::pk2; using pg8::fast_sigmoid;

constexpr int M = 65536, T = 4096, D = 1024, FF = 2816, ZC = 2816, QKVC = 1536, LOC = 1536, LAC = 256;
constexpr size_t MiB = (size_t)1 << 20;
constexpr size_t WS_SS = 1 * MiB;
constexpr size_t WS_LB = 5 * MiB;
constexpr size_t WS_RKB = 6 * MiB;
constexpr size_t WS_ROPE = 8 * MiB;
constexpr size_t WS_W = 24 * MiB;
constexpr size_t FFN_STRIDE = 16 * MiB + MiB / 2, WD_OFF = 11 * MiB;
constexpr size_t WS_WMIX = WS_W + 8 * FFN_STRIDE;
constexpr size_t EVEN_STRIDE = 8 * MiB + MiB / 4, WOUT_OFF = 5 * MiB + MiB / 2, WLORA_OFF = 7 * MiB + MiB / 2;
constexpr size_t WS_WODD = WS_WMIX + 2 * EVEN_STRIDE, ODD_STRIDE = 5 * MiB, WO_OFF = 3 * MiB;
constexpr size_t WS_XB = 184 * MiB;
constexpr size_t OUT_XL = 0, OUT_LA = 128 * MiB, OUT_YRAW = 160 * MiB;
constexpr size_t WS_HZ = 312 * MiB;
constexpr size_t WS_Y = 664 * MiB;
constexpr size_t WS_LO = 792 * MiB;
constexpr size_t WS_END = 984 * MiB;
static_assert(WS_WODD + 2 * ODD_STRIDE <= WS_XB, "ws map");
constexpr int LDS_BYTES = 147456;

struct Args {
    const float* x; const int* pos;
    const float *f1n, *f1g, *f1u, *f1d, *mixn, *f2n, *f2g, *f2u, *f2d;
    const float *win, *mu, *w0, *wdec, *a0, *waaa, *wgate, *kk, *ka, *rk, *gng, *gnb, *lng, *lnb, *wsp, *bsp, *wout;
    const float *wqkv, *bqkv, *qn, *kn, *sinks, *wo, *bo;
    float* out; unsigned char* ws;
    float inv_freq[32];
    int ph_lo, ph_hi;
};

#define KAS __attribute__((address_space(4)))
__device__ __forceinline__ const KAS Args* kargs(int off) { return (const KAS Args*)((const KAS char*)__builtin_amdgcn_kernarg_segment_ptr() + off); }
__device__ __forceinline__ float bf2f(unsigned short h) { return __uint_as_float((unsigned)h << 16); }
__device__ __forceinline__ float bflo(unsigned w) { return __uint_as_float(w << 16); }
__device__ __forceinline__ float bfhi(unsigned w) { return __uint_as_float(w & 0xffff0000u); }
__device__ __forceinline__ void unpack8(const u32x4 w, float (&f)[8]) { f[0] = bflo(w.x); f[1] = bfhi(w.x); f[2] = bflo(w.y); f[3] = bfhi(w.y); f[4] = bflo(w.z); f[5] = bfhi(w.z); f[6] = bflo(w.w); f[7] = bfhi(w.w); }
__device__ __forceinline__ u32x4 pack8(const float (&f)[8]) { return (u32x4){pk2(f[0], f[1]), pk2(f[2], f[3]), pk2(f[4], f[5]), pk2(f[6], f[7])}; }
__device__ __forceinline__ float wave_sum(float v) {
#pragma unroll
    for (int o = 1; o < 64; o <<= 1) v += __shfl_xor(v, o);
    return v;
}
template <int CTRL> __device__ __forceinline__ float dpp_mov(float x) { return __int_as_float(__builtin_amdgcn_update_dpp(0, __float_as_int(x), CTRL, 0xF, 0xF, false)); }
__device__ __forceinline__ float row16_sum(float x) { x += dpp_mov<0xB1>(x); x += dpp_mov<0x4E>(x); x += dpp_mov<0x124>(x); x += dpp_mov<0x128>(x); return x; }
__device__ __forceinline__ float row16_max(float x) { x = fmaxf(x, dpp_mov<0xB1>(x)); x = fmaxf(x, dpp_mov<0x4E>(x)); x = fmaxf(x, dpp_mov<0x124>(x)); x = fmaxf(x, dpp_mov<0x128>(x)); return x; }
__device__ __forceinline__ float wave_sum_dpp(float x) { x = row16_sum(x);
    return __int_as_float(__builtin_amdgcn_readlane(__float_as_int(x), 0)) + __int_as_float(__builtin_amdgcn_readlane(__float_as_int(x), 16)) + (__int_as_float(__builtin_amdgcn_readlane(__float_as_int(x), 32)) + __int_as_float(__builtin_amdgcn_readlane(__float_as_int(x), 48))); }
#define LDS_FENCE() asm volatile("s_waitcnt lgkmcnt(0)" ::: "memory")

__device__ __forceinline__ void tr_item(const float* W, int N, const float* gk, bf16_t* WT, int ldk, int drow, int k0, int n0, LAS float* scr, int lane) {
    f32x4 v[8];
#pragma unroll
    for (int i = 0; i < 8; ++i) { const int kk = 8 * i + (lane >> 3); v[i] = *(const f32x4*)(W + (size_t)(k0 + kk) * N + n0 + 4 * (lane & 7)); }
#pragma unroll
    for (int i = 0; i < 8; ++i) { const int kk = 8 * i + (lane >> 3); const float g = gk ? gk[k0 + kk] : 1.0f; *(LAS f32x4*)(scr + kk * 36 + 4 * (lane & 7)) = v[i] * g; }
    LDS_FENCE();
    const int c = lane & 7;
#pragma unroll
    for (int j = 0; j < 4; ++j) { const int n = (lane >> 3) + 8 * j; const LAS float* s = scr + (8 * c) * 36 + n;
        u32x4 o; o.x = pk2(s[0 * 36], s[1 * 36]); o.y = pk2(s[2 * 36], s[3 * 36]); o.z = pk2(s[4 * 36], s[5 * 36]); o.w = pk2(s[6 * 36], s[7 * 36]);
        *(u32x4*)(WT + (size_t)(drow + n) * ldk + k0 + 8 * c) = o; }
    LDS_FENCE();
}
__device__ __forceinline__ void prologue(const KAS Args& a, LAS unsigned char* lds, const int tid_, const int bid, const int nblk) {
    unsigned char* ws = a.ws;
    const int tid = tid_, lane = tid & 63, wave = tid >> 6;
    LAS float* scr = (LAS float*)(lds + wave * 16384);
    const int gw = bid * 8 + wave, NGW = nblk * 8;
    const int gt = bid * 512 + tid, NGT = nblk * 512;
    constexpr int I_GU = 16 * 88, I_DN = 44 * 32, I_FFN = 2 * I_GU + I_DN, N_FFN = 8 * I_FFN;
    constexpr int I_IN = 16 * 88, I_OUT = 16 * 32, I_QKV = 16 * 48, I_O = 16 * 32, I_MIX = I_IN + I_OUT + I_QKV + I_O;
    for (int it = gw; it < N_FFN + 2 * I_MIX; it += NGW) {
        if (it < N_FFN) {
            const int f = it / I_FFN, r = it % I_FFN, l = f >> 1, second = f & 1;
            bf16_t* wgu = (bf16_t*)(ws + WS_W + (size_t)f * FFN_STRIDE); bf16_t* wd = (bf16_t*)(ws + WS_W + (size_t)f * FFN_STRIDE + WD_OFF);
            if (r < 2 * I_GU) { const int part = r / I_GU, loc = r % I_GU, kb = loc / 88, nb = loc % 88, n0 = 32 * nb;
                const float* src = (part == 0 ? (second ? a.f2g : a.f1g) : (second ? a.f2u : a.f1u)) + (size_t)l * D * FF;
                const float* gk = (second ? a.f2n : a.f1n) + l * D;
                tr_item(src, FF, gk, wgu, D, (n0 >> 7) * 256 + (n0 & 127) + part * 128, 64 * kb, n0, scr, lane);
            } else { const int loc = r - 2 * I_GU, kb = loc / 32, nb = loc % 32;
                const float* src = (second ? a.f2d : a.f1d) + (size_t)l * FF * D;
                tr_item(src, D, nullptr, wd, FF, 32 * nb, 64 * kb, 32 * nb, scr, lane); }
        } else {
            const int r = it - N_FFN, i = r / I_MIX, q = r % I_MIX;
            if (q < I_IN) { const int kb = q / 88, nb = q % 88;
                tr_item(a.win + (size_t)i * D * ZC, ZC, a.mixn + (2 * i) * D, (bf16_t*)(ws + WS_WMIX + i * EVEN_STRIDE), D, 32 * nb, 64 * kb, 32 * nb, scr, lane);
            } else if (q < I_IN + I_OUT) { const int loc = q - I_IN, kb = loc / 32, nb = loc % 32;
                tr_item(a.wout + (size_t)i * D * D, D, nullptr, (bf16_t*)(ws + WS_WMIX + i * EVEN_STRIDE + WOUT_OFF), D, 32 * nb, 64 * kb, 32 * nb, scr, lane);
            } else if (q < I_IN + I_OUT + I_QKV) { const int loc = q - I_IN - I_OUT, kb = loc / 48, nb = loc % 48;
                tr_item(a.wqkv + (size_t)i * D * QKVC, QKVC, a.mixn + (2 * i + 1) * D, (bf16_t*)(ws + WS_WODD + i * ODD_STRIDE), D, 32 * nb, 64 * kb, 32 * nb, scr, lane);
            } else { const int loc = q - I_IN - I_OUT - I_QKV, kb = loc / 32, nb = loc % 32;
                tr_item(a.wo + (size_t)i * D * D, D, nullptr, (bf16_t*)(ws + WS_WODD + i * ODD_STRIDE + WO_OFF), D, 32 * nb, 64 * kb, 32 * nb, scr, lane); }
        }
    }
    for (int idx = gt; idx < 2 * LOC * LAC; idx += NGT) {
        const int i = idx / (LOC * LAC), e = idx % (LOC * LAC), n = e / LAC, k = e % LAC, seg = n >> 9, nn = n & 511;
        float v = 0.f;
        if (seg == 0) { if (k < 64) v = a.wdec[(size_t)i * 64 * 512 + k * 512 + nn]; }
        else if (seg == 1) { if (k >= 64 && k < 128) v = a.waaa[(size_t)i * 64 * 512 + (k - 64) * 512 + nn]; }
        else { if (k >= 128) v = a.wgate[(size_t)i * 128 * 512 + (k - 128) * 512 + nn]; }
        ((bf16_t*)(ws + WS_WMIX + i * EVEN_STRIDE + WLORA_OFF))[e] = (bf16_t)(pk2(v, 0.f) & 0xffffu);
    }
    for (int idx = gt; idx < 2 * LOC; idx += NGT) { const int i = idx / LOC, n = idx % LOC;
        ((float*)(ws + WS_LB))[idx] = (n < 512) ? a.w0[i * 512 + n] : (n < 1024 ? a.a0[i * 512 + n - 512] : 0.f); }
    { bf16_t* xb = (bf16_t*)(ws + WS_XB); bf16_t* xl = (bf16_t*)((unsigned char*)a.out + OUT_XL); float* ss0 = (float*)(ws + WS_SS);
      for (int mb = gw; mb < M; mb += 2 * NGW) { f32x4 v[2][4]; const int m1 = (mb + NGW < M) ? mb + NGW : mb;
#pragma unroll
          for (int j = 0; j < 4; ++j) { v[0][j] = ((const f32x4*)(a.x + (size_t)mb * D) + lane)[64 * j]; v[1][j] = ((const f32x4*)(a.x + (size_t)m1 * D) + lane)[64 * j]; }
#pragma unroll
          for (int k = 0; k < 2; ++k) { const int m = k ? m1 : mb; if (k && m1 == mb) break; float s = 0.f;
#pragma unroll
              for (int j = 0; j < 4; ++j) { const f32x4 w = v[k][j]; s += (w[0] * w[0] + w[1] * w[1]) + (w[2] * w[2] + w[3] * w[3]);
                  const unsigned h01 = pk2(w[0], w[1]), h23 = pk2(w[2], w[3]);
                  const unsigned l01 = pk2(w[0] - bflo(h01), w[1] - bfhi(h01)), l23 = pk2(w[2] - bflo(h23), w[3] - bfhi(h23));
                  *(u32x2*)(xb + (size_t)m * D + 4 * (lane + 64 * j)) = (u32x2){h01, h23}; *(u32x2*)(xl + (size_t)m * D + 4 * (lane + 64 * j)) = (u32x2){l01, l23}; }
              s = wave_sum(s); if (lane < 16) ss0[(size_t)m * 16 + lane] = (lane == 0) ? s : 0.f; } } }
    { float* tab = (float*)(ws + WS_ROPE);
      for (int idx = gt; idx < M * 32; idx += NGT) { const int m = idx >> 5, d = idx & 31; const float ang = (float)a.pos[m] * a.inv_freq[d];
          const double rev = (double)ang * 0.15915494309189535; const float fr = (float)(rev - __builtin_rint(rev));
          tab[(size_t)m * 64 + d] = __builtin_amdgcn_cosf(fr); tab[(size_t)m * 64 + 32 + d] = __builtin_amdgcn_sinf(fr); } }
}

__device__ __forceinline__ void el_phase(const KAS Args& a, int i, const int tid_, const int bid, const int nblk) {
    const bf16_t* Z = (const bf16_t*)(a.ws + WS_HZ); bf16_t* LA = (bf16_t*)((unsigned char*)a.out + OUT_LA);
    const float* mu = a.mu + i * 1792 + 1536;
    const int gt = bid * 512 + tid_, NGT = nblk * 512;
    for (int ib = gt; ib < M * 32; ib += 4 * NGT) { u32x4 rc[4], rp[4];
#pragma unroll
        for (int k = 0; k < 4; ++k) { const int idx = ib + k * NGT; const int ii = idx < M * 32 ? idx : ib; const int m = ii >> 5, c0 = (ii & 31) * 8, t = m & (T - 1);
            rc[k] = *(const u32x4*)(Z + (size_t)m * ZC + 1536 + c0); rp[k] = (t > 0) ? *(const u32x4*)(Z + (size_t)(m - 1) * ZC + 1536 + c0) : (u32x4){0u, 0u, 0u, 0u}; }
#pragma unroll
        for (int k = 0; k < 4; ++k) { const int idx = ib + k * NGT; if (idx >= M * 32) break; const int m = idx >> 5, c0 = (idx & 31) * 8;
            float zc[8], zp[8], o[8]; unpack8(rc[k], zc); unpack8(rp[k], zp);
#pragma unroll
            for (int e = 0; e < 8; ++e) { const float z = zc[e] + (zp[e] - zc[e]) * mu[c0 + e];
                o[e] = (c0 < 64) ? (2.0f * fast_sigmoid(2.0f * z) - 1.0f) : (c0 < 128 ? z : fast_sigmoid(z)); }
            *(u32x4*)(LA + (size_t)m * LAC + c0) = pack8(o); } }
}

constexpr int TC = 32, SST = 352;
__device__ __forceinline__ void scan_load(const bf16_t* Z, const bf16_t* LO, size_t mrow0, int t0, int tid, int colb, u32x2 (&pz)[8]) {
    const int t = t0 + (tid >> 4); const size_t m = mrow0 + t; const bf16_t* zr = Z + m * ZC + colb; const bf16_t* lo = LO + m * LOC + colb;
    pz[0] = *(const u32x2*)(zr); pz[1] = *(const u32x2*)(zr + 512); pz[2] = *(const u32x2*)(zr + 1024);
    if (t > 0) { pz[3] = *(const u32x2*)(zr - ZC); pz[4] = *(const u32x2*)(zr + 512 - ZC); pz[5] = *(const u32x2*)(zr + 1024 - ZC); } else { pz[3] = (u32x2){0u, 0u}; pz[4] = (u32x2){0u, 0u}; pz[5] = (u32x2){0u, 0u}; }
    pz[6] = *(const u32x2*)(lo); pz[7] = *(const u32x2*)(lo + 512);
}
__device__ __forceinline__ void up4(const u32x2 w, float (&f)[4]) { f[0] = bflo(w.x); f[1] = bfhi(w.x); f[2] = bflo(w.y); f[3] = bfhi(w.y); }
__device__ __forceinline__ void scan_stage(const u32x2 (&pz)[8], LAS float* buf, float* RKB, size_t mrow0, int t0, int tid, int h, int half,
                                           const float (&mu_r)[4], const float (&mu_k)[4], const float (&mu_v)[4], const float (&kkc)[4], const float (&kac)[4], const float (&rkc)[4]) {
    const int tl = tid >> 4, cgp = tid & 15;
    float zr[4], zk[4], zv[4], zrp[4], zkp[4], zvp[4], ew[4], ic[4];
    up4(pz[0], zr); up4(pz[1], zk); up4(pz[2], zv); up4(pz[3], zrp); up4(pz[4], zkp); up4(pz[5], zvp); up4(pz[6], ew); up4(pz[7], ic);
    f32x4 r, k2, v, kkv, w; float n2 = 0.f, rkb = 0.f;
#pragma unroll
    for (int e = 0; e < 4; ++e) { r[e] = zr[e] + (zrp[e] - zr[e]) * mu_r[e]; const float k = zk[e] + (zkp[e] - zk[e]) * mu_k[e]; v[e] = zv[e] + (zvp[e] - zv[e]) * mu_v[e];
        kkv[e] = k * kkc[e]; n2 += kkv[e] * kkv[e]; k2[e] = k * (1.0f + (ic[e] - 1.0f) * kac[e]); w[e] = __builtin_amdgcn_exp2f(-1.4426950408889634f * ew[e]); rkb += r[e] * k2[e] * rkc[e]; }
    n2 = row16_sum(n2); rkb = row16_sum(rkb);
    const float inv = __builtin_amdgcn_rsqf(fmaxf(n2, 1e-24f));
    const f32x4 kkn = kkv * inv; f32x4 nb;
#pragma unroll
    for (int e = 0; e < 4; ++e) nb[e] = -kkn[e] * ic[e];
    if (half == 0 && cgp == 0) RKB[(mrow0 + t0 + tl) * 8 + h] = rkb;
    LAS float* sb = buf + tl * SST + 4 * cgp;
    *(LAS f32x4*)(sb) = kkn; *(LAS f32x4*)(sb + 64) = nb; *(LAS f32x4*)(sb + 128) = w; *(LAS f32x4*)(sb + 192) = k2; *(LAS f32x4*)(sb + 256) = r;
    if ((cgp >> 3) == half) *(LAS f32x4*)(buf + tl * SST + 320 + 4 * (cgp & 7)) = v;
}
__device__ __forceinline__ void scan_phase(const KAS Args& a, LAS unsigned char* lds, int i, const int tid_, const int bid, const int nblk) {
    const int tid = tid_, lane = tid & 63, wave = __builtin_amdgcn_readfirstlane(tid >> 6);
    const bf16_t* Z = (const bf16_t*)(a.ws + WS_HZ); const bf16_t* LO = (const bf16_t*)(a.ws + WS_LO);
    bf16_t* YR = (bf16_t*)((unsigned char*)a.out + OUT_YRAW); float* RKB = (float*)(a.ws + WS_RKB);
    LAS float* bufs = (LAS float*)lds; LAS float* ybuf = bufs + 2 * TC * SST;
    for (int unit = bid; unit < 256; unit += nblk) {
        const int bh = unit >> 1, half = unit & 1, b = bh >> 3, h = bh & 7, colb = h * 64 + 4 * (tid & 15);
        float mu_r[4], mu_k[4], mu_v[4], kkc[4], kac[4], rkc[4];
#pragma unroll
        for (int e = 0; e < 4; ++e) { mu_r[e] = a.mu[i * 1792 + colb + e]; mu_k[e] = a.mu[i * 1792 + 512 + colb + e]; mu_v[e] = a.mu[i * 1792 + 1024 + colb + e];
            kkc[e] = a.kk[i * 512 + colb + e]; kac[e] = a.ka[i * 512 + colb + e]; rkc[e] = a.rk[i * 512 + colb + e]; }
        const size_t mrow0 = (size_t)b * T;
        const int rl = wave * 4 + (lane >> 4), cgp = lane & 15;
        f32x4 S = {0.f, 0.f, 0.f, 0.f};
        u32x2 pz[8];
        __syncthreads();
        scan_load(Z, LO, mrow0, 0, tid, colb, pz);
        scan_stage(pz, bufs, RKB, mrow0, 0, tid, h, half, mu_r, mu_k, mu_v, kkc, kac, rkc);
        __syncthreads();
        for (int c = 0; c < T / TC; ++c) {
            const bool more = (c + 1 < T / TC);
            if (more) scan_load(Z, LO, mrow0, (c + 1) * TC, tid, colb, pz);
            const LAS float* buf = bufs + (c & 1) * (TC * SST); LAS float* yb = ybuf + (c & 1) * (TC * 32);
            {
                const LAS float* sb = buf + 4 * cgp; const LAS float* vb = buf + 320 + rl;
                f32x4 kk4 = *(const LAS f32x4*)(sb), nb4 = *(const LAS f32x4*)(sb + 64), w4 = *(const LAS f32x4*)(sb + 128), k4 = *(const LAS f32x4*)(sb + 192), r4 = *(const LAS f32x4*)(sb + 256);
                float v = vb[0], ysel = 0.f;
#pragma unroll
                for (int t = 0; t < TC; ++t) {
                    f32x4 kk4n = kk4, nb4n = nb4, w4n = w4, k4n = k4, r4n = r4; float vn = v;
                    if (t + 1 < TC) { const LAS float* sn = sb + (t + 1) * SST;
                        kk4n = *(const LAS f32x4*)(sn); nb4n = *(const LAS f32x4*)(sn + 64); w4n = *(const LAS f32x4*)(sn + 128); k4n = *(const LAS f32x4*)(sn + 192); r4n = *(const LAS f32x4*)(sn + 256); vn = vb[(t + 1) * SST]; }
                    __builtin_amdgcn_sched_barrier(0x6);
                    float sa = fmaf(S[3], kk4[3], fmaf(S[2], kk4[2], fmaf(S[1], kk4[1], S[0] * kk4[0])));
                    const f32x4 Tm = S * w4 + k4 * v;
                    sa = row16_sum(sa);
                    S = Tm + nb4 * sa;
                    float y = fmaf(S[3], r4[3], fmaf(S[2], r4[2], fmaf(S[1], r4[1], S[0] * r4[0]))); y = row16_sum(y);
                    ysel = (cgp == (t & 15)) ? y : ysel;
                    if ((t & 15) == 15) yb[(t - 15 + cgp) * 32 + rl] = ysel;
                    kk4 = kk4n; nb4 = nb4n; w4 = w4n; k4 = k4n; r4 = r4n; v = vn; }
            }
            if (more) scan_stage(pz, bufs + ((c + 1) & 1) * (TC * SST), RKB, mrow0, (c + 1) * TC, tid, h, half, mu_r, mu_k, mu_v, kkc, kac, rkc);
            __syncthreads();
#pragma unroll
            for (int q = 0; q < 2; ++q) { const int idx = tid + 512 * q, t = idx >> 5, r = idx & 31;
                YR[(mrow0 + c * TC + t) * 512 + h * 64 + half * 32 + r] = (bf16_t)(pk2(yb[t * 32 + r], 0.f) & 0xffffu); }
        }
    }
}

__device__ __forceinline__ void post_phase(const KAS Args& a, LAS unsigned char* lds, int i, const int tid_, const int bid, const int nblk) {
    const int tid = tid_, lane = tid & 63, wave = __builtin_amdgcn_readfirstlane(tid >> 6);
    const bf16_t* Z = (const bf16_t*)(a.ws + WS_HZ); const bf16_t* LO = (const bf16_t*)(a.ws + WS_LO); const bf16_t* YR = (const bf16_t*)((unsigned char*)a.out + OUT_YRAW);
    const float* RKB = (const float*)(a.ws + WS_RKB); bf16_t* Y = (bf16_t*)(a.ws + WS_Y);
    { const int c0 = 8 * lane; float gg[8], gb[8], muv[8];
#pragma unroll
      for (int e = 0; e < 8; ++e) { gg[e] = a.gng[i * 512 + c0 + e]; gb[e] = a.gnb[i * 512 + c0 + e]; muv[e] = a.mu[i * 1792 + 1024 + c0 + e]; }
      const int stride = nblk * 8;
      for (int mb = bid * 8 + wave; mb < M; mb += 2 * stride) {
          u32x4 ry[2], rvc[2], rvp[2], rg[2]; float bon[2]; bool has[2];
#pragma unroll
          for (int k = 0; k < 2; ++k) { const int m = mb + k * stride; has[k] = (m < M); const int mm = has[k] ? m : mb; const int t = mm & (T - 1);
              ry[k] = *(const u32x4*)(YR + (size_t)mm * 512 + c0); rvc[k] = *(const u32x4*)(Z + (size_t)mm * ZC + 1024 + c0);
              rvp[k] = (t > 0) ? *(const u32x4*)(Z + (size_t)(mm - 1) * ZC + 1024 + c0) : (u32x4){0u, 0u, 0u, 0u};
              rg[k] = *(const u32x4*)(LO + (size_t)mm * LOC + 1024 + c0); bon[k] = RKB[(size_t)mm * 8 + (lane >> 3)]; }
#pragma unroll
          for (int k = 0; k < 2; ++k) { const int m = mb + k * stride;
              float y[8], vc[8], vp[8], g[8], o[8];
              unpack8(ry[k], y); unpack8(rvc[k], vc); unpack8(rvp[k], vp); unpack8(rg[k], g);
              float s = 0.f;
#pragma unroll
              for (int e = 0; e < 8; ++e) s += y[e];
              s += __shfl_xor(s, 1); s += __shfl_xor(s, 2); s += __shfl_xor(s, 4);
              const float mean = s * (1.0f / 64.0f); float q = 0.f;
#pragma unroll
              for (int e = 0; e < 8; ++e) { const float d = y[e] - mean; q += d * d; }
              q += __shfl_xor(q, 1); q += __shfl_xor(q, 2); q += __shfl_xor(q, 4);
              const float rstd = 1.0f / sqrtf(q * (1.0f / 64.0f) + 64e-5f);
#pragma unroll
              for (int e = 0; e < 8; ++e) { const float vs = vc[e] + (vp[e] - vc[e]) * muv[e]; o[e] = ((y[e] - mean) * rstd * gg[e] + gb[e] + bon[k] * vs) * g[e]; }
              if (has[k]) *(u32x4*)(Y + (size_t)m * D + c0) = pack8(o); } } }
    LAS float* stat = (LAS float*)lds;
    LAS bf16_t* Wl = (LAS bf16_t*)(lds + 1024);
    LAS bf16_t* St = (LAS bf16_t*)(lds + 1024 + 128 * 136 * 2);
    const int l15 = lane & 15, l4 = lane >> 4;
    for (int ch = bid; ch < M / 128; ch += nblk) { const size_t m0 = (size_t)ch * 128;
        __syncthreads();
#pragma unroll 1
        for (int tb = 0; tb < 16; tb += 4) { u32x4 raw[4];
#pragma unroll
            for (int k = 0; k < 4; ++k) raw[k] = *(const u32x4*)(Z + (m0 + wave * 16 + tb + k) * ZC + 2304 + 8 * lane);
#pragma unroll
            for (int k = 0; k < 4; ++k) { const int tok = wave * 16 + tb + k; float sv[8]; unpack8(raw[k], sv); float s = 0.f;
#pragma unroll
                for (int e = 0; e < 8; ++e) s += sv[e];
                const float mean = wave_sum(s) * (1.0f / 512.0f); float q = 0.f;
#pragma unroll
                for (int e = 0; e < 8; ++e) { const float d = sv[e] - mean; q += d * d; }
                const float rstd = 1.0f / sqrtf(wave_sum(q) * (1.0f / 512.0f) + 1e-5f);
                if (lane == 0) { stat[2 * tok] = mean; stat[2 * tok + 1] = rstd; } } }
        const int stok = tid >> 2, spart = tid & 3, etok = 16 * wave + l15;
        u32x4 raw[4]; f32x4 wr0[4], wr1[4];
#define GM_LOAD(G) do { const float* wsrc_ = a.wsp + ((size_t)(i * 4 + (G)) * 128 + stok) * 128 + 32 * spart; _Pragma("unroll") for (int q = 0; q < 4; ++q) { \
        raw[q] = *(const u32x4*)(Z + (m0 + stok) * ZC + 2304 + (G) * 128 + 32 * spart + 8 * q); wr0[q] = *(const f32x4*)(wsrc_ + 8 * q); wr1[q] = *(const f32x4*)(wsrc_ + 8 * q + 4); } } while (0)
        GM_LOAD(0);
#pragma unroll 1
        for (int g = 0; g < 4; ++g) {
            __syncthreads();
            { const float mean = stat[2 * stok], rstd = stat[2 * stok + 1];
#pragma unroll
              for (int q = 0; q < 4; ++q) { float sv[8], wv[8]; const int d0 = 32 * spart + 8 * q;
                  unpack8(raw[q], sv);
#pragma unroll
                  for (int e = 0; e < 8; ++e) { const int dd = g * 128 + d0 + e; const float sn = (sv[e] - mean) * rstd * a.lng[i * 512 + dd] + a.lnb[i * 512 + dd];
                      St[(d0 + e) * 136 + stok] = (bf16_t)(pk2(sn, 0.f) & 0xffffu); }
#pragma unroll
                  for (int e = 0; e < 4; ++e) { wv[e] = (d0 + e <= stok) ? wr0[q][e] : 0.f; wv[4 + e] = (d0 + 4 + e <= stok) ? wr1[q][e] : 0.f; }
                  *(LAS u32x4*)(Wl + stok * 136 + d0) = pack8(wv); } }
            if (g < 3) GM_LOAD(g + 1);
            u32x2 uz[8];
#pragma unroll
            for (int dt = 0; dt < 8; ++dt) uz[dt] = *(const u32x2*)(Z + (m0 + etok) * ZC + 1792 + g * 128 + 16 * dt + 4 * l4);
            const float bs = a.bsp[(i * 4 + g) * 128 + etok];
            __syncthreads();
            f32x4 acc[8];
#pragma unroll
            for (int dt = 0; dt < 8; ++dt) acc[dt] = (f32x4){0.f, 0.f, 0.f, 0.f};
#pragma unroll
            for (int ks = 0; ks < 4; ++ks) { const bf16x8 wf = *(const LAS bf16x8*)(Wl + (16 * wave + l15) * 136 + 32 * ks + 8 * l4);
#pragma unroll
                for (int dt = 0; dt < 8; ++dt) { const bf16x8 sf = *(const LAS bf16x8*)(St + (16 * dt + l15) * 136 + 32 * ks + 8 * l4);
                    acc[dt] = __builtin_amdgcn_mfma_f32_16x16x32_bf16(sf, wf, acc[dt], 0, 0, 0); } }
#pragma unroll
            for (int dt = 0; dt < 8; ++dt) { const f32x2 u0 = {bflo(uz[dt].x), bfhi(uz[dt].x)}, u1 = {bflo(uz[dt].y), bfhi(uz[dt].y)};
                *(u32x2*)(Y + (m0 + etok) * D + 512 + g * 128 + 16 * dt + 4 * l4) = (u32x2){pk2(u0.x * (acc[dt][0] + bs), u0.y * (acc[dt][1] + bs)), pk2(u1.x * (acc[dt][2] + bs), u1.y * (acc[dt][3] + bs))}; }
        }
#undef GM_LOAD
    }
}

__device__ __forceinline__ void attn_phase(const KAS Args& a, LAS unsigned char* lds, int i, const int tid_, const int bid, const int nblk) {
    const int tid = tid_, lane = tid & 63, wave = __builtin_amdgcn_readfirstlane(tid >> 6);
    const int l15 = lane & 15, l4 = lane >> 4;
    const bf16_t* QKV = (const bf16_t*)(a.ws + WS_HZ); bf16_t* Y = (bf16_t*)(a.ws + WS_Y); const float* tab = (const float*)(a.ws + WS_ROPE);
    LAS bf16_t* Ks = (LAS bf16_t*)lds;
    LAS bf16_t* Vt = (LAS bf16_t*)(lds + 36864);
    LAS bf16_t* Pb = (LAS bf16_t*)(lds + 36864 + 33792) + wave * (16 * 168);
    const float* qn = a.qn + i * 64; const float* kn = a.kn + i * 64;
    for (int unit = bid; unit < 16 * 4 * 32; unit += nblk) {
        const int b = unit >> 7, kvh = (unit >> 5) & 3, n = unit & 31;
        const size_t m0 = (size_t)b * T + n * 128;
        __syncthreads();
        { const int key = tid >> 1, hh = tid & 1; const bool valid = (n > 0) || (key >= 128); const size_t mk = m0 + key - 128;
          u32x4 k0v = {0u, 0u, 0u, 0u}, k1v = k0v, k2v = k0v, k3v = k0v;
          if (valid) { const bf16_t* kp = QKV + mk * QKVC + 1024 + kvh * 64 + 16 * hh; k0v = *(const u32x4*)(kp); k1v = *(const u32x4*)(kp + 8); k2v = *(const u32x4*)(kp + 32); k3v = *(const u32x4*)(kp + 40); }
          LAS bf16_t* kd = Ks + key * 72 + 16 * hh;
          *(LAS u32x4*)(kd) = k0v; *(LAS u32x4*)(kd + 8) = k1v; *(LAS u32x4*)(kd + 32) = k2v; *(LAS u32x4*)(kd + 40) = k3v;
        }
        { const int kp = (wave & 1) * 64 + lane, dq = wave >> 1; const bool valid = (n > 0) || (kp >= 64); const size_t mk = m0 + 2 * kp - 128;
          u32x4 va0 = {0u, 0u, 0u, 0u}, va1 = va0, vb0 = va0, vb1 = va0;
          if (valid) { const bf16_t* vp = QKV + mk * QKVC + 1280 + kvh * 64 + 16 * dq; va0 = *(const u32x4*)(vp); va1 = *(const u32x4*)(vp + 8); vb0 = *(const u32x4*)(vp + QKVC); vb1 = *(const u32x4*)(vp + QKVC + 8); }
          LAS unsigned* vt32 = (LAS unsigned*)Vt;
#define VT_ST(dd, A, B) vt32[((16 * dq + (dd)) * 264 + 2 * kp) >> 1] = ((A) & 0xffffu) | ((B) << 16); vt32[((16 * dq + (dd) + 1) * 264 + 2 * kp) >> 1] = ((A) >> 16) | ((B) & 0xffff0000u)
          VT_ST(0, va0.x, vb0.x); VT_ST(2, va0.y, vb0.y); VT_ST(4, va0.z, vb0.z); VT_ST(6, va0.w, vb0.w);
          VT_ST(8, va1.x, vb1.x); VT_ST(10, va1.y, vb1.y); VT_ST(12, va1.z, vb1.z); VT_ST(14, va1.w, vb1.w);
#undef VT_ST
        }
        __syncthreads();
        const int g = wave >> 1, qh = kvh * 4 + g; const float sink = a.sinks[i * 16 + qh];
#pragma unroll 1
        for (int pass = 0; pass < 2; ++pass) { const int i0 = (wave & 1) * 64 + pass * 32;
            bf16x8 qf[2][2];
#pragma unroll
            for (int rt = 0; rt < 2; ++rt) { const size_t mq = m0 + i0 + 16 * rt + l15; const bf16_t* qp = QKV + mq * QKVC + qh * 64 + 8 * l4;
                qf[rt][0] = *(const bf16x8*)(qp); qf[rt][1] = *(const bf16x8*)(qp + 32); }
            f32x4 sc[2][10];
#pragma unroll
            for (int rt = 0; rt < 2; ++rt)
#pragma unroll
                for (int kt = 0; kt < 10; ++kt) sc[rt][kt] = (f32x4){0.f, 0.f, 0.f, 0.f};
#pragma unroll
            for (int kt = 0; kt < 10; ++kt)
#pragma unroll
                for (int ks = 0; ks < 2; ++ks) { const bf16x8 kf = *(const LAS bf16x8*)(Ks + (i0 + 16 * kt + l15) * 72 + 32 * ks + 8 * l4);
#pragma unroll
                    for (int rt = 0; rt < 2; ++rt) if (kt - rt >= 0 && kt - rt <= 8) sc[rt][kt] = __builtin_amdgcn_mfma_f32_16x16x32_bf16(kf, qf[rt][ks], sc[rt][kt], 0, 0, 0); }
#pragma unroll
            for (int rt = 0; rt < 2; ++rt) {
                float mx = -INFINITY;
#pragma unroll
                for (int kt = 0; kt < 10; ++kt) { const int dk = kt - rt;
                    if (dk < 0 || dk > 8) continue;
#pragma unroll
                    for (int reg = 0; reg < 4; ++reg) { float sv = sc[rt][kt][reg];
                        if (dk == 0) sv = (4 * l4 + reg > l15) ? sv : -INFINITY;
                        if (dk == 8) sv = (4 * l4 + reg <= l15) ? sv : -INFINITY;
                        if (n == 0) sv = (i0 + 16 * kt + 4 * l4 + reg >= 128) ? sv : -INFINITY;
                        sc[rt][kt][reg] = sv; mx = fmaxf(mx, sv); } }
                mx = fmaxf(mx, __shfl_xor(mx, 16)); mx = fmaxf(mx, __shfl_xor(mx, 32)); mx = fmaxf(mx, sink);
                const float mneg = -mx * 1.4426950408889634f; float sum = 0.f;
#pragma unroll
                for (int kt = 0; kt < 10; ++kt) { const int dk = kt - rt;
                    if (dk < 0 || dk > 8) { sc[rt][kt] = (f32x4){0.f, 0.f, 0.f, 0.f}; continue; }
#pragma unroll
                    for (int reg = 0; reg < 4; ++reg) { const float p = __builtin_amdgcn_exp2f(fmaf(sc[rt][kt][reg], 1.4426950408889634f, mneg)); sc[rt][kt][reg] = p; sum += p; } }
                sum += __shfl_xor(sum, 16); sum += __shfl_xor(sum, 32);
                sum += __builtin_amdgcn_exp2f(fmaf(sink, 1.4426950408889634f, mneg));
                const float rden = __builtin_amdgcn_rcpf(sum);
                f32x4 o[4];
#pragma unroll
                for (int dt = 0; dt < 4; ++dt) o[dt] = (f32x4){0.f, 0.f, 0.f, 0.f};
#pragma unroll
                for (int ks = 0; ks < 5; ++ks) { const f32x4 pa = sc[rt][2 * ks], pb = sc[rt][2 * ks + 1];
                    const bf16x8 pf = __builtin_bit_cast(bf16x8, (u32x4){pk2(pa[0], pa[1]), pk2(pa[2], pa[3]), pk2(pb[0], pb[1]), pk2(pb[2], pb[3])});
#pragma unroll
                    for (int dt = 0; dt < 4; ++dt) { const LAS bf16_t* vp = Vt + (16 * dt + l15) * 264 + i0 + 32 * ks + 4 * l4;
                        const u32x2 v0 = *(const LAS u32x2*)(vp), v1 = *(const LAS u32x2*)(vp + 16);
                        const bf16x8 vf = __builtin_bit_cast(bf16x8, (u32x4){v0.x, v0.y, v1.x, v1.y});
                        o[dt] = __builtin_amdgcn_mfma_f32_16x16x32_bf16(vf, pf, o[dt], 0, 0, 0); } }
                { const size_t mq = m0 + i0 + 16 * rt + l15;
#pragma unroll
                  for (int dt = 0; dt < 4; ++dt) *(u32x2*)(Y + mq * D + qh * 64 + 16 * dt + 4 * l4) = (u32x2){pk2(o[dt][0] * rden, o[dt][1] * rden), pk2(o[dt][2] * rden, o[dt][3] * rden)}; }
            }
        }
    }
}

#define XB_TMO      128
#define XB_XCNT(j)  (256  + 64 * (j))
#define XB_XSUB(j)  (1280 + 64 * (j))
#define XB_XGEN(j)  (2304 + 64 * (j))
#define XB_TOP      3328
#define XB_TOPGEN   3392
#define XCD_BAR_WORDS 3456
#define XB_SPIN_CAP (1u << 18)

__device__ __forceinline__ unsigned xb_ld(unsigned* p)              { return __hip_atomic_load(p, __ATOMIC_RELAXED, __HIP_MEMORY_SCOPE_AGENT); }
__device__ __forceinline__ unsigned xb_add(unsigned* p, unsigned v) { return __hip_atomic_fetch_add(p, v, __ATOMIC_RELAXED, __HIP_MEMORY_SCOPE_AGENT); }
__device__ __forceinline__ unsigned xb_xcc_id() { return (unsigned)__builtin_amdgcn_s_getreg((3 << 11) | 20) & 0xFu; }
#define XB_SPIN(cond, bar) do { unsigned _sp = 0; while (cond) { __builtin_amdgcn_s_sleep(1); \
    if ((++_sp & 255u) == 0u) { if (xb_ld(&(bar)[XB_TMO])) break; if (_sp > XB_SPIN_CAP) { atomicAdd(&(bar)[XB_TMO], 1u); break; } } } } while (0)

struct XcdBarrier {
    unsigned* bar; unsigned x;
    volatile LAS unsigned* st;
};

__device__ __forceinline__ XcdBarrier xcd_barrier_post(unsigned* bar, volatile LAS unsigned* st) {
    XcdBarrier b; b.bar = bar; b.x = xb_xcc_id(); b.st = st;
    if (threadIdx.x == 0) (void)xb_add(&bar[XB_XCNT(b.x)], 1u);
    return b;
}
__device__ __forceinline__ void xcd_barrier_complete(unsigned* bar, unsigned x, unsigned& nloc, unsigned& nx) {
    const unsigned G = gridDim.x * gridDim.y * gridDim.z;
    unsigned sum, cnt, mine, sp = 0u;
    for (;;) {
        sum = 0u; cnt = 0u; mine = 0u;
#pragma unroll
        for (unsigned j = 0; j < 16; ++j) { const unsigned c = xb_ld(&bar[XB_XCNT(j)]); sum += c; cnt += (c > 0u) ? 1u : 0u; mine = (j == x) ? c : mine; }
        if (sum == G) break;
        __builtin_amdgcn_s_sleep(1);
        if ((++sp & 255u) == 0u) { if (xb_ld(&bar[XB_TMO])) break; if (sp > XB_SPIN_CAP) { atomicAdd(&bar[XB_TMO], 1u); break; } }
    }
    nloc = mine > 0u ? mine : 1u; nx = cnt > 0u ? cnt : 1u;
}

__device__ __forceinline__ void xcd_barrier(const XcdBarrier& b) {
    asm volatile("s_waitcnt vmcnt(0)" ::: "memory");
    __syncthreads();
    if (threadIdx.x == 0) {
        unsigned* bar = b.bar;
        __builtin_amdgcn_s_waitcnt(0);
        unsigned nloc = b.st[0], nx = b.st[1];
        if (nloc == 0u) { xcd_barrier_complete(bar, b.x, nloc, nx); b.st[0] = nloc; b.st[1] = nx; }
        const unsigned old = xb_add(&bar[XB_XSUB(b.x)], 1u);
        const unsigned gen = old / nloc;
        if (old + 1u == (gen + 1u) * nloc) {
            __builtin_amdgcn_fence(__ATOMIC_RELEASE, "agent");
            asm volatile("s_waitcnt vmcnt(0)" ::: "memory");
            const unsigned og = xb_add(&bar[XB_TOP], 1u);
            const unsigned tg = og / nx;
            if (og + 1u == (tg + 1u) * nx) xb_add(&bar[XB_TOPGEN], 1u);
            else XB_SPIN(xb_ld(&bar[XB_TOPGEN]) == tg, bar);
            __builtin_amdgcn_fence(__ATOMIC_ACQUIRE, "agent");
            xb_add(&bar[XB_XGEN(b.x)], 1u);
            asm volatile("s_waitcnt vmcnt(0)" ::: "memory");
        } else {
            XB_SPIN(xb_ld(&bar[XB_XGEN(b.x)]) == gen, bar);
            __builtin_amdgcn_fence(__ATOMIC_ACQUIRE, "agent");
            asm volatile("s_waitcnt vmcnt(0)" ::: "memory");
        }
    }
    __syncthreads();
}
#ifndef PROBE_KIND
#define PROBE_KIND -1
#endif
#if PROBE_KIND == 6
constexpr int NE = 11, NO = 7; __device__ const signed char EVEN_K[NE] = {1, 2, 3, 4, 5, 6, 6, 7, 8, 1, 2}, EVEN_S[NE] = {0, 0, 0, 0, 0, 0, 0, 0, 0, 1, 1}, ODD_K[NO] = {1, 2, 3, 9, 8, 1, 2}, ODD_S[NO] = {0, 0, 0, 0, 0, 1, 1};
#elif PROBE_KIND == 7
constexpr int NE = 11, NO = 7; __device__ const signed char EVEN_K[NE] = {1, 2, 3, 4, 5, 6, 7, 7, 8, 1, 2}, EVEN_S[NE] = {0, 0, 0, 0, 0, 0, 0, 0, 0, 1, 1}, ODD_K[NO] = {1, 2, 3, 9, 8, 1, 2}, ODD_S[NO] = {0, 0, 0, 0, 0, 1, 1};
#elif PROBE_KIND == 9
constexpr int NE = 10, NO = 8; __device__ const signed char EVEN_K[NE] = {1, 2, 3, 4, 5, 6, 7, 8, 1, 2}, EVEN_S[NE] = {0, 0, 0, 0, 0, 0, 0, 0, 1, 1}, ODD_K[NO] = {1, 2, 3, 9, 9, 8, 1, 2}, ODD_S[NO] = {0, 0, 0, 0, 0, 0, 1, 1};
#elif PROBE_KIND == 1
constexpr int NE = 12, NO = 9; __device__ const signed char EVEN_K[NE] = {1, 1, 2, 3, 4, 5, 6, 7, 8, 1, 1, 2}, EVEN_S[NE] = {0, 0, 0, 0, 0, 0, 0, 0, 0, 1, 1, 1}, ODD_K[NO] = {1, 1, 2, 3, 9, 8, 1, 1, 2}, ODD_S[NO] = {0, 0, 0, 0, 0, 0, 1, 1, 1};
#elif PROBE_KIND == 3
constexpr int NE = 12, NO = 8; __device__ const signed char EVEN_K[NE] = {1, 2, 3, 3, 4, 5, 5, 6, 7, 8, 1, 2}, EVEN_S[NE] = {0, 0, 0, 0, 0, 0, 0, 0, 0, 0, 1, 1}, ODD_K[NO] = {1, 2, 3, 3, 9, 8, 1, 2}, ODD_S[NO] = {0, 0, 0, 0, 0, 0, 1, 1};
#else
constexpr int NE = 10, NO = 7; __device__ const signed char EVEN_K[NE] = {1, 2, 3, 4, 5, 6, 7, 8, 1, 2}, EVEN_S[NE] = {0, 0, 0, 0, 0, 0, 0, 0, 1, 1}, ODD_K[NO] = {1, 2, 3, 9, 8, 1, 2}, ODD_S[NO] = {0, 0, 0, 0, 0, 1, 1};
#endif
constexpr int N_PHASES = 1 + 2 * (NE + NO);
__global__ void __launch_bounds__(512) mega_fwd(Args a_) {
    extern __shared__ __attribute__((aligned(16))) unsigned char lds_raw[];
    cg::grid_group grid = cg::this_grid();
    const int ph_lo = a_.ph_lo, ph_hi = a_.ph_hi;
    volatile LAS unsigned* MISC = (volatile LAS unsigned*)((LAS unsigned char*)lds_raw + 131072 + 320);
    if (threadIdx.x < 32) MISC[threadIdx.x] = 0u;
    __syncthreads();
    XcdBarrier xbar; xbar.bar = (unsigned*)a_.ws; xbar.x = 0; xbar.st = nullptr;
    for (int ph = ph_lo; ph < ph_hi; ++ph) {
        int koff = 0, bid = blockIdx.x, nblk = gridDim.x, tid_ = threadIdx.x; asm volatile("" : "+s"(koff), "+s"(bid), "+s"(nblk), "+v"(tid_));
        LAS unsigned char* lds = (LAS unsigned char*)lds_raw + koff;
        const KAS Args& a = *kargs(koff);
        unsigned char* ws = a.ws;
        float* ssb = (float*)(ws + WS_SS);
        bf16_t* XB = (bf16_t*)(ws + WS_XB); bf16_t* HZ = (bf16_t*)(ws + WS_HZ); bf16_t* YB = (bf16_t*)(ws + WS_Y);
        int kind = 0, l = 0, second = 0;
        if (ph > 0) { const int p = ph - 1, pair = p / (NE + NO), q = p % (NE + NO);
            if (q < NE) { l = 2 * pair; kind = EVEN_K[q]; second = EVEN_S[q]; }
            else { l = 2 * pair + 1; kind = ODD_K[q - NE]; second = ODD_S[q - NE]; } }
        const int i = l >> 1, odd = l & 1, f = 2 * l + second;
#ifndef PHM
#define PHM 0x3ff
#endif
        if (kind == 0) { if (bid == 0) { for (int k_ = tid_; k_ < 4096; k_ += 512) ((unsigned*)ws)[k_] = 0u; }
                         if (PHM & 1) prologue(a, lds, tid_, bid, nblk); }
        else if (kind == 1 && (PHM & 2)) {
            pg8::Gemm g{XB, (const bf16_t*)(ws + WS_W + (size_t)f * FFN_STRIDE), M, 2 * FF, D}; pg8::StaticOrder S; S.init(M, 2 * FF, nblk, bid);
            pg8::EpiSwiglu E{HZ, FF, ssb};
            pg8::gemm_phase<pg8::EpiSwiglu, pg8::StaticOrder, true, true>(lds, g, S, E, tid_);
        } else if ((kind == 2 || kind == 8) && (PHM & 4)) {
            pg8::Gemm g; const float* bias = nullptr; float scale = 1.0f; float* ssn;
            if (kind == 2) { g = pg8::Gemm{HZ, (const bf16_t*)(ws + WS_W + (size_t)f * FFN_STRIDE + WD_OFF), M, D, FF}; scale = 0.5f; ssn = ssb; }
            else { g = pg8::Gemm{YB, (const bf16_t*)(odd ? ws + WS_WODD + i * ODD_STRIDE + WO_OFF : ws + WS_WMIX + i * EVEN_STRIDE + WOUT_OFF), M, D, D}; if (odd) bias = a.bo + i * D; ssn = ssb; }
            const bool first = (kind == 2 && l == 0 && !second), last = (kind == 2 && l == 3 && second), prelast = (kind == 8 && l == 3);
            bf16_t* xl = (bf16_t*)((unsigned char*)a.out + OUT_XL); bf16_t* xl2 = (bf16_t*)(ws + WS_LO);
            pg8::StaticOrder S; S.init(M, D, nblk, bid);
            pg8::EpiResid E{first ? a.x : nullptr, XB, last ? xl2 : xl, prelast ? xl2 : xl, last ? a.out : nullptr, ssn, bias, scale};
            pg8::gemm_phase<pg8::EpiResid, pg8::StaticOrder, false, true>(lds, g, S, E, tid_);
        } else if ((kind == 3 || kind == 5) && (PHM & 8)) {
            pg8::Gemm g; pg8::EpiBf E;
            if (kind == 3 && !odd) { g = pg8::Gemm{XB, (const bf16_t*)(ws + WS_WMIX + i * EVEN_STRIDE), M, ZC, D}; E = pg8::EpiBf{HZ, ZC, ssb, nullptr, 3, nullptr, nullptr, nullptr}; }
            else if (kind == 3) { g = pg8::Gemm{XB, (const bf16_t*)(ws + WS_WODD + i * ODD_STRIDE), M, QKVC, D}; E = pg8::EpiBf{HZ, QKVC, ssb, a.bqkv + i * QKVC, 2, (const float*)(ws + WS_ROPE), a.qn + i * 64, a.kn + i * 64}; }
            else { g = pg8::Gemm{(const bf16_t*)((unsigned char*)a.out + OUT_LA), (const bf16_t*)(ws + WS_WMIX + i * EVEN_STRIDE + WLORA_OFF), M, LOC, LAC}; E = pg8::EpiBf{(bf16_t*)(ws + WS_LO), LOC, nullptr, (const float*)(ws + WS_LB) + i * LOC, 1, nullptr, nullptr, nullptr}; }
            pg8::StaticOrder S; S.init(M, g.N, nblk, bid);
            pg8::gemm_phase<pg8::EpiBf, pg8::StaticOrder, true, true>(lds, g, S, E, tid_);
        } else if (kind == 4 && (PHM & 16)) el_phase(a, i, tid_, bid, nblk);
        else if (kind == 6 && (PHM & 32)) scan_phase(a, lds, i, tid_, bid, nblk);
        else if (kind == 7 && (PHM & 64)) post_phase(a, lds, i, tid_, bid, nblk);
        else if (kind == 9 && (PHM & 128)) attn_phase(a, lds, i, tid_, bid, nblk);
#ifndef PROBE_SYNC
#define PROBE_SYNC 1
#endif
#ifndef PROBE_PRO2
#define PROBE_PRO2 0
#endif
        if (PROBE_PRO2 && ph == 0) { grid.sync(); prologue(a, lds, tid_, bid, nblk); }
        if (ph + 1 < ph_hi) { if (ph == ph_lo) { grid.sync(); xbar = xcd_barrier_post((unsigned*)ws, MISC + 8); } else xcd_barrier(xbar); }
    }
}

#ifndef MK_MULTI
#define MK_MULTI 0
#endif
extern "C" void kernel_launch(void* const* d_in, const int* in_sizes, int n_in, void* d_out, int out_size, void* d_ws, size_t ws_size, hipStream_t stream) {
    static int grid = 0;
    if (grid == 0) {
        if (n_in != 35 || in_sizes[0] != M * D || out_size != M * D || ws_size < WS_END) { fprintf(stderr, "kernel_launch: unexpected shapes (n_in %d, in0 %d, out %d, ws %zu); nothing launched\n", n_in, n_in > 0 ? in_sizes[0] : -1, out_size, ws_size); grid = -1; return; }
        int dev = 0, cus = 0, per_cu = 0;
        hipGetDevice(&dev); hipDeviceGetAttribute(&cus, hipDeviceAttributeMultiprocessorCount, dev);
        if (hipFuncSetAttribute((const void*)mega_fwd, hipFuncAttributeMaxDynamicSharedMemorySize, LDS_BYTES) != hipSuccess) { fprintf(stderr, "kernel_launch: hipFuncSetAttribute failed\n"); grid = -1; return; }
        if (hipOccupancyMaxActiveBlocksPerMultiprocessor(&per_cu, (const void*)mega_fwd, 512, LDS_BYTES) != hipSuccess || per_cu < 1) { fprintf(stderr, "kernel_launch: occupancy query says %d\n", per_cu); per_cu = 1; }
        (void)hipGetLastError();
        grid = cus * per_cu;
        if (grid > 256) grid = 256;
    }
    if (grid < 0) return;
    Args a{};
    const float** fp = (const float**)&a.f1n;
    a.x = (const float*)d_in[0]; a.pos = (const int*)d_in[1];
    for (int k = 2; k < 35; ++k) fp[k - 2] = (const float*)d_in[k];
    a.out = (float*)d_out; a.ws = (unsigned char*)d_ws;
    for (int d = 0; d < 32; ++d) a.inv_freq[d] = (float)pow(10000.0, -(double)(2 * d) / 64.0);
#if MK_MULTI
    for (int ph = 0; ph < N_PHASES; ++ph) { a.ph_lo = ph; a.ph_hi = ph + 1; hipLaunchKernelGGL(mega_fwd, dim3(grid), dim3(512), LDS_BYTES, stream, a); }
#else
    a.ph_lo = 0; a.ph_hi = N_PHASES;
    void* args[] = {&a};
    hipError_t e = hipLaunchCooperativeKernel((const void*)mega_fwd, dim3(grid), dim3(512), args, LDS_BYTES, stream);
    if (e != hipSuccess) fprintf(stderr, "cooperative launch failed: %s (grid %d)\n", hipGetErrorString(e), grid);
#endif
}
```
